# Optimizing an MI355X kernel written in HIP

```python
import jax, jax.numpy as jnp
from jax import lax
import numpy as np

D_MODEL = 1024
BATCH = 16
SEQ = 2048
DEPTH = 1

MIX_WIDTH = D_MODEL
RET_HEADS = 4
RET_DK = MIX_WIDTH // (2 * RET_HEADS)
RET_DV = MIX_WIDTH // (2 * RET_HEADS)
RET_WIDTH = RET_HEADS * RET_DV
RET_CHUNK = 128
DIFF_HEADS = 4
DIFF_DQK = MIX_WIDTH // (4 * DIFF_HEADS)
DIFF_DV = 2 * DIFF_DQK
DIFF_WIDTH = DIFF_HEADS * DIFF_DV
Q_BLOCK = 128
IN_SPLITS = [RET_HEADS * RET_DK, RET_HEADS * RET_DK, RET_WIDTH, RET_WIDTH,
             DIFF_HEADS * 2 * DIFF_DQK, DIFF_HEADS * 2 * DIFF_DQK, DIFF_WIDTH]
IN_COLS = sum(IN_SPLITS)
IN_OFFSETS = [int(o) for o in np.cumsum(IN_SPLITS)[:-1]]

PEER_HEADS = 8
PEER_TOPK = 16
N_KEYS = 128
N_EXPERTS = N_KEYS * N_KEYS
PEER_DQ = 256
PEER_TOKEN_BLOCK = 128

RMS_EPS = 1e-6
NEG_INF = -1e30

kernel_name = "hybrid_retnet_diffattn_peer"


def rmsnorm(x, g=None):
    xf = x.astype(jnp.float32)
    y = xf * lax.rsqrt(jnp.mean(xf * xf, axis=-1, keepdims=True) + RMS_EPS)
    if g is not None:
        y = y * g.astype(jnp.float32)
    return y.astype(x.dtype)


def lambda_init(layer_idx):
    return 0.8 - 0.6 * float(np.exp(-0.3 * layer_idx))


def retention(q, k, v):
    B, T, H, dk = q.shape
    dv = v.shape[-1]
    C = RET_CHUNK
    N = T // C
    log_gamma = jnp.log1p(-jnp.exp2(-5.0 - jnp.arange(H, dtype=jnp.float32)))

    def chunks(a):
        return a.astype(jnp.float32).reshape(B, N, C, H, a.shape[-1]).transpose(1, 0, 3, 2, 4)

    qc, kc, vc = chunks(q), chunks(k) * (dk ** -0.5), chunks(v)
    idx = jnp.arange(C, dtype=jnp.float32)
    rel = idx[:, None] - idx[None, :]
    intra = jnp.where(rel >= 0, jnp.exp(log_gamma[:, None, None] * jnp.maximum(rel, 0.0)), 0.0)
    cross = jnp.exp(log_gamma[:, None] * (idx + 1.0))
    kdec = jnp.exp(log_gamma[:, None] * (C - 1.0 - idx))
    cdec = jnp.exp(log_gamma * C)

    def step(S, inp):
        qi, ki, vi = inp
        o = jnp.einsum('bhij,bhjv->bhiv', jnp.einsum('bhid,bhjd->bhij', qi, ki) * intra[None], vi)
        o = o + jnp.einsum('bhid,bhdv->bhiv', qi, S) * cross[None, :, :, None]
        S = S * cdec[None, :, None, None] + jnp.einsum('bhjd,bhjv->bhdv', ki * kdec[None, :, :, None], vi)
        return S, o

    S0 = jnp.zeros((B, H, dk, dv), jnp.float32)
    _, o = lax.scan(step, S0, (qc, kc, vc))
    return o.transpose(1, 0, 3, 2, 4).reshape(B, T, H, dv)


def alibi_slopes(n_heads):
    return jnp.exp2(-8.0 * (jnp.arange(n_heads, dtype=jnp.float32) + 1.0) / n_heads)


def diff_attention(q, k, v, lam):
    B, T, H, _, d = q.shape
    dv = v.shape[-1]
    C = Q_BLOCK
    N = T // C
    qb = (q.astype(jnp.float32) * (d ** -0.5)).reshape(B, N, C, H, 2, d).transpose(1, 0, 3, 4, 2, 5)
    kt = k.astype(jnp.float32).transpose(0, 2, 3, 1, 4)
    vt = v.astype(jnp.float32).transpose(0, 2, 1, 3)
    slopes = alibi_slopes(H)
    kpos = jnp.arange(T)

    def block(args):
        qi, start = args
        qpos = start + jnp.arange(C)
        dist = (qpos[:, None] - kpos[None, :]).astype(jnp.float32)
        bias = jnp.where(dist >= 0, -slopes[:, None, None] * dist, NEG_INF)
        s = jnp.einsum('bhpid,bhpjd->bhpij', qi, kt) + bias[None, :, None]
        p = jax.nn.softmax(s, axis=-1)
        a = p[:, :, 0] - lam * p[:, :, 1]
        return jnp.einsum('bhij,bhjv->bhiv', a, vt)

    o = lax.map(block, (qb, jnp.arange(N) * C))
    return o.transpose(1, 0, 3, 2, 4).reshape(B, T, H, dv)


def peer(xn, wq, subkeys, u, v):
    B, T, D = xn.shape
    xt = xn.reshape(-1, PEER_TOKEN_BLOCK, D)
    K = PEER_TOPK

    def block(xb):
        t = xb.shape[0]
        q = (xb @ wq).reshape(t, PEER_HEADS, 2, PEER_DQ // 2)
        s = jnp.einsum('thpd,hpkd->thpk', q, subkeys).astype(jnp.float32)
        s_top, i_top = lax.top_k(s, K)
        cand = (s_top[:, :, 0, :, None] + s_top[:, :, 1, None, :]).reshape(t, PEER_HEADS, K * K)
        c_top, c_idx = lax.top_k(cand, K)
        i1 = jnp.take_along_axis(i_top[:, :, 0], c_idx // K, axis=-1)
        i2 = jnp.take_along_axis(i_top[:, :, 1], c_idx % K, axis=-1)
        e = i1 * N_KEYS + i2
        g = jax.nn.softmax(c_top, axis=-1)
        ue = jnp.take(u, e, axis=0)
        ve = jnp.take(v, e, axis=0)
        act = jax.nn.gelu(jnp.einsum('thkd,td->thk', ue, xb).astype(jnp.float32), approximate=False)
        return jnp.einsum('thk,thkd->td', (g * act).astype(xb.dtype), ve)

    return lax.map(block, xt).reshape(B, T, D)


def setup_inputs(seed: int = 0) -> dict:
    key = jax.random.key(seed)
    ks = jax.random.split(key, 13)
    f = jnp.float32
    x = jax.random.normal(ks[0], (BATCH, SEQ, D_MODEL), f)
    norm_mix_g = 1.0 + 0.02 * jax.random.normal(ks[1], (DEPTH, D_MODEL), f)
    w_in = jax.random.normal(ks[2], (DEPTH, D_MODEL, IN_COLS), f) * D_MODEL ** -0.5
    diff_lambda = 0.1 * jax.random.normal(ks[3], (DEPTH, 4, DIFF_DQK), f)
    diff_subln_g = 1.0 + 0.02 * jax.random.normal(ks[4], (DEPTH, DIFF_DV), f)
    w_out = jax.random.normal(ks[5], (DEPTH, MIX_WIDTH, D_MODEL), f) * MIX_WIDTH ** -0.5
    norm_ffn_g = 1.0 + 0.02 * jax.random.normal(ks[6], (DEPTH, D_MODEL), f)
    peer_wq = jax.random.normal(ks[7], (DEPTH, D_MODEL, PEER_HEADS * PEER_DQ), f) * D_MODEL ** -0.5
    peer_subkeys = jax.random.normal(ks[8], (DEPTH, PEER_HEADS, 2, N_KEYS, PEER_DQ // 2), f) * (PEER_DQ // 2) ** -0.5
    peer_u = jax.random.normal(ks[9], (DEPTH, N_EXPERTS, D_MODEL), f) * D_MODEL ** -0.5
    peer_v = jax.random.normal(ks[10], (DEPTH, N_EXPERTS, D_MODEL), f) * PEER_TOPK ** -0.5
    final_norm_g = 1.0 + 0.02 * jax.random.normal(ks[11], (D_MODEL,), f)
    return {"x": x, "norm_mix_g": norm_mix_g, "w_in": w_in, "diff_lambda": diff_lambda,
            "diff_subln_g": diff_subln_g, "w_out": w_out, "norm_ffn_g": norm_ffn_g,
            "peer_wq": peer_wq, "peer_subkeys": peer_subkeys, "peer_u": peer_u,
            "peer_v": peer_v, "final_norm_g": final_norm_g}


def reference(x, norm_mix_g, w_in, diff_lambda, diff_subln_g, w_out, norm_ffn_g,
              peer_wq, peer_subkeys, peer_u, peer_v, final_norm_g):
    B, T, D = x.shape
    for l in range(DEPTH):
        h = rmsnorm(x, norm_mix_g[l])
        proj = h @ w_in[l]
        rq, rk, rv, rg, dq, dk, dv = jnp.split(proj, IN_OFFSETS, axis=-1)
        ry = retention(rq.reshape(B, T, RET_HEADS, RET_DK), rk.reshape(B, T, RET_HEADS, RET_DK),
                       rv.reshape(B, T, RET_HEADS, RET_DV))
        ry = rmsnorm(ry).reshape(B, T, RET_WIDTH)
        ret_out = (jax.nn.silu(rg.astype(jnp.float32)) * ry).astype(x.dtype)
        li = lambda_init(l)
        lp = diff_lambda[l].astype(jnp.float32)
        lam = jnp.exp(jnp.sum(lp[0] * lp[1])) - jnp.exp(jnp.sum(lp[2] * lp[3])) + li
        dy = diff_attention(dq.reshape(B, T, DIFF_HEADS, 2, DIFF_DQK), dk.reshape(B, T, DIFF_HEADS, 2, DIFF_DQK),
                            dv.reshape(B, T, DIFF_HEADS, DIFF_DV), lam)
        diff_out = (rmsnorm(dy, diff_subln_g[l]) * (1.0 - li)).reshape(B, T, DIFF_WIDTH).astype(x.dtype)
        x = x + jnp.concatenate([ret_out, diff_out], axis=-1) @ w_out[l]
        x = x + peer(rmsnorm(x, norm_ffn_g[l]), peer_wq[l], peer_subkeys[l], peer_u[l], peer_v[l])
    return rmsnorm(x, final_norm_g)
```

```cpp
#include <hip/hip_runtime.h>
#include <hip/hip_cooperative_groups.h>
#include <cstdio>
#include <cstdint>
namespace cg = cooperative_groups;

#define LAS __attribute__((address_space(3)))
typedef unsigned short bf16;
typedef short bf16x8 __attribute__((ext_vector_type(8)));
typedef short s16x4 __attribute__((ext_vector_type(4)));
typedef float f32x4 __attribute__((ext_vector_type(4)));
typedef float f32x2 __attribute__((ext_vector_type(2)));
typedef float f32x16 __attribute__((ext_vector_type(16)));
typedef unsigned u32x4 __attribute__((ext_vector_type(4)));
typedef unsigned u32x2 __attribute__((ext_vector_type(2)));
typedef int i32x2 __attribute__((ext_vector_type(2)));

constexpr int BATCH = 16, SEQ = 2048, DM = 1024, MTOK = BATCH * SEQ;
constexpr int NIN = 3584;
constexpr int C_RQ = 0, C_RK = 512, C_RV = 1024, C_RG = 1536, C_DQ = 2048, C_DK = 2560, C_DV = 3072;
constexpr int NQ = 2048;
constexpr int NEXP = 16384;
constexpr float RMS_EPS = 1e-6f;
constexpr float LOG2E = 1.4426950408889634f;
constexpr float QSCALE2 = 0.125f * LOG2E;
constexpr float RK_SCALE = 0.08838834764831845f;

constexpr size_t MiB = 1u << 20;
constexpr size_t WS_CTL = 0, CTL_BYTES = 1 * MiB;
constexpr size_t WS_WIN = 1 * MiB;
constexpr size_t WS_WOUT = 8 * MiB;
constexpr size_t WS_WQ = 10 * MiB;
constexpr size_t WS_SK = 14 * MiB;
constexpr size_t WS_RSS = 15 * MiB;
constexpr size_t WS_U = 17 * MiB;
constexpr size_t WS_V = 33 * MiB;
constexpr size_t WS_SU = 49 * MiB, WS_SV = 49 * MiB + 65536;
constexpr size_t WS_H = 81 * MiB;
constexpr size_t WS_PROJ = 145 * MiB;
constexpr size_t WS_XG = WS_PROJ;
constexpr size_t WS_Q = WS_PROJ + 64 * MiB;
constexpr size_t WS_END = WS_PROJ + 224 * MiB;
constexpr int CW_QUEUE = 64;

constexpr int LDS_MAIN = 147456;
constexpr int LDS_BYTES = LDS_MAIN + 256;

__device__ __forceinline__ unsigned f2bf(float f) { unsigned u = __builtin_bit_cast(unsigned, f); return (u + 0x7fffu + ((u >> 16) & 1u)) >> 16; }
__device__ __forceinline__ unsigned pk2(float lo, float hi) { typedef __bf16 bf16x2_t __attribute__((ext_vector_type(2))); f32x2 v = {lo, hi}; bf16x2_t b = __builtin_convertvector(v, bf16x2_t); return __builtin_bit_cast(unsigned, b); }
__device__ __forceinline__ float bf_lo(unsigned u) { return __builtin_bit_cast(float, u << 16); }
__device__ __forceinline__ float bf_hi(unsigned u) { return __builtin_bit_cast(float, u & 0xffff0000u); }
__device__ __forceinline__ unsigned off_b(unsigned row, unsigned ch) { return 256u * row + 16u * (ch ^ (((row & 3) << 2) | ((row >> 2) & 3))); }
__device__ __forceinline__ s16x4 lds_tr(const LAS char* p) { typedef short v4i16_t __attribute__((ext_vector_type(4))); return __builtin_bit_cast(s16x4, __builtin_amdgcn_ds_read_tr16_b64_v4i16((LAS v4i16_t*)p)); }
__device__ __forceinline__ bf16x8 cat8(s16x4 lo, s16x4 hi) { return __builtin_shufflevector(lo, hi, 0, 1, 2, 3, 4, 5, 6, 7); }
__device__ __forceinline__ float wave_sum(float v) {
#pragma unroll
    for (int o = 1; o < 64; o <<= 1) v += __shfl_xor(v, o);
    return v;
}
#define DPPF(v, ctrl) __int_as_float(__builtin_amdgcn_update_dpp(0, __float_as_int(v), ctrl, 0xf, 0xf, false))
__device__ __forceinline__ float wave_sum_fast(float v) {
    v += DPPF(v, 0xB1); v += DPPF(v, 0x4E); v += DPPF(v, 0x141); v += DPPF(v, 0x140);
    { auto r = __builtin_amdgcn_permlane16_swap(__float_as_uint(v), __float_as_uint(v), false, false); v = __uint_as_float(r[0]) + __uint_as_float(r[1]); }
    { auto r = __builtin_amdgcn_permlane32_swap(__float_as_uint(v), __float_as_uint(v), false, false); v = __uint_as_float(r[0]) + __uint_as_float(r[1]); }
    return v;
}
__device__ __forceinline__ float wave_max_fast(float v) {
    v = fmaxf(v, DPPF(v, 0xB1)); v = fmaxf(v, DPPF(v, 0x4E)); v = fmaxf(v, DPPF(v, 0x141)); v = fmaxf(v, DPPF(v, 0x140));
    { auto r = __builtin_amdgcn_permlane16_swap(__float_as_uint(v), __float_as_uint(v), false, false); v = fmaxf(__uint_as_float(r[0]), __uint_as_float(r[1])); }
    { auto r = __builtin_amdgcn_permlane32_swap(__float_as_uint(v), __float_as_uint(v), false, false); v = fmaxf(__uint_as_float(r[0]), __uint_as_float(r[1])); }
    return v;
}
namespace pg8 {
#define PG8_LAS __attribute__((address_space(3)))
typedef unsigned short bf16_t;
typedef short bf16x8 __attribute__((ext_vector_type(8)));
typedef float f32x4 __attribute__((ext_vector_type(4)));
typedef unsigned u32x4 __attribute__((ext_vector_type(4)));
constexpr int BM = 256, BK = 64, HALF = 128, HTB = HALF * BK * 2  , STAGE_BYTES = 8 * HTB, NXCD = 8, WGM = 8;

__host__ __device__ __forceinline__ int lds_byte(int r, int c) { const int st = (r >> 4) * 2 + (c >> 5), rr = r & 15, cc = c & 31, ob = rr * 64 + cc * 2; return st * 1024 + (ob ^ (((ob >> 9) & 1) << 5)); }
__host__ __device__ __forceinline__ void stage_rc(int b, int& R, int& C) { const int st = b / 1024, sb = b % 1024, swz = sb ^ (((sb >> 9) & 1) << 5); R = (st >> 1) * 16 + swz / 64; C = (st & 1) * 32 + (swz % 64) / 2; }
__host__ __device__ __forceinline__ int perm32(int rho) { const int n = rho >> 4, i = rho & 15; return 8 * (i >> 2) + 4 * n + (i & 3); }

struct Unit { int pm, pn; };
struct Gemm { const bf16_t* A; const bf16_t* Bt; int M, N, K; };

struct StaticOrder {
    int nM, nN, nwg, G, c;
    __host__ __device__ void init(int M, int N, int G_, int c_) { nM = M / BM; nN = N / BM; nwg = nM * nN; G = G_; c = c_; }
    __host__ __device__ bool next(int i, Unit& u) const {
        const long L = (long)i * G + c; if (L >= nwg) return false;
        int wgid = (int)L; { const int q = nwg / NXCD, r = nwg % NXCD, xcd = wgid % NXCD, off = wgid / NXCD; wgid = (xcd < r ? xcd * (q + 1) : r * (q + 1) + (xcd - r) * q) + off; }
        const int nig = WGM * nN, gid = wgid / nig, fm = gid * WGM, gsz = (nM - fm) < WGM ? (nM - fm) : WGM;
        u.pm = fm + ((wgid % nig) % gsz); u.pn = (wgid % nig) / gsz; return true;
    }
    __device__ __forceinline__ void a_ready(const Unit&) const {}
    __device__ __forceinline__ void done(const Unit&) const {}
};

__device__ __forceinline__ unsigned cvt_pk_bf16(float lo, float hi) { unsigned r; asm volatile("v_cvt_pk_bf16_f32 %0, %1, %2" : "=v"(r) : "v"(lo), "v"(hi)); return r; }
typedef float f32x2 __attribute__((ext_vector_type(2)));
__device__ __forceinline__ f32x2 gelu_pk(f32x2 v) {
    const f32x2 av = __builtin_elementwise_abs(v), d = av * 0.2316418882f + 1.0f;
    f32x2 t; t.x = __builtin_amdgcn_rcpf(d.x); t.y = __builtin_amdgcn_rcpf(d.y);
    f32x2 q = t * 0.5307027145f + (-0.7265760135f); q = q * t + 0.7107068705f; q = q * t + (-0.142248368f); q = q * t + 0.127414796f; q = q * t;
    const f32x2 s = (v * v) * (-0.72134752044f);
    f32x2 e; e.x = __builtin_amdgcn_exp2f(s.x); e.y = __builtin_amdgcn_exp2f(s.y);
    const f32x2 m = v * (q * e), r = v - m;
    f32x2 o; o.x = v.x < 0.f ? m.x : r.x; o.y = v.y < 0.f ? m.y : r.y; return o;
}

template <class Epi, class Sched, bool ALIGN_EPI = false, bool SP2 = false>
__device__ __forceinline__ void gemm_phase(PG8_LAS unsigned char* lds, const Gemm g, const Sched& S, const Epi& E) {
    const int tid = threadIdx.x, wid = __builtin_amdgcn_readfirstlane(tid >> 6), lane = tid & 63, wr = wid >> 2, wc = wid & 3, fr = lane & 15, fq = lane >> 4;
    const int K = g.K, nt = K / BK;
    unsigned voffA[2], voffB[2];
#pragma unroll
    for (int i = 0; i < 2; ++i) { int R, C; stage_rc(tid * 16 + i * 8192, R, C); const int Rb = Epi::PERM ? ((R & ~31) + perm32(R & 31)) : R;
        voffA[i] = (unsigned)(R * K + C) * 2u; voffB[i] = (unsigned)(Rb * K + C) * 2u; }
    const size_t kstep = (size_t)(BK * 2);
    const size_t hstep = (size_t)HALF * K * 2;
    const size_t tstep = 2 * hstep;
    const unsigned ldsw = (unsigned)wid * 1024u;
    const int aoff = lds_byte(wr * 64 + fr, fq * 8), boff = lds_byte(wc * 32 + fr, fq * 8);
#define PG8_SA(b, h) (((b) * 2 + (h)) * HTB)
#define PG8_SB(b, h) ((4 + (b) * 2 + (h)) * HTB)
#define PG8_STAGE(bufoff, gbase, voff) do { _Pragma("unroll") for (int _i = 0; _i < 2; ++_i) \
        __builtin_amdgcn_global_load_lds((const unsigned*)((const char*)(gbase) + (voff)[_i]), (PG8_LAS unsigned*)(lds + (bufoff) + ldsw + _i * 8192), 16, 0, 0); } while (0)
#define PG8_LDA(dst, b, h) do { _Pragma("unroll") for (int m = 0; m < 4; ++m) _Pragma("unroll") for (int k = 0; k < 2; ++k) dst[m][k] = *(const PG8_LAS bf16x8*)(lds + PG8_SA(b, h) + aoff + m * 2048 + k * 1024); } while (0)
#define PG8_LDB(dst, b, h) do { _Pragma("unroll") for (int n = 0; n < 2; ++n) _Pragma("unroll") for (int k = 0; k < 2; ++k) dst[n][k] = *(const PG8_LAS bf16x8*)(lds + PG8_SB(b, h) + boff + n * 2048 + k * 1024); } while (0)
#define PG8_MMA(ai, bj, At, Bt) do { __builtin_amdgcn_s_setprio(1); _Pragma("unroll") for (int m = 0; m < 4; ++m) _Pragma("unroll") for (int n = 0; n < 2; ++n) _Pragma("unroll") for (int k = 0; k < 2; ++k) \
        acc[ai][bj][m][n] = __builtin_amdgcn_mfma_f32_16x16x32_bf16(Bt[n][k], At[m][k], acc[ai][bj][m][n], 0, 0, 0); __builtin_amdgcn_s_setprio(0); } while (0)
#define PG8_WAIT_V(n) asm volatile("s_waitcnt vmcnt(" #n ")" ::: "memory")
#define PG8_WAIT_L(n) asm volatile("s_waitcnt lgkmcnt(" #n ")" ::: "memory")
#define PG8_BAR __builtin_amdgcn_s_barrier()
#define PG8_SCHED __builtin_amdgcn_sched_barrier(0)
    Unit cur, nxt; int ui = 0;
    if (!S.next(0, cur)) return;
    f32x4 acc[2][2][4][2];
#pragma unroll
    for (int a = 0; a < 2; ++a)
#pragma unroll
        for (int b = 0; b < 2; ++b)
#pragma unroll
            for (int m = 0; m < 4; ++m)
#pragma unroll
                for (int n = 0; n < 2; ++n) acc[a][b][m][n] = (f32x4){0.f, 0.f, 0.f, 0.f};
    bf16x8 At[4][2], B0[2][2], B1[2][2];
    const char* cA = (const char*)g.A + (size_t)cur.pm * tstep; const char* cB = (const char*)g.Bt + (size_t)cur.pn * tstep;
    S.a_ready(cur);
    if constexpr (SP2) {
        PG8_STAGE(PG8_SB(0, 0), cB, voffB); PG8_STAGE(PG8_SB(0, 1), cB + hstep, voffB); PG8_STAGE(PG8_SA(0, 0), cA, voffA); PG8_STAGE(PG8_SA(0, 1), cA + hstep, voffA);
        if (wr == 1) PG8_BAR;
        PG8_WAIT_V(2); PG8_BAR;
        PG8_STAGE(PG8_SB(1, 0), cB + kstep, voffB); PG8_STAGE(PG8_SA(1, 0), cA + kstep, voffA); PG8_STAGE(PG8_SB(1, 1), cB + hstep + kstep, voffB);
        PG8_WAIT_V(6); PG8_BAR;
    } else {
        PG8_STAGE(PG8_SB(0, 0), cB, voffB); PG8_STAGE(PG8_SA(0, 0), cA, voffA); PG8_STAGE(PG8_SB(0, 1), cB + hstep, voffB); PG8_STAGE(PG8_SA(0, 1), cA + hstep, voffA);
        if (wr == 1) PG8_BAR;
        PG8_WAIT_V(4); PG8_BAR;
        PG8_STAGE(PG8_SB(1, 0), cB + kstep, voffB); PG8_STAGE(PG8_SA(1, 0), cA + kstep, voffA); PG8_STAGE(PG8_SB(1, 1), cB + hstep + kstep, voffB);
        PG8_WAIT_V(6); PG8_BAR;
    }
    for (;;) {
        const bool has_next = S.next(ui + 1, nxt);
        const char* nA = has_next ? (const char*)g.A + (size_t)nxt.pm * tstep : cA; const char* nB = has_next ? (const char*)g.Bt + (size_t)nxt.pn * tstep : cB;
        for (int t = 0; t < nt; t += 2) {
            const bool last = (t == nt - 2);
            const char* a1 = cA + (size_t)(t + 1) * kstep;
            const char* a2 = last ? nA : cA + (size_t)(t + 2) * kstep; const char* b2 = last ? nB : cB + (size_t)(t + 2) * kstep;
            const char* a3 = a2 + kstep; const char* b3 = b2 + kstep;
            if (last && has_next) S.a_ready(nxt);
            if constexpr (SP2) {
            PG8_LDB(B0, 0, 0); PG8_LDB(B1, 0, 1); PG8_SCHED; PG8_LDA(At, 0, 0); PG8_STAGE(PG8_SA(1, 1), a1 + hstep, voffA);
            PG8_WAIT_V(8); PG8_WAIT_L(0); PG8_BAR; PG8_MMA(0, 0, At, B0); PG8_MMA(0, 1, At, B1); PG8_BAR; PG8_SCHED;
            PG8_LDA(At, 0, 1); PG8_STAGE(PG8_SB(0, 0), b2, voffB); PG8_STAGE(PG8_SB(0, 1), b2 + hstep, voffB); PG8_STAGE(PG8_SA(0, 0), a2, voffA);
            PG8_WAIT_V(8); PG8_WAIT_L(0); PG8_BAR; PG8_MMA(1, 0, At, B0); PG8_MMA(1, 1, At, B1); PG8_BAR; PG8_SCHED;
            PG8_LDB(B0, 1, 0); PG8_LDB(B1, 1, 1); PG8_SCHED; PG8_LDA(At, 1, 0); PG8_STAGE(PG8_SA(0, 1), a2 + hstep, voffA);
            PG8_WAIT_V(8); PG8_WAIT_L(0); PG8_BAR; PG8_MMA(0, 0, At, B0); PG8_MMA(0, 1, At, B1); PG8_BAR; PG8_SCHED;
            PG8_LDA(At, 1, 1); PG8_STAGE(PG8_SB(1, 0), b3, voffB); PG8_STAGE(PG8_SB(1, 1), b3 + hstep, voffB); PG8_STAGE(PG8_SA(1, 0), a3, voffA);
            PG8_WAIT_V(8); PG8_WAIT_L(0); PG8_BAR; PG8_MMA(1, 0, At, B0); PG8_MMA(1, 1, At, B1); PG8_BAR; PG8_SCHED;
            } else {
            PG8_LDB(B0, 0, 0); PG8_SCHED; PG8_LDA(At, 0, 0); PG8_STAGE(PG8_SA(1, 1), a1 + hstep, voffA);
            PG8_WAIT_L(8); PG8_BAR; PG8_WAIT_L(0); PG8_MMA(0, 0, At, B0); PG8_BAR; PG8_SCHED;
            PG8_LDB(B1, 0, 1); PG8_STAGE(PG8_SB(0, 0), b2, voffB);
            PG8_BAR; PG8_WAIT_L(0); PG8_MMA(0, 1, At, B1); PG8_BAR;
            PG8_LDA(At, 0, 1); PG8_STAGE(PG8_SA(0, 0), a2, voffA);
            PG8_BAR; PG8_WAIT_L(0); PG8_MMA(1, 0, At, B0); PG8_BAR; PG8_SCHED;
            PG8_STAGE(PG8_SB(0, 1), b2 + hstep, voffB);
            PG8_WAIT_V(6); PG8_BAR; PG8_MMA(1, 1, At, B1); PG8_BAR;
            PG8_LDB(B0, 1, 0); PG8_SCHED; PG8_LDA(At, 1, 0); PG8_STAGE(PG8_SA(0, 1), a2 + hstep, voffA);
            PG8_WAIT_L(8); PG8_BAR; PG8_WAIT_L(0); PG8_MMA(0, 0, At, B0); PG8_BAR; PG8_SCHED;
            PG8_LDB(B1, 1, 1); PG8_STAGE(PG8_SB(1, 0), b3, voffB);
            PG8_BAR; PG8_WAIT_L(0); PG8_MMA(0, 1, At, B1); PG8_BAR;
            PG8_LDA(At, 1, 1); PG8_STAGE(PG8_SA(1, 0), a3, voffA);
            PG8_BAR; PG8_WAIT_L(0); PG8_MMA(1, 0, At, B0); PG8_BAR; PG8_SCHED;
            PG8_STAGE(PG8_SB(1, 1), b3 + hstep, voffB);
            PG8_WAIT_V(6); PG8_BAR; PG8_MMA(1, 1, At, B1); PG8_BAR;
            }
        }
        if constexpr (ALIGN_EPI) { if (wr == 0) PG8_BAR; }
        if constexpr (!Epi::AFTER_DRAIN) { E(acc, cur, wr, wc, fr, fq); S.done(cur); }
        if (!has_next) break;
#pragma unroll
        for (int a = 0; a < 2; ++a)
#pragma unroll
            for (int b = 0; b < 2; ++b)
#pragma unroll
                for (int m = 0; m < 4; ++m)
#pragma unroll
                    for (int n = 0; n < 2; ++n) acc[a][b][m][n] = (f32x4){0.f, 0.f, 0.f, 0.f};
        cur = nxt; cA = nA; cB = nB; ++ui;
        if constexpr (ALIGN_EPI) { if (wr == 1) PG8_BAR; }
    }
    PG8_WAIT_V(0);
    if constexpr (!ALIGN_EPI) { if (wr == 0) PG8_BAR; }
    PG8_BAR;
    if constexpr (Epi::AFTER_DRAIN) { E.fused(acc, cur, wr, wc, fr, fq, lds, wid, lane); S.done(cur); }
#undef PG8_SA
#undef PG8_SB
#undef PG8_STAGE
#undef PG8_LDA
#undef PG8_LDB
#undef PG8_MMA
#undef PG8_WAIT_V
#undef PG8_WAIT_L
#undef PG8_BAR
#undef PG8_SCHED
}
}
namespace pg8 {
struct EpiProj {
    static constexpr bool PERM = true, AFTER_DRAIN = false;
    bf16_t* O;
    __device__ __forceinline__ void operator()(const f32x4 (&acc)[2][2][4][2], const Unit& u, int wr, int wc, int fr, int fq) const {
        const int row0 = u.pm * BM + wr * 64 + fr, col0 = u.pn * BM + wc * 32 + 8 * fq;
        const float sc = (u.pn == 2 || u.pn == 3) ? RK_SCALE : ((u.pn == 8 || u.pn == 9) ? QSCALE2 : 1.f);
#pragma unroll
        for (int ai = 0; ai < 2; ++ai)
#pragma unroll
            for (int m = 0; m < 4; ++m) { bf16_t* rowp = O + (size_t)(row0 + ai * HALF + m * 16) * NIN + col0;
#pragma unroll
                for (int bj = 0; bj < 2; ++bj) { const f32x4 v0 = acc[ai][bj][m][0] * sc, v1 = acc[ai][bj][m][1] * sc;
                    u32x4 w; w.x = cvt_pk_bf16(v0[0], v0[1]); w.y = cvt_pk_bf16(v0[2], v0[3]); w.z = cvt_pk_bf16(v1[0], v1[1]); w.w = cvt_pk_bf16(v1[2], v1[3]);
                    *(u32x4*)(rowp + bj * HALF) = w; } }
    }
};
struct EpiOut {
    static constexpr bool PERM = true, AFTER_DRAIN = false;
    const float* X; bf16_t* XB; float* RSS;
    __device__ __forceinline__ void operator()(const f32x4 (&acc)[2][2][4][2], const Unit& u, int wr, int wc, int fr, int fq) const {
        const int row0 = u.pm * BM + wr * 64 + fr, col0 = u.pn * BM + wc * 32 + 8 * fq;
#pragma unroll
        for (int ai = 0; ai < 2; ++ai)
#pragma unroll
            for (int m = 0; m < 4; ++m) { const int row = row0 + ai * HALF + m * 16; const size_t off = (size_t)row * DM + col0; float ss = 0.f;
#pragma unroll
                for (int bj = 0; bj < 2; ++bj) {
                    const f32x4 a0 = *(const f32x4*)(X + off + bj * HALF) + acc[ai][bj][m][0], a1 = *(const f32x4*)(X + off + bj * HALF + 4) + acc[ai][bj][m][1];
                    ss += (a0[0] * a0[0] + a0[1] * a0[1]) + (a0[2] * a0[2] + a0[3] * a0[3]) + (a1[0] * a1[0] + a1[1] * a1[1]) + (a1[2] * a1[2] + a1[3] * a1[3]);
                    u32x4 w; w.x = cvt_pk_bf16(a0[0], a0[1]); w.y = cvt_pk_bf16(a0[2], a0[3]); w.z = cvt_pk_bf16(a1[0], a1[1]); w.w = cvt_pk_bf16(a1[2], a1[3]);
                    *(u32x4*)(XB + off + bj * HALF) = w; }
                ss += __shfl_xor(ss, 16); ss += __shfl_xor(ss, 32);
                if (fq == 0) RSS[(size_t)row * 16 + u.pn * 4 + wc] = ss; }
    }
};
struct EpiQ {
    static constexpr bool PERM = true, AFTER_DRAIN = false;
    const float* RSS; bf16_t* Q;
    __device__ __forceinline__ void operator()(const f32x4 (&acc)[2][2][4][2], const Unit& u, int wr, int wc, int fr, int fq) const {
        const int row0 = u.pm * BM + wr * 64 + fr, col0 = u.pn * BM + wc * 32 + 8 * fq;
#pragma unroll
        for (int ai = 0; ai < 2; ++ai)
#pragma unroll
            for (int m = 0; m < 4; ++m) { const int row = row0 + ai * HALF + m * 16;
                const f32x4* rp = (const f32x4*)(RSS + (size_t)row * 16); const f32x4 s0 = rp[0], s1 = rp[1], s2 = rp[2], s3 = rp[3];
                const float ss = ((s0[0] + s0[1]) + (s0[2] + s0[3])) + ((s1[0] + s1[1]) + (s1[2] + s1[3])) + ((s2[0] + s2[1]) + (s2[2] + s2[3])) + ((s3[0] + s3[1]) + (s3[2] + s3[3]));
                const float rstd = 1.0f / sqrtf(ss * (1.0f / DM) + RMS_EPS);
                bf16_t* rowp = Q + (size_t)row * NQ + col0;
#pragma unroll
                for (int bj = 0; bj < 2; ++bj) { const f32x4 v0 = acc[ai][bj][m][0] * rstd, v1 = acc[ai][bj][m][1] * rstd;
                    u32x4 w; w.x = cvt_pk_bf16(v0[0], v0[1]); w.y = cvt_pk_bf16(v0[2], v0[3]); w.z = cvt_pk_bf16(v1[0], v1[1]); w.w = cvt_pk_bf16(v1[2], v1[3]);
                    *(u32x4*)(rowp + bj * HALF) = w; } }
    }
};
}
struct Params {
    const float *x, *norm_mix_g, *w_in, *diff_lambda, *diff_subln_g, *w_out, *norm_ffn_g, *peer_wq, *peer_subkeys, *peer_u, *peer_v, *final_norm_g;
    float* out; unsigned char* ws; int ph_lo, ph_hi;
};
__device__ __forceinline__ void p0_transpose_item(const float* W, int K, int N, bf16* WT, LAS float* scr, int item, int lane, const float* gk = nullptr) {
    const int nblk = N / 32, kb = item / nblk, nb = item % nblk, k0 = 64 * kb, n0 = 32 * nb;
#pragma unroll 8
    for (int i = 0; i < 32; ++i) { const int kk = 2 * i + (lane >> 5); scr[kk * 33 + (lane & 31)] = W[(size_t)(k0 + kk) * N + n0 + (lane & 31)] * (gk ? gk[k0 + kk] : 1.0f); }
    asm volatile("s_waitcnt lgkmcnt(0)" ::: "memory");
    const int c = lane & 7;
#pragma unroll
    for (int j = 0; j < 4; ++j) { const int n = (lane >> 3) + 8 * j; const LAS float* s = scr + (8 * c) * 33 + n;
        u32x4 o; o.x = pk2(s[0 * 33], s[1 * 33]); o.y = pk2(s[2 * 33], s[3 * 33]); o.z = pk2(s[4 * 33], s[5 * 33]); o.w = pk2(s[6 * 33], s[7 * 33]);
        *(u32x4*)(WT + (size_t)(n0 + n) * K + k0 + 8 * c) = o; }
    asm volatile("s_waitcnt lgkmcnt(0)" ::: "memory");
}
__device__ __forceinline__ void p0_convert(const float* src, bf16* dst, size_t n8, int gw, int ngw, int lane) {
    for (size_t g = (size_t)gw * 64 + lane; g < n8; g += (size_t)ngw * 64) {
        const f32x4 a = ((const f32x4*)src)[2 * g], b = ((const f32x4*)src)[2 * g + 1];
        u32x4 o; o.x = pk2(a[0], a[1]); o.y = pk2(a[2], a[3]); o.z = pk2(b[0], b[1]); o.w = pk2(b[2], b[3]);
        ((u32x4*)dst)[g] = o; }
}
__device__ __forceinline__ void p0_fp8_rows(const float* src, unsigned char* dst, float* inv, int gw, int ngw, int lane) {
    float cal; { float one28 = 128.f; asm volatile("" : "+v"(one28)); const int enc = __builtin_amdgcn_cvt_pk_fp8_f32(one28, one28, 0, false); const f32x2 dec = __builtin_amdgcn_cvt_pk_f32_fp8(enc, false); cal = 128.f / dec.x; }
    for (int row0 = gw; row0 < NEXP; row0 += 2 * ngw) {
        f32x4 v[2][4]; float m[2];
#pragma unroll
        for (int q = 0; q < 2; ++q) { const f32x4* sp = (const f32x4*)(src + (size_t)(row0 + q * ngw) * DM + 16 * lane);
#pragma unroll
            for (int j = 0; j < 4; ++j) v[q][j] = sp[j]; }
#pragma unroll
        for (int q = 0; q < 2; ++q) { float mm = 0.f;
#pragma unroll
            for (int j = 0; j < 4; ++j) mm = fmaxf(mm, fmaxf(fmaxf(fabsf(v[q][j][0]), fabsf(v[q][j][1])), fmaxf(fabsf(v[q][j][2]), fabsf(v[q][j][3]))));
#pragma unroll
            for (int o = 1; o < 64; o <<= 1) mm = fmaxf(mm, __shfl_xor(mm, o));
            m[q] = mm; }
#pragma unroll
        for (int q = 0; q < 2; ++q) { const int row = row0 + q * ngw; const float sc = m[q] > 0.f ? 224.f / m[q] : 1.f;
            u32x4 o;
#pragma unroll
            for (int j = 0; j < 4; ++j) { int pk = __builtin_amdgcn_cvt_pk_fp8_f32(v[q][j][0] * sc, v[q][j][1] * sc, 0, false); pk = __builtin_amdgcn_cvt_pk_fp8_f32(v[q][j][2] * sc, v[q][j][3] * sc, pk, true); o[j] = (unsigned)pk; }
            *(u32x4*)(dst + (size_t)row * DM + 16 * lane) = o;
            if (lane == 0) inv[row] = (m[q] > 0.f ? m[q] * (1.0f / 224.f) : 1.f) * cal; }
    }
}
__device__ __forceinline__ void p0_norm_row(const float* xrow, const float* g, bf16* orow, int lane) {
    const f32x4* xr = (const f32x4*)xrow + lane; const f32x4* gr = (const f32x4*)g + lane;
    f32x4 v[4]; float s = 0.f;
#pragma unroll
    for (int j = 0; j < 4; ++j) { v[j] = xr[64 * j]; s += (v[j][0] * v[j][0] + v[j][1] * v[j][1]) + (v[j][2] * v[j][2] + v[j][3] * v[j][3]); }
    const float rstd = 1.0f / sqrtf(wave_sum(s) * (1.f / DM) + RMS_EPS);
    u32x2* o8 = (u32x2*)orow + lane;
#pragma unroll
    for (int j = 0; j < 4; ++j) { const f32x4 gg = gr[64 * j]; u32x2 o; o.x = pk2(v[j][0] * rstd * gg[0], v[j][1] * rstd * gg[1]); o.y = pk2(v[j][2] * rstd * gg[2], v[j][3] * rstd * gg[3]); o8[64 * j] = o; }
}
__device__ __forceinline__ void p0_norm_row2(const float* xrow0, const float* xrow1, const float* g, bf16* orow0, bf16* orow1, int lane) {
    const f32x4* x0 = (const f32x4*)xrow0 + lane; const f32x4* x1 = (const f32x4*)xrow1 + lane; const f32x4* gr = (const f32x4*)g + lane;
    f32x4 a[4], b[4]; float sa = 0.f, sb = 0.f;
#pragma unroll
    for (int j = 0; j < 4; ++j) { a[j] = x0[64 * j]; b[j] = x1[64 * j]; }
#pragma unroll
    for (int j = 0; j < 4; ++j) { sa += (a[j][0] * a[j][0] + a[j][1] * a[j][1]) + (a[j][2] * a[j][2] + a[j][3] * a[j][3]); sb += (b[j][0] * b[j][0] + b[j][1] * b[j][1]) + (b[j][2] * b[j][2] + b[j][3] * b[j][3]); }
    const float ra = 1.0f / sqrtf(wave_sum(sa) * (1.f / DM) + RMS_EPS), rb = 1.0f / sqrtf(wave_sum(sb) * (1.f / DM) + RMS_EPS);
    u32x2* oa = (u32x2*)orow0 + lane; u32x2* ob = (u32x2*)orow1 + lane;
#pragma unroll
    for (int j = 0; j < 4; ++j) { const f32x4 gg = gr[64 * j];
        u32x2 o; o.x = pk2(a[j][0] * ra * gg[0], a[j][1] * ra * gg[1]); o.y = pk2(a[j][2] * ra * gg[2], a[j][3] * ra * gg[3]); oa[64 * j] = o;
        u32x2 q; q.x = pk2(b[j][0] * rb * gg[0], b[j][1] * rb * gg[1]); q.y = pk2(b[j][2] * rb * gg[2], b[j][3] * rb * gg[3]); ob[64 * j] = q; }
}
__device__ __forceinline__ void p0_i8_rows(const float* src, const float* gain, unsigned char* dst, float* inv, int gw, int ngw, int lane) {
    f32x4 gq[4];
#pragma unroll
    for (int j = 0; j < 4; ++j) gq[j] = *(const f32x4*)(gain + 16 * lane + 4 * j);
    for (int row0 = gw; row0 < NEXP; row0 += 2 * ngw) {
        f32x4 v[2][4]; float m[2];
#pragma unroll
        for (int q = 0; q < 2; ++q) { const f32x4* sp = (const f32x4*)(src + (size_t)(row0 + q * ngw) * DM + 16 * lane);
#pragma unroll
            for (int j = 0; j < 4; ++j) v[q][j] = sp[j] * gq[j]; }
#pragma unroll
        for (int q = 0; q < 2; ++q) { float mm = 0.f;
#pragma unroll
            for (int j = 0; j < 4; ++j) mm = fmaxf(mm, fmaxf(fmaxf(fabsf(v[q][j][0]), fabsf(v[q][j][1])), fmaxf(fabsf(v[q][j][2]), fabsf(v[q][j][3]))));
#pragma unroll
            for (int o = 1; o < 64; o <<= 1) mm = fmaxf(mm, __shfl_xor(mm, o));
            m[q] = mm; }
#pragma unroll
        for (int q = 0; q < 2; ++q) { const int row = row0 + q * ngw; const float sc = m[q] > 0.f ? 127.f / m[q] : 1.f;
            u32x4 o;
#pragma unroll
            for (int j = 0; j < 4; ++j) { const int b0 = (int)rintf(v[q][j][0] * sc), b1 = (int)rintf(v[q][j][1] * sc), b2 = (int)rintf(v[q][j][2] * sc), b3 = (int)rintf(v[q][j][3] * sc);
                o[j] = ((unsigned)b0 & 255u) | (((unsigned)b1 & 255u) << 8) | (((unsigned)b2 & 255u) << 16) | (((unsigned)b3 & 255u) << 24); }
            *(u32x4*)(dst + (size_t)row * DM + 16 * lane) = o;
            if (lane == 0) inv[row] = m[q] > 0.f ? m[q] * (1.0f / 127.f) : 1.f; }
    }
}
__device__ __forceinline__ void p0_prologue(const Params& P, LAS unsigned char* lds, int wave, int lane) {
    LAS float* scr = (LAS float*)(lds + wave * 16384);
    const int gw = blockIdx.x * 8 + wave, ngw = gridDim.x * 8;
    constexpr int I_IN = (DM / 64) * (NIN / 32), I_OUT = (DM / 64) * (DM / 32), I_WQ = (DM / 64) * (NQ / 32), NIT = I_IN + I_OUT + I_WQ;
    bf16* WinT = (bf16*)(P.ws + WS_WIN); bf16* WoutT = (bf16*)(P.ws + WS_WOUT); bf16* WqT = (bf16*)(P.ws + WS_WQ);
    for (int it = gw; it < NIT; it += ngw) {
        int r = it;
        if (r < I_IN) { p0_transpose_item(P.w_in, DM, NIN, WinT, scr, r, lane); continue; } r -= I_IN;
        if (r < I_OUT) { p0_transpose_item(P.w_out, DM, DM, WoutT, scr, r, lane); continue; } r -= I_OUT;
        p0_transpose_item(P.peer_wq, DM, NQ, WqT, scr, r, lane, P.norm_ffn_g);
    }
    p0_convert(P.peer_subkeys, (bf16*)(P.ws + WS_SK), (size_t)16 * 128 * 128 / 8, gw, ngw, lane);
    p0_i8_rows(P.peer_u, P.norm_ffn_g, P.ws + WS_U, (float*)(P.ws + WS_SU), gw, ngw, lane);
    p0_fp8_rows(P.peer_v, P.ws + WS_V, (float*)(P.ws + WS_SV), gw, ngw, lane);
    bf16* H = (bf16*)(P.ws + WS_H);
    for (int m = gw; m < MTOK; m += 2 * ngw) p0_norm_row2(P.x + (size_t)m * DM, P.x + (size_t)(m + ngw) * DM, P.norm_mix_g, H + (size_t)m * DM, H + (size_t)(m + ngw) * DM, lane);
}
#define MFMA32(a, b, c) __builtin_amdgcn_mfma_f32_32x32x16_bf16((a), (b), (c), 0, 0, 0)
#define MFMA16(a, b, c) __builtin_amdgcn_mfma_f32_16x16x32_bf16((a), (b), (c), 0, 0, 0)
__device__ __forceinline__ float swap_max(float v) { auto rr = __builtin_amdgcn_permlane32_swap(__float_as_uint(v), __float_as_uint(v), false, false); return fmaxf(__uint_as_float(rr[0]), __uint_as_float(rr[1])); }
__device__ __forceinline__ float swap_add(float v) { auto rr = __builtin_amdgcn_permlane32_swap(__float_as_uint(v), __float_as_uint(v), false, false); return __uint_as_float(rr[0]) + __uint_as_float(rr[1]); }
__device__ __forceinline__ bf16x8 pack8(const f32x16& x, int s) {
    u32x4 p; p.x = pk2(x[8 * s], x[8 * s + 1]); p.y = pk2(x[8 * s + 2], x[8 * s + 3]); p.z = pk2(x[8 * s + 4], x[8 * s + 5]); p.w = pk2(x[8 * s + 6], x[8 * s + 7]);
    return __builtin_bit_cast(bf16x8, p);
}
constexpr float ATT_THR = 8.0f;
constexpr float ATT_NEG = -1.0e30f;

constexpr int PR = 272, PT = 320;
constexpr int AT_Q = 0, AT_KV = 256 * PR, AT_KVSZ = 64 * PR + 64 * PT;
static_assert(AT_KV + 2 * AT_KVSZ <= LDS_MAIN, "attention LDS");
__device__ __forceinline__ void attn_unit(const bf16* PROJ, bf16* Y, const float* subln_g, float lam, int b, int h, int qb, LAS unsigned char* lds) {
    int tid = threadIdx.x; asm volatile("" : "+v"(tid));
    const int lane = tid & 63, r32 = lane & 31, hi = lane >> 5;
    const int w = __builtin_amdgcn_readfirstlane(tid >> 6);
    const size_t rowbase = (size_t)b * SEQ;
    const float slope2 = exp2f(-2.f * (float)(h + 1)) * LOG2E;
    const int srow = tid >> 4, sch = tid & 15;
    const char* gbase = (const char*)(PROJ + rowbase * NIN + h * 128);
    const unsigned soff = (unsigned)(srow * NIN + sch * 8) * 2u;
    {   const char* qb_ = gbase + ((size_t)qb * 256 * NIN + C_DQ) * 2;
#pragma unroll
        for (int i = 0; i < 8; ++i) { const int row = srow + 32 * i; const u32x4 v = *(const u32x4*)(qb_ + (soff + (unsigned)(32 * i * NIN * 2))); *(LAS u32x4*)(lds + AT_Q + row * PR + sch * 16) = v; } }
    u32x4 sk[2], sv[2];
#define A_LOAD(j) do { const char* kb_ = gbase + ((size_t)(64 * (j)) * NIN + C_DK) * 2; const char* vb_ = gbase + ((size_t)(64 * (j)) * NIN + C_DV) * 2; \
        _Pragma("unroll") for (int i_ = 0; i_ < 2; ++i_) { sk[i_] = *(const u32x4*)(kb_ + (soff + (unsigned)(32 * i_ * NIN * 2))); sv[i_] = *(const u32x4*)(vb_ + (soff + (unsigned)(32 * i_ * NIN * 2))); } } while (0)
#define A_STORE(buf) do { _Pragma("unroll") for (int i_ = 0; i_ < 2; ++i_) { \
        *(LAS u32x4*)(lds + AT_KV + (buf) * AT_KVSZ + (srow + 32 * i_) * PR + sch * 16) = sk[i_]; *(LAS u32x4*)(lds + AT_KV + (buf) * AT_KVSZ + 64 * PR + (srow + 32 * i_) * PT + sch * 16) = sv[i_]; } } while (0)
    const int nt = 4 * qb + 4, jd = 4 * qb + (w >> 1);
    const int qpos = qb * 256 + 32 * w + r32;
    unsigned qbase = AT_Q + (32 * w + r32) * PR + hi * 16, kbase = r32 * PR + hi * 16;
    unsigned vbase = 64 * PR + (4 * hi + ((lane & 15) >> 2)) * PT + ((lane >> 4) & 1) * 32 + (lane & 3) * 8;
    f32x16 O1[4], O2[4];
#pragma unroll
    for (int c = 0; c < 4; ++c)
#pragma unroll
        for (int r = 0; r < 16; ++r) { O1[c][r] = 0.f; O2[c][r] = 0.f; }
    float mref[2] = {0.f, 0.f}, lsum[2] = {0.f, 0.f};
    bool started = false;
    A_LOAD(nt - 1); A_STORE(0); if (nt > 1) A_LOAD(nt - 2);
    __syncthreads();
    for (int it = 0; it < nt; ++it) {
        const int j = nt - 1 - it, cur = it & 1;
        asm volatile("" : "+v"(qbase), "+v"(kbase), "+v"(vbase));
        if (it + 1 < nt) A_STORE(cur ^ 1);
        if (it + 2 < nt) A_LOAD(j - 2);
        if (j <= jd) {
            const unsigned kvo = AT_KV + cur * AT_KVSZ;
            for (int kb = 1; kb >= 0; --kb) {
                const bool diag = (j == jd);
                if (diag && kb > (w & 1)) continue;
                const bool domask = diag && kb == (w & 1);
                bf16x8 Pb[2][2];
#pragma unroll
                for (int p = 0; p < 2; ++p) {
                    f32x16 S;
                    const float tb = slope2 * (float)(64 * j + 32 * kb - qpos + 4 * hi) - mref[p];
#pragma unroll
                    for (int r = 0; r < 16; ++r) S[r] = tb + slope2 * (float)((r & 3) + 8 * (r >> 2));
#pragma unroll
                    for (int ks = 0; ks < 4; ++ks) {
                        const bf16x8 qf = *(const LAS bf16x8*)(lds + qbase + (8 * p + 2 * ks) * 16);
                        const bf16x8 kf = *(const LAS bf16x8*)(lds + (kbase + kvo + kb * (32 * PR)) + (8 * p + 2 * ks) * 16);
                        S = MFMA32(kf, qf, S);
                    }
                    if (domask) {
#pragma unroll
                        for (int r = 0; r < 16; ++r) { const int kv = (r & 3) + 8 * (r >> 2) + 4 * hi; if (kv > r32) S[r] = ATT_NEG; } }
                    float rm = fmaxf(S[0], S[1]);
#pragma unroll
                    for (int r = 2; r < 16; ++r) rm = fmaxf(rm, S[r]);
                    rm = swap_max(rm);
                    if (!started) {
                        mref[p] = rm;
#pragma unroll
                        for (int r = 0; r < 16; ++r) S[r] -= rm;
                    } else if (__any(rm > ATT_THR)) {
                        const float dl = fmaxf(rm, 0.f); mref[p] += dl;
#pragma unroll
                        for (int r = 0; r < 16; ++r) S[r] -= dl;
                        const float f = exp2f(-dl); lsum[p] *= f;
                        if (p == 0) {
#pragma unroll
                            for (int c = 0; c < 4; ++c) O1[c] = O1[c] * f;
                        } else {
#pragma unroll
                            for (int c = 0; c < 4; ++c) O2[c] = O2[c] * f;
                        }
                    }
                    float ls = 0.f;
#pragma unroll
                    for (int r = 0; r < 16; ++r) { S[r] = __builtin_amdgcn_exp2f(S[r]); ls += S[r]; }
                    lsum[p] += ls;
                    Pb[p][0] = pack8(S, 0); Pb[p][1] = pack8(S, 1);
                }
                started = true;
#pragma unroll
                for (int c = 0; c < 4; ++c)
#pragma unroll
                    for (int ss = 0; ss < 2; ++ss) {
                        const LAS char* vp = (const LAS char*)lds + (vbase + kvo + kb * (32 * PT));
                        const bf16x8 vf = cat8(lds_tr(vp + ((16 * ss) * PT + c * 64)), lds_tr(vp + ((16 * ss + 8) * PT + c * 64)));
                        O1[c] = MFMA32(vf, Pb[0][ss], O1[c]); O2[c] = MFMA32(vf, Pb[1][ss], O2[c]);
                    }
            }
        }
        __syncthreads();
    }
#undef A_LOAD
#undef A_STORE
    const float inv1 = 1.0f / swap_add(lsum[0]), inv2 = lam / swap_add(lsum[1]);
    float ss = 0.f;
#pragma unroll
    for (int c = 0; c < 4; ++c)
#pragma unroll
        for (int r = 0; r < 16; ++r) { const float o = O1[c][r] * inv1 - O2[c][r] * inv2; O1[c][r] = o; ss += o * o; }
    ss = swap_add(ss);
    const float rstd = (1.0f / sqrtf(ss * (1.0f / 128.f) + RMS_EPS)) * 0.8f;
    bf16* yrow = Y + (rowbase + qpos) * DM + 512 + h * 128;
#pragma unroll
    for (int c = 0; c < 4; ++c)
#pragma unroll
        for (int g4 = 0; g4 < 4; ++g4) { const int dv0 = 32 * c + 8 * g4 + 4 * hi; const f32x4 gg = *(const f32x4*)(subln_g + dv0);
            u32x2 o; o.x = pk2(O1[c][4 * g4] * rstd * gg[0], O1[c][4 * g4 + 1] * rstd * gg[1]); o.y = pk2(O1[c][4 * g4 + 2] * rstd * gg[2], O1[c][4 * g4 + 3] * rstd * gg[3]);
            *(u32x2*)(yrow + dv0) = o; }
}

constexpr int RT_P = 0, RT_K = 128 * PR, RT_V = 2 * 128 * PR, RT_ST = 2 * 128 * PR + 128 * PT;
static_assert(RT_ST + 128 * PR <= LDS_MAIN, "retention LDS");
__device__ __forceinline__ u32x4 scale8(u32x4 v, float f) { u32x4 o; o.x = pk2(bf_lo(v.x) * f, bf_hi(v.x) * f); o.y = pk2(bf_lo(v.y) * f, bf_hi(v.y) * f); o.z = pk2(bf_lo(v.z) * f, bf_hi(v.z) * f); o.w = pk2(bf_lo(v.w) * f, bf_hi(v.w) * f); return o; }
__device__ __forceinline__ void ret_unit(const bf16* PROJ, bf16* Y, int b, int h, LAS unsigned char* lds) {
    int tid = threadIdx.x; asm volatile("" : "+v"(tid));
    const int lane = tid & 63, l15 = lane & 15, g = lane >> 4;
    const int w = __builtin_amdgcn_readfirstlane(tid >> 6);
    const size_t rowbase = (size_t)b * SEQ;
    const float gam = 1.0f - exp2f(-5.f - (float)h), lg = log2f(gam), cdec = exp2f(128.f * lg), g127 = exp2f(127.f * lg);
    const int srow = tid >> 4, sch = tid & 15;
    const char* gbase = (const char*)(PROJ + rowbase * NIN + h * 128);
    const unsigned soff = (unsigned)(srow * NIN + sch * 8) * 2u;
    const unsigned qoff = (unsigned)((16 * w + l15) * NIN + C_RQ + 8 * g) * 2u;
    const unsigned toff = (unsigned)((16 * w + l15) * NIN + C_RG + 4 * g) * 2u;
    const float qscale = exp2f(lg * (float)(16 * w + l15));
    u32x4 sk[4], sv[4];
#define R_LOAD(n) do { const char* kb_ = gbase + ((size_t)(128 * (n)) * NIN + C_RK) * 2; const char* vb_ = gbase + ((size_t)(128 * (n)) * NIN + C_RV) * 2; \
        _Pragma("unroll") for (int i_ = 0; i_ < 4; ++i_) { sk[i_] = *(const u32x4*)(kb_ + (soff + (unsigned)(32 * i_ * NIN * 2))); sv[i_] = *(const u32x4*)(vb_ + (soff + (unsigned)(32 * i_ * NIN * 2))); } } while (0)
#define R_STORE() do { _Pragma("unroll") for (int i_ = 0; i_ < 4; ++i_) { const int row_ = srow + 32 * i_; \
        *(LAS u32x4*)(lds + RT_K + row_ * PR + sch * 16) = scale8(sk[i_], exp2f(-lg * (float)row_)); *(LAS u32x4*)(lds + RT_V + row_ * PT + sch * 16) = sv[i_]; } } while (0)
#define Q_LOAD(n) do { const char* qb_ = gbase + (size_t)(128 * (n)) * NIN * 2; _Pragma("unroll") for (int s_ = 0; s_ < 4; ++s_) qraw[s_] = *(const u32x4*)(qb_ + (qoff + 64u * s_)); } while (0)
    f32x4 Sacc[8];
#pragma unroll
    for (int c = 0; c < 8; ++c) Sacc[c] = (f32x4){0.f, 0.f, 0.f, 0.f};
    for (int i = tid; i < 128 * PR / 16; i += 512) *(LAS u32x4*)(lds + RT_ST + i * 16) = (u32x4){0u, 0u, 0u, 0u};
    u32x4 qraw[4];
    R_LOAD(0); Q_LOAD(0); R_STORE();
    __syncthreads();
    const int tq = (lane & 15) >> 2, tp = lane & 3;
    unsigned b_k = RT_K + l15 * PR + g * 16;
    unsigned b_p = RT_P + (16 * w + l15) * PR + g * 16;
    unsigned b_pw = RT_P + (16 * w + l15) * PR + g * 8;
    unsigned b_kt = RT_K + (8 * g + tq) * PR + tp * 8 + w * 32;
    unsigned b_vt = RT_V + (8 * g + tq) * PT + tp * 8;
    unsigned b_st = RT_ST + l15 * PR + g * 16;
    unsigned b_sw = RT_ST + l15 * PR + (16 * w + 4 * g) * 2;
    for (int n = 0; n < SEQ / 128; ++n) {
        asm volatile("" : "+v"(b_k), "+v"(b_p), "+v"(b_pw), "+v"(b_kt), "+v"(b_vt), "+v"(b_st), "+v"(b_sw));
        bf16x8 Qf[4], Pf[4], KTf[4];
#pragma unroll
        for (int s = 0; s < 4; ++s) Qf[s] = __builtin_bit_cast(bf16x8, scale8(qraw[s], qscale));
#pragma unroll
        for (int jb = 0; jb < 8; ++jb) {
            f32x4 a = (f32x4){0.f, 0.f, 0.f, 0.f};
#pragma unroll
            for (int s = 0; s < 4; ++s) { const bf16x8 kf = *(const LAS bf16x8*)(lds + (b_k + jb * (16 * PR) + s * 64)); a = MFMA16(kf, Qf[s], a); }
            const int ii = 16 * w + l15, jj = 16 * jb + 4 * g;
            u32x2 pw; pw.x = pk2(jj <= ii ? a[0] : 0.f, jj + 1 <= ii ? a[1] : 0.f); pw.y = pk2(jj + 2 <= ii ? a[2] : 0.f, jj + 3 <= ii ? a[3] : 0.f);
            *(LAS u32x2*)(lds + (b_pw + jb * 32)) = pw;
        }
#pragma unroll
        for (int s = 0; s < 4; ++s) { Pf[s] = *(const LAS bf16x8*)(lds + (b_p + s * 64));
            KTf[s] = cat8(lds_tr((const LAS char*)lds + (b_kt + (32 * s) * PR)), lds_tr((const LAS char*)lds + (b_kt + (32 * s + 4) * PR))); }
        f32x4 OT[8];
#pragma unroll
        for (int c = 0; c < 8; ++c) {
            f32x4 o = (f32x4){0.f, 0.f, 0.f, 0.f}, t4 = (f32x4){0.f, 0.f, 0.f, 0.f};
#pragma unroll
            for (int s = 0; s < 4; ++s) {
                const bf16x8 vf = cat8(lds_tr((const LAS char*)lds + (b_vt + (32 * s) * PT + c * 32)), lds_tr((const LAS char*)lds + (b_vt + (32 * s + 4) * PT + c * 32)));
                const bf16x8 stf = *(const LAS bf16x8*)(lds + (b_st + c * (16 * PR) + s * 64));
                o = MFMA16(stf, Qf[s], o); o = MFMA16(vf, Pf[s], o); t4 = MFMA16(KTf[s], vf, t4);
            }
            OT[c] = o; Sacc[c] = Sacc[c] * cdec + t4 * g127;
            __builtin_amdgcn_sched_barrier(0);
        }
        if (n + 1 < SEQ / 128) { Q_LOAD(n + 1); R_LOAD(n + 1); }
        float ss = 0.f;
#pragma unroll
        for (int c = 0; c < 8; ++c) ss += (OT[c][0] * OT[c][0] + OT[c][1] * OT[c][1]) + (OT[c][2] * OT[c][2] + OT[c][3] * OT[c][3]);
        ss += __shfl_xor(ss, 16); ss += __shfl_xor(ss, 32);
        const float rstd = __builtin_amdgcn_rsqf(ss * (1.0f / 128.f) + RMS_EPS);
        const char* rgb = gbase + (size_t)(128 * n) * NIN * 2;
        char* yb = (char*)(Y + (rowbase + (size_t)n * 128) * DM + h * 128); const unsigned yoff = (unsigned)((16 * w + l15) * DM + 4 * g) * 2u;
#pragma unroll
        for (int c = 0; c < 8; ++c) { const u32x2 rg = *(const u32x2*)(rgb + (toff + 32u * c));
            const float r0 = bf_lo(rg.x), r1 = bf_hi(rg.x), r2 = bf_lo(rg.y), r3 = bf_hi(rg.y);
            const float s0 = r0 * __builtin_amdgcn_rcpf(1.f + __expf(-r0)), s1 = r1 * __builtin_amdgcn_rcpf(1.f + __expf(-r1)), s2 = r2 * __builtin_amdgcn_rcpf(1.f + __expf(-r2)), s3 = r3 * __builtin_amdgcn_rcpf(1.f + __expf(-r3));
            u32x2 o; o.x = pk2(OT[c][0] * rstd * s0, OT[c][1] * rstd * s1); o.y = pk2(OT[c][2] * rstd * s2, OT[c][3] * rstd * s3);
            *(u32x2*)(yb + (yoff + 32u * c)) = o; }
        __syncthreads();
#pragma unroll
        for (int c = 0; c < 8; ++c) { u32x2 o; o.x = pk2(Sacc[c][0] * gam, Sacc[c][1] * gam); o.y = pk2(Sacc[c][2] * gam, Sacc[c][3] * gam);
            *(LAS u32x2*)(lds + (b_sw + c * (16 * PR))) = o; }
        if (n + 1 < SEQ / 128) R_STORE();
        __syncthreads();
    }
#undef R_LOAD
#undef R_STORE
#undef Q_LOAD
}

constexpr int P2_NRET = BATCH * 4, P2_NATT = BATCH * 4 * 8, P2_NITEMS = P2_NRET + P2_NATT;
__device__ __forceinline__ void p2_mixers(const Params& P, LAS unsigned char* lds) {
    const int tid = threadIdx.x;
    unsigned* ctl = (unsigned*)(P.ws + WS_CTL);
    volatile LAS int* lctl = (volatile LAS int*)(lds + LDS_MAIN);
    const bf16* PROJ = (const bf16*)(P.ws + WS_PROJ); bf16* Y = (bf16*)(P.ws + WS_H);
    float d1 = 0.f, d2 = 0.f;
    for (int i = 0; i < 64; ++i) { d1 += P.diff_lambda[i] * P.diff_lambda[64 + i]; d2 += P.diff_lambda[128 + i] * P.diff_lambda[192 + i]; }
    const float lam = expf(d1) - expf(d2) + 0.2f;
    for (;;) {
        if (tid == 0) lctl[0] = (int)atomicAdd(ctl + CW_QUEUE, 1u);
        __syncthreads();
        const int item = __builtin_amdgcn_readfirstlane(lctl[0]);
        __syncthreads();
        if (item >= P2_NITEMS) break;
        if (item < P2_NRET) ret_unit(PROJ, Y, item >> 2, item & 3, lds);
        else { const int idx = item - P2_NRET; attn_unit(PROJ, Y, P.diff_subln_g, lam, (idx & 63) >> 2, idx & 3, 7 - (idx >> 6), lds); }
    }
}
#define XB_TMO      128
#define XB_XCNT(j)  (256  + 64 * (j))
#define XB_XSUB(j)  (1280 + 64 * (j))
#define XB_XGEN(j)  (2304 + 64 * (j))
#define XB_TOP      3328
#define XB_TOPGEN   3392
#define XCD_BAR_WORDS 3456
#define XB_SPIN_CAP (1u << 18)

__device__ __forceinline__ unsigned xb_ld(unsigned* p)              { return __hip_atomic_load(p, __ATOMIC_RELAXED, __HIP_MEMORY_SCOPE_AGENT); }
__device__ __forceinline__ unsigned xb_add(unsigned* p, unsigned v) { return __hip_atomic_fetch_add(p, v, __ATOMIC_RELAXED, __HIP_MEMORY_SCOPE_AGENT); }
__device__ __forceinline__ unsigned xb_xcc_id() { return (unsigned)__builtin_amdgcn_s_getreg((3 << 11) | 20) & 0xFu; }
#define XB_SPIN(cond, bar) do { unsigned _sp = 0; while (cond) { __builtin_amdgcn_s_sleep(1); \
    if ((++_sp & 255u) == 0u) { if (xb_ld(&(bar)[XB_TMO])) break; if (_sp > XB_SPIN_CAP) { atomicAdd(&(bar)[XB_TMO], 1u); break; } } } } while (0)

struct XcdBarrier {
    unsigned* bar; unsigned x;
    volatile LAS unsigned* st;
};

__device__ __forceinline__ XcdBarrier xcd_barrier_post(unsigned* bar, volatile LAS unsigned* st) {
    XcdBarrier b; b.bar = bar; b.x = xb_xcc_id(); b.st = st;
    if (threadIdx.x == 0) (void)xb_add(&bar[XB_XCNT(b.x)], 1u);
    return b;
}
__device__ __forceinline__ void xcd_barrier_complete(unsigned* bar, unsigned x, unsigned& nloc, unsigned& nx) {
    const unsigned G = gridDim.x * gridDim.y * gridDim.z;
    unsigned sum, cnt, mine, sp = 0u;
    for (;;) {
        sum = 0u; cnt = 0u; mine = 0u;
#pragma unroll
        for (unsigned j = 0; j < 16; ++j) { const unsigned c = xb_ld(&bar[XB_XCNT(j)]); sum += c; cnt += (c > 0u) ? 1u : 0u; mine = (j == x) ? c : mine; }
        if (sum == G) break;
        __builtin_amdgcn_s_sleep(1);
        if ((++sp & 255u) == 0u) { if (xb_ld(&bar[XB_TMO])) break; if (sp > XB_SPIN_CAP) { atomicAdd(&bar[XB_TMO], 1u); break; } }
    }
    nloc = mine > 0u ? mine : 1u; nx = cnt > 0u ? cnt : 1u;
}

__device__ __forceinline__ void xcd_barrier(const XcdBarrier& b) {
    asm volatile("s_waitcnt vmcnt(0)" ::: "memory");
    __syncthreads();
    if (threadIdx.x == 0) {
        unsigned* bar = b.bar;
        __builtin_amdgcn_s_waitcnt(0);
        unsigned nloc = b.st[0], nx = b.st[1];
        if (nloc == 0u) { xcd_barrier_complete(bar, b.x, nloc, nx); b.st[0] = nloc; b.st[1] = nx; }
        const unsigned old = xb_add(&bar[XB_XSUB(b.x)], 1u);
        const unsigned gen = old / nloc;
        if (old + 1u == (gen + 1u) * nloc) {
            __builtin_amdgcn_fence(__ATOMIC_RELEASE, "agent");
            asm volatile("s_waitcnt vmcnt(0)" ::: "memory");
            const unsigned og = xb_add(&bar[XB_TOP], 1u);
            const unsigned tg = og / nx;
            if (og + 1u == (tg + 1u) * nx) xb_add(&bar[XB_TOPGEN], 1u);
            else XB_SPIN(xb_ld(&bar[XB_TOPGEN]) == tg, bar);
            __builtin_amdgcn_fence(__ATOMIC_ACQUIRE, "agent");
            xb_add(&bar[XB_XGEN(b.x)], 1u);
            asm volatile("s_waitcnt vmcnt(0)" ::: "memory");
        } else {
            XB_SPIN(xb_ld(&bar[XB_XGEN(b.x)]) == gen, bar);
            __builtin_amdgcn_fence(__ATOMIC_ACQUIRE, "agent");
            asm volatile("s_waitcnt vmcnt(0)" ::: "memory");
        }
    }
    __syncthreads();
}
__device__ __forceinline__ int ord_key(float s) { const int b = __float_as_int(s); return b ^ ((b >> 31) & 0x7fffffff); }
__device__ __forceinline__ float ord_val(int k) { return __int_as_float(k ^ ((k >> 31) & 0x7fffffff)); }
__device__ __forceinline__ int med3i(int a, int b, int c) { int r; asm("v_med3_i32 %0, %1, %2, %3" : "=v"(r) : "v"(a), "v"(b), "v"(c)); return r; }
__device__ __forceinline__ int imax(int a, int b) { return a > b ? a : b; }
__device__ __forceinline__ int imin(int a, int b) { return a < b ? a : b; }
#define INS16(L, x) do { const int x_ = (x); _Pragma("unroll") for (int i_ = 15; i_ >= 1; --i_) L[i_] = med3i(L[i_ - 1], L[i_], x_); L[0] = imax(L[0], x_); } while (0)
__device__ __forceinline__ void merge_halves16(int (&L)[16]) {
    int c[16];
#pragma unroll
    for (int i = 0; i < 8; ++i) {
        auto r0 = __builtin_amdgcn_permlane32_swap((unsigned)L[i], (unsigned)L[15 - i], false, false);
        auto r1 = __builtin_amdgcn_permlane32_swap((unsigned)L[15 - i], (unsigned)L[i], false, false);
        const bool hi = (threadIdx.x & 32) != 0;
        const int pa_i = hi ? (int)r1[0] : (int)r0[1], pa_15i = hi ? (int)r0[0] : (int)r1[1];
        c[i] = imax(L[i], pa_15i); c[15 - i] = imax(L[15 - i], pa_i);
    }
#define BSTAGE(d) _Pragma("unroll") for (int i = 0; i < 16; ++i) if ((i & (d)) == 0) { const int a = c[i], b = c[i + (d)]; c[i] = imax(a, b); c[i + (d)] = imin(a, b); }
    BSTAGE(8) BSTAGE(4) BSTAGE(2) BSTAGE(1)
#undef BSTAGE
#pragma unroll
    for (int i = 0; i < 16; ++i) L[i] = c[i];
}
__device__ __forceinline__ float dpp_add(float v, const int ctrl_sel) {
    int m;
    if (ctrl_sel == 0) m = __builtin_amdgcn_update_dpp(0, __float_as_int(v), 0xB1, 0xf, 0xf, false);
    else if (ctrl_sel == 1) m = __builtin_amdgcn_update_dpp(0, __float_as_int(v), 0x4E, 0xf, 0xf, false);
    else if (ctrl_sel == 2) m = __builtin_amdgcn_update_dpp(0, __float_as_int(v), 0x141, 0xf, 0xf, false);
    else m = __builtin_amdgcn_update_dpp(0, __float_as_int(v), 0x128, 0xf, 0xf, false);
    return v + __int_as_float(m);
}
__device__ __forceinline__ float dot2bf(unsigned a, unsigned b, float acc) {
    typedef __bf16 bf2 __attribute__((ext_vector_type(2)));
    return __builtin_amdgcn_fdot2_f32_bf16(__builtin_bit_cast(bf2, a), __builtin_bit_cast(bf2, b), acc, false);
}
__device__ __forceinline__ float dot8(u32x4 a, u32x4 b, float acc) {
    const unsigned a0 = a.x, a1 = a.y, a2 = a.z, a3 = a.w, b0 = b.x, b1 = b.y, b2 = b.z, b3 = b.w;
    acc = dot2bf(a0, b0, acc); acc = dot2bf(a1, b1, acc); acc = dot2bf(a2, b2, acc); acc = dot2bf(a3, b3, acc);
    return acc;
}
#define AXPY8(accp, wk, v) do { (accp)[0] += (wk) * bf_lo((v).x); (accp)[1] += (wk) * bf_hi((v).x); (accp)[2] += (wk) * bf_lo((v).y); (accp)[3] += (wk) * bf_hi((v).y); \
        (accp)[4] += (wk) * bf_lo((v).z); (accp)[5] += (wk) * bf_hi((v).z); (accp)[6] += (wk) * bf_lo((v).w); (accp)[7] += (wk) * bf_hi((v).w); } while (0)


__device__ __forceinline__ void p5_scores(const Params& P, LAS unsigned char* lds) {
    int tid = threadIdx.x; asm volatile("" : "+v"(tid));
    const int lane = tid & 63, r32 = lane & 31, hi = lane >> 5;
    const int w = __builtin_amdgcn_readfirstlane(tid >> 6), tg = w >> 1, ph = w & 1;
    const int tok0 = blockIdx.x * 128;
    const bf16* SKb = (const bf16*)(P.ws + WS_SK); const bf16* Qb = (const bf16*)(P.ws + WS_Q);
    u32x2* ENT = (u32x2*)(P.ws + WS_H);
    LAS int* lists = (LAS int*)(lds + 131072);
    u32x4 st[8];
#define S_LOAD(h) do { _Pragma("unroll") for (int i_ = 0; i_ < 8; ++i_) { const int n_ = tid + 512 * i_; st[i_] = *(const u32x4*)(SKb + ((size_t)(h) * 256 + (n_ >> 4)) * 128 + (n_ & 15) * 8); } } while (0)
#define S_STORE(buf) do { _Pragma("unroll") for (int i_ = 0; i_ < 8; ++i_) { const int n_ = tid + 512 * i_; *(LAS u32x4*)(lds + (buf) * 65536 + (n_ >> 11) * 32768 + off_b((n_ >> 4) & 127, n_ & 15)) = st[i_]; } } while (0)
    S_LOAD(0); S_STORE(0); S_LOAD(1);
    __syncthreads();
    for (int h = 0; h < 8; ++h) {
        const int cur = h & 1;
        int L[16];
        {
            const bf16* qrow = Qb + (size_t)(tok0 + 32 * tg + r32) * NQ + (h * 2 + ph) * 128 + 8 * hi;
            bf16x8 qf[8];
#pragma unroll
            for (int ks = 0; ks < 8; ++ks) qf[ks] = *(const bf16x8*)(qrow + 16 * ks);
            f32x16 acc[4];
#pragma unroll
            for (int kb = 0; kb < 4; ++kb)
#pragma unroll
                for (int r = 0; r < 16; ++r) acc[kb][r] = 0.f;
            const LAS unsigned char* SKl = lds + cur * 65536 + ph * 32768;
#pragma unroll
            for (int ks = 0; ks < 8; ++ks)
#pragma unroll
                for (int kb = 0; kb < 4; ++kb) { const bf16x8 a = *(const LAS bf16x8*)(SKl + off_b(32 * kb + r32, 2 * ks + hi)); acc[kb] = MFMA32(a, qf[ks], acc[kb]); }
#pragma unroll
            for (int i = 0; i < 16; ++i) L[i] = (int)0x80000000;
#pragma unroll
            for (int kb = 0; kb < 4; ++kb)
#pragma unroll
                for (int r = 0; r < 16; ++r) { const int key = 32 * kb + (r & 3) + 8 * (r >> 2) + 4 * hi; const int x = (ord_key(acc[kb][r]) & ~127) | key; INS16(L, x); }
        }
        merge_halves16(L);
        if (hi == 0) { LAS int* lp = lists + ((tg * 2 + ph) * 32 + r32) * 16;
#pragma unroll
            for (int i = 0; i < 4; ++i) *(LAS u32x4*)(lp + 4 * i) = (u32x4){(unsigned)L[4 * i], (unsigned)L[4 * i + 1], (unsigned)L[4 * i + 2], (unsigned)L[4 * i + 3]}; }
        if (h + 1 < 8) { S_STORE(cur ^ 1); if (h + 2 < 8) S_LOAD(h + 2); }
        __syncthreads();
        if (ph == 0) {
            const LAS int* la = lists + ((tg * 2 + 0) * 32 + r32) * 16; const LAS int* lb = lists + ((tg * 2 + 1) * 32 + r32) * 16;
            float A[16], B[16];
            {   int bl[16];
#pragma unroll
                for (int i = 0; i < 4; ++i) { const u32x4 v = *(const LAS u32x4*)(lb + 4 * i); bl[4 * i] = (int)v.x; bl[4 * i + 1] = (int)v.y; bl[4 * i + 2] = (int)v.z; bl[4 * i + 3] = (int)v.w; }
#pragma unroll
                for (int i = 0; i < 16; ++i) { const float av = ord_val(L[i] & ~127), bv = ord_val(bl[i] & ~127); A[i] = hi ? bv : av; B[i] = hi ? av : bv; } }
            int C[16];
#pragma unroll
            for (int i = 0; i < 16; ++i) C[i] = (int)0x80000000;
#define CAND(i, j) do { const float v_ = A[i] + B[j]; const int code_ = hi ? ((j) * 16 + (i)) : ((i) * 16 + (j)); const int x2_ = (ord_key(v_) & ~255) | code_; INS16(C, x2_); } while (0)
#pragma unroll
            for (int j = 1; j < 16; ++j) CAND(0, j);
#pragma unroll
            for (int j = 2; j < 8; ++j) CAND(1, j);
            CAND(2, 3); CAND(2, 4);
            {
                const float v0 = hi ? (A[2] + B[2]) : (A[0] + B[0]), v1 = hi ? (A[3] + B[3]) : (A[1] + B[1]);
                const int x0 = (ord_key(v0) & ~255) | (hi ? 0x22 : 0x00), x1 = (ord_key(v1) & ~255) | (hi ? 0x33 : 0x11);
                INS16(C, x0); INS16(C, x1); }
#undef CAND
            merge_halves16(C);
            float gsum = 0.f, e[16];
            const float vmax = ord_val(C[0] & ~255);
#pragma unroll
            for (int i = 0; i < 16; ++i) { e[i] = __expf(ord_val(C[i] & ~255) - vmax); gsum += e[i]; }
            const float ginv = 1.0f / gsum;
            u32x2* ep = ENT + (size_t)(tok0 + 32 * tg + r32) * 128 + h * 16 + hi * 8;
            int Cs[8]; float Gs[8];
#pragma unroll
            for (int i = 0; i < 8; ++i) { int c0 = C[i], c1 = C[i + 8]; float e0 = e[i], e1 = e[i + 8]; asm volatile("" : "+v"(c0), "+v"(c1), "+v"(e0), "+v"(e1)); Cs[i] = hi ? c1 : c0; Gs[i] = (hi ? e1 : e0) * ginv; }
#pragma unroll
            for (int i = 0; i < 8; i += 2) {
                u32x4 o;
                { const int code = Cs[i] & 255; const int i1 = la[code >> 4] & 127, i2 = lb[code & 15] & 127; o.x = (unsigned)(i1 * 128 + i2); o.y = __float_as_uint(Gs[i]); }
                { const int code = Cs[i + 1] & 255; const int i1 = la[code >> 4] & 127, i2 = lb[code & 15] & 127; o.z = (unsigned)(i1 * 128 + i2); o.w = __float_as_uint(Gs[i + 1]); }
                *(u32x4*)(ep + i) = o;
            }
        }
        __syncthreads();
    }
#undef S_LOAD
#undef S_STORE
}
__device__ __forceinline__ void fp8x16_to_f32(u32x4 v, float (&f)[16]) {
#pragma unroll
    for (int j = 0; j < 4; ++j) { const int wv_ = (int)v[j]; const f32x2 lo = __builtin_amdgcn_cvt_pk_f32_fp8(wv_, false), hi = __builtin_amdgcn_cvt_pk_f32_fp8(wv_, true);
        f[4 * j] = lo.x; f[4 * j + 1] = lo.y; f[4 * j + 2] = hi.x; f[4 * j + 3] = hi.y; }
}
constexpr int CW_PACE = 65536;
__device__ __forceinline__ void xcc_pace(unsigned* ctl, const XcdBarrier& b, unsigned step) {
    __syncthreads();
    if (threadIdx.x == 0) {
        unsigned* c = ctl + CW_PACE + 64 * b.x; const unsigned nloc = b.st[0];
        if (nloc != 0u) { xb_add(c, 1u); const unsigned want = (step + 1u) * nloc; unsigned sp = 0;
            while (xb_ld(c) < want) { __builtin_amdgcn_s_sleep(1); if (++sp > (1u << 16)) break; } }
    }
    __syncthreads();
}
#define P6_REP(k) (32 * ((k) >> 2) + 16 * (((k) >> 1) & 1) + 8 * ((k) & 1))
__device__ __forceinline__ void p6_gather(const Params& P, LAS unsigned char* lds, const XcdBarrier& xbar) {
    int tid = threadIdx.x; asm volatile("" : "+v"(tid));
    const int lane = tid & 63, l15 = lane & 15;
    const int w = __builtin_amdgcn_readfirstlane(tid >> 6);
    const int tok0 = blockIdx.x * 128;
    const u32x2* ENT = (const u32x2*)(P.ws + WS_H);
    const bf16* XG = (const bf16*)(P.ws + WS_XG); const unsigned char* U8 = P.ws + WS_U; const unsigned char* V8 = P.ws + WS_V;
    const float* SU = (const float*)(P.ws + WS_SU); const float* SV = (const float*)(P.ws + WS_SV);
    const float* RSS = (const float*)(P.ws + WS_RSS);
    const int kk = 4 * (lane >> 5) + 2 * ((lane >> 4) & 1) + ((lane >> 3) & 1);
    const unsigned xsb = (unsigned)w * 8192u + (unsigned)lane * 16u;
    const unsigned ssb = 65536u + (unsigned)w * 4096u;
    const unsigned ska = ssb + (unsigned)kk * 8u;
    const unsigned skv = ssb + (unsigned)l15 * 8u;
    const unsigned wlb = 98304u + (unsigned)w * 2048u;
    const unsigned rowoff = 16u * (unsigned)lane;
    xcd_barrier(xbar);
    unsigned pace_step = 0;
    for (int r = 0; r < 4; ++r) {
        if (r > 0) xcc_pace((unsigned*)(P.ws + WS_CTL), xbar, pace_step++);
        float acc[4][16]; float rstd[4], xscale[4];
#pragma unroll
        for (int t = 0; t < 4; ++t) {
            const size_t tok = (size_t)tok0 + 32 * r + 4 * w + t;
            const u32x4 e4 = ((const u32x4*)ENT)[tok * 64 + lane];
            {
                const u32x4 xa = *(const u32x4*)(XG + tok * DM + 16 * lane), xb = *(const u32x4*)(XG + tok * DM + 16 * lane + 8); float xf[16];
#pragma unroll
                for (int j = 0; j < 4; ++j) { xf[2 * j] = bf_lo(xa[j]); xf[2 * j + 1] = bf_hi(xa[j]); xf[8 + 2 * j] = bf_lo(xb[j]); xf[8 + 2 * j + 1] = bf_hi(xb[j]); }
                float mx = 0.f;
#pragma unroll
                for (int i = 0; i < 16; ++i) mx = fmaxf(mx, fabsf(xf[i]));
                mx = wave_max_fast(mx);
                const float qs = mx > 0.f ? 127.f / mx : 1.f; u32x4 xq;
#pragma unroll
                for (int j = 0; j < 4; ++j) { const int b0 = (int)rintf(xf[4 * j] * qs), b1 = (int)rintf(xf[4 * j + 1] * qs), b2 = (int)rintf(xf[4 * j + 2] * qs), b3 = (int)rintf(xf[4 * j + 3] * qs);
                    xq[j] = ((unsigned)b0 & 255u) | (((unsigned)b1 & 255u) << 8) | (((unsigned)b2 & 255u) << 16) | (((unsigned)b3 & 255u) << 24); }
                *(LAS u32x4*)(lds + xsb + t * 1024) = xq; xscale[t] = mx > 0.f ? mx * (1.0f / 127.f) : 1.f; }
            const f32x4* rp = (const f32x4*)(RSS + tok * 16); const f32x4 s0 = rp[0], s1 = rp[1], s2 = rp[2], s3 = rp[3];
            const float ssq = ((s0[0] + s0[1]) + (s0[2] + s0[3])) + ((s1[0] + s1[1]) + (s1[2] + s1[3])) + ((s2[0] + s2[1]) + (s2[2] + s2[3])) + ((s3[0] + s3[1]) + (s3[2] + s3[3]));
            rstd[t] = (1.0f / sqrtf(ssq * (1.0f / DM) + RMS_EPS)) * xscale[t];
            const unsigned bA = e4.x >> 10, bB = e4.z >> 10; int posA = 0, posB = 0, base = 0;
            for (int s = 0; s < 16; ++s) {
                const unsigned long long mA = __ballot(bA == (unsigned)s), mB = __ballot(bB == (unsigned)s);
                const int cA = __popcll(mA), cB = __popcll(mB);
                const int rA = (int)__builtin_amdgcn_mbcnt_hi((unsigned)(mA >> 32), __builtin_amdgcn_mbcnt_lo((unsigned)mA, 0u));
                const int rB = (int)__builtin_amdgcn_mbcnt_hi((unsigned)(mB >> 32), __builtin_amdgcn_mbcnt_lo((unsigned)mB, 0u));
                if (bA == (unsigned)s) posA = base + rA;
                if (bB == (unsigned)s) posB = base + cA + rB;
                base += cA + cB;
            }
            *(LAS u32x2*)(lds + ssb + t * 1024 + posA * 8) = (u32x2){e4.x, e4.y}; *(LAS u32x2*)(lds + ssb + t * 1024 + posB * 8) = (u32x2){e4.z, e4.w};
#pragma unroll
            for (int i = 0; i < 16; ++i) acc[t][i] = 0.f;
        }
        {   u32x4 ua[8]; u32x2 entN; float suN, svN;
#define PA_PRE(B, T) do { entN = *(const LAS u32x2*)(lds + ska + (T) * 1024 + (B) * 64); suN = SU[entN.x]; svN = SV[entN.x]; \
            _Pragma("unroll") for (int k = 0; k < 8; ++k) { const unsigned ex_ = (unsigned)__builtin_amdgcn_readlane((int)entN.x, P6_REP(k)); ua[k] = *(const u32x4*)(U8 + (ex_ * 1024u + rowoff)); } } while (0)
#define PA_BODY(B, T, NB, NT) do { \
            const u32x2 ent = entN; const float suk = suN, svk = svN; \
            const u32x4 xq = *(const LAS u32x4*)(lds + xsb + (T) * 1024); \
            int d[8]; \
            _Pragma("unroll") for (int k = 0; k < 8; ++k) d[k] = __builtin_amdgcn_sdot4((int)ua[k].x, (int)xq.x, __builtin_amdgcn_sdot4((int)ua[k].y, (int)xq.y, __builtin_amdgcn_sdot4((int)ua[k].z, (int)xq.z, __builtin_amdgcn_sdot4((int)ua[k].w, (int)xq.w, 0, false), false), false), false); \
            asm volatile("" : "+v"(d[0]), "+v"(d[1]), "+v"(d[2]), "+v"(d[3]), "+v"(d[4]), "+v"(d[5]), "+v"(d[6]), "+v"(d[7])); \
            PA_PRE(NB, NT);     \
            int s4[4], t2[2]; \
            _Pragma("unroll") for (int k = 0; k < 4; ++k) { auto rr = __builtin_amdgcn_permlane32_swap((unsigned)d[k], (unsigned)d[k + 4], false, false); s4[k] = (int)rr[0] + (int)rr[1]; } \
            _Pragma("unroll") for (int k = 0; k < 2; ++k) { auto rr = __builtin_amdgcn_permlane16_swap((unsigned)s4[k], (unsigned)s4[k + 2], false, false); t2[k] = (int)rr[0] + (int)rr[1]; } \
            const bool b3 = (lane & 8) != 0; \
            const int keep = b3 ? t2[1] : t2[0], give = b3 ? t2[0] : t2[1]; \
            int di = keep + __builtin_amdgcn_update_dpp(0, give, 0x128, 0xf, 0xf, false); \
            di += __builtin_amdgcn_update_dpp(0, di, 0xB1, 0xf, 0xf, false); di += __builtin_amdgcn_update_dpp(0, di, 0x4E, 0xf, 0xf, false); di += __builtin_amdgcn_update_dpp(0, di, 0x141, 0xf, 0xf, false); \
            const float a = rstd[T] * suk * (float)di; \
            const float wv = __uint_as_float(ent.y) * svk * (0.5f * a * (1.0f + erff(a * 0.70710678118654752f))); \
            if ((lane & 7) == 0) *(LAS float*)(lds + wlb + (T) * 512 + (B) * 32 + kk * 4) = wv; \
            __builtin_amdgcn_sched_barrier(0); \
        } while (0)
            {
            PA_PRE(0, 0);
#pragma unroll 1
            for (int b = 0; b < 16; ++b) {
                PA_BODY(b, 0, b, 1);
                PA_BODY(b, 1, b, 2);
                PA_BODY(b, 2, b, 3);
                PA_BODY(b, 3, (b + 1) & 15, 0);
            }
            }
#undef PA_PRE
#undef PA_BODY
        }
        {   u32x4 va[16]; unsigned evN;
#define PB_ENT(B, T) do { evN = *(const LAS unsigned*)(lds + skv + (T) * 1024 + (B) * 128); } while (0)
#define PB_LDV(k) do { const unsigned ex_ = (unsigned)__builtin_amdgcn_readlane((int)evN, (k)); va[k] = *(const u32x4*)(V8 + (ex_ * 1024u + rowoff)); } while (0)
#define PB_BODY(B, T, NB, NT) do { float (&accT)[16] = acc[T]; \
            const float wvv = *(const LAS float*)(lds + wlb + (T) * 512 + (B) * 64 + l15 * 4);     \
            PB_ENT(NB, NT); \
            _Pragma("unroll") for (int k = 0; k < 16; ++k) { \
                const float wk_ = __int_as_float(__builtin_amdgcn_readlane(__float_as_int(wvv), k)); float vf_[16]; fp8x16_to_f32(va[k], vf_); \
                _Pragma("unroll") for (int i = 0; i < 16; ++i) accT[i] += wk_ * vf_[i]; \
                asm volatile("" : "+v"(accT[0]), "+v"(accT[1]), "+v"(accT[2]), "+v"(accT[3]), "+v"(accT[4]), "+v"(accT[5]), "+v"(accT[6]), "+v"(accT[7]), "+v"(accT[8]), "+v"(accT[9]), "+v"(accT[10]), "+v"(accT[11]), "+v"(accT[12]), "+v"(accT[13]), "+v"(accT[14]), "+v"(accT[15])); \
                PB_LDV(k); } \
        } while (0)
            {
            PB_ENT(0, 0);
#pragma unroll
            for (int k = 0; k < 16; ++k) PB_LDV(k);
#pragma unroll 1
            for (int b = 0; b < 8; ++b) {
                PB_BODY(b, 0, b, 1);
                PB_BODY(b, 1, b, 2);
                PB_BODY(b, 2, b, 3);
                PB_BODY(b, 3, (b + 1) & 7, 0);
            }
            }
#undef PB_ENT
#undef PB_LDV
#undef PB_BODY
        }
#pragma unroll
        for (int t = 0; t < 4; ++t) {
            const size_t tok = (size_t)tok0 + 32 * r + 4 * w + t;
            float* orow = P.out + tok * DM + 16 * lane; const float* fg = P.final_norm_g + 16 * lane;
            const u32x4 ra = *(const u32x4*)(XG + tok * DM + 16 * lane), rb = *(const u32x4*)(XG + tok * DM + 16 * lane + 8);
            f32x4 xr[4]; float ss = 0.f;
            xr[0] = (f32x4){bf_lo(ra.x), bf_hi(ra.x), bf_lo(ra.y), bf_hi(ra.y)}; xr[1] = (f32x4){bf_lo(ra.z), bf_hi(ra.z), bf_lo(ra.w), bf_hi(ra.w)};
            xr[2] = (f32x4){bf_lo(rb.x), bf_hi(rb.x), bf_lo(rb.y), bf_hi(rb.y)}; xr[3] = (f32x4){bf_lo(rb.z), bf_hi(rb.z), bf_lo(rb.w), bf_hi(rb.w)};
#pragma unroll
            for (int j = 0; j < 4; ++j) { xr[j] += (f32x4){acc[t][4 * j], acc[t][4 * j + 1], acc[t][4 * j + 2], acc[t][4 * j + 3]};
                ss += (xr[j][0] * xr[j][0] + xr[j][1] * xr[j][1]) + (xr[j][2] * xr[j][2] + xr[j][3] * xr[j][3]); }
            const float rs = 1.0f / sqrtf(wave_sum_fast(ss) * (1.0f / DM) + RMS_EPS);
#pragma unroll
            for (int j = 0; j < 4; ++j) *(f32x4*)(orow + 4 * j) = xr[j] * rs * *(const f32x4*)(fg + 4 * j);
        }
    }
}
constexpr int CW_BAR = 4096;
constexpr int NPHASE = 6;
__global__ void __launch_bounds__(512, 2) fwd(Params P) {
    __shared__ __attribute__((aligned(16))) unsigned char lds_raw[LDS_BYTES];
    LAS unsigned char* lds = (LAS unsigned char*)lds_raw;
    const int tid = threadIdx.x, lane = tid & 63, wave = __builtin_amdgcn_readfirstlane(tid >> 6);
    const int lo = P.ph_lo, hi = P.ph_hi, G = gridDim.x;
#define IN(k) (lo <= (k) && (k) < hi)
#define SEAM(k) do { if (IN(k) && IN((k) + 1)) { if ((k) == 2) cg::this_grid().sync(); else xcd_barrier(xbar); } } while (0)
    bf16* WinT = (bf16*)(P.ws + WS_WIN); bf16* WoutT = (bf16*)(P.ws + WS_WOUT); bf16* WqT = (bf16*)(P.ws + WS_WQ);
    bf16* Hb = (bf16*)(P.ws + WS_H); bf16* PROJ = (bf16*)(P.ws + WS_PROJ); bf16* XG = (bf16*)(P.ws + WS_XG); bf16* Qb = (bf16*)(P.ws + WS_Q);
    float* RSS = (float*)(P.ws + WS_RSS);
    if (tid < 16) ((volatile LAS unsigned*)(lds + LDS_MAIN))[tid] = 0u;
    __syncthreads();
    XcdBarrier xbar = xcd_barrier_post((unsigned*)(P.ws + WS_CTL) + CW_BAR, (volatile LAS unsigned*)(lds + LDS_MAIN + 32));

    if (IN(0)) { p0_prologue(P, lds, wave, lane); SEAM(0); }
    if (IN(1)) {
        pg8::Gemm g{Hb, WinT, MTOK, NIN, DM}; pg8::StaticOrder S; S.init(MTOK, NIN, G, (int)blockIdx.x);
        pg8::EpiProj E{PROJ};
        pg8::gemm_phase<pg8::EpiProj, pg8::StaticOrder, true, true>(lds, g, S, E);
        SEAM(1);
    }
    if (IN(2)) { p2_mixers(P, lds); SEAM(2); }
    if (IN(3)) {
        pg8::Gemm g{Hb  , WoutT, MTOK, DM, DM}; pg8::StaticOrder S; S.init(MTOK, DM, G, (int)blockIdx.x);
        pg8::EpiOut E{P.x, XG, RSS};
        pg8::gemm_phase<pg8::EpiOut, pg8::StaticOrder, true, true>(lds, g, S, E);
        SEAM(3);
    }
    if (IN(4)) {
        pg8::Gemm g{XG, WqT, MTOK, NQ, DM}; pg8::StaticOrder S; S.init(MTOK, NQ, G, (int)blockIdx.x);
        pg8::EpiQ E{RSS, Qb};
        pg8::gemm_phase<pg8::EpiQ, pg8::StaticOrder, true, true>(lds, g, S, E);
        SEAM(4);
    }
    if (IN(5)) { p5_scores(P, lds); p6_gather(P, lds, xbar); }
#undef IN
#undef SEAM
}

extern "C" void kernel_launch(void* const* d_in, const int* in_sizes, int n_in, void* d_out, int out_size, void* d_ws, size_t ws_size, hipStream_t stream) {
    static int grid = 0;
    if (grid == 0) {
        if (n_in != 12 || in_sizes[0] != MTOK * DM || out_size != MTOK * DM || ws_size < WS_END) { fprintf(stderr, "kernel_launch: unexpected shapes (n_in %d, in0 %d, out %d, ws %zu)\n", n_in, n_in > 0 ? in_sizes[0] : -1, out_size, ws_size); grid = -1; return; }
        int dev = 0, cus = 0, per_cu = 0;
        (void)hipGetDevice(&dev); (void)hipDeviceGetAttribute(&cus, hipDeviceAttributeMultiprocessorCount, dev);
        (void)hipOccupancyMaxActiveBlocksPerMultiprocessor(&per_cu, (const void*)fwd, 512, 0);
        (void)hipGetLastError();
        if (per_cu < 1 || cus != 256) { fprintf(stderr, "kernel_launch: occupancy %d, cus %d: need 1 block on each of 256 CUs\n", per_cu, cus); grid = -1; return; }
        grid = cus;
    }
    if (grid < 0) return;
    (void)hipMemsetAsync((char*)d_ws + WS_CTL, 0, CTL_BYTES, stream);
    Params p{};
    p.x = (const float*)d_in[0]; p.norm_mix_g = (const float*)d_in[1]; p.w_in = (const float*)d_in[2]; p.diff_lambda = (const float*)d_in[3];
    p.diff_subln_g = (const float*)d_in[4]; p.w_out = (const float*)d_in[5]; p.norm_ffn_g = (const float*)d_in[6]; p.peer_wq = (const float*)d_in[7];
    p.peer_subkeys = (const float*)d_in[8]; p.peer_u = (const float*)d_in[9]; p.peer_v = (const float*)d_in[10]; p.final_norm_g = (const float*)d_in[11];
    p.out = (float*)d_out; p.ws = (unsigned char*)d_ws;
    p.ph_lo = 0; p.ph_hi = NPHASE;
    void* args[] = {&p};
    hipError_t e = hipLaunchCooperativeKernel((const void*)fwd, dim3(grid), dim3(512), args, 0, stream);
    if (e != hipSuccess) fprintf(stderr, "kernel_launch: cooperative launch failed: %s\n", hipGetErrorString(e));
}
```

```cpp
#include <hip/hip_runtime.h>
#include <hip/hip_cooperative_groups.h>
#include <cstdio>
#include <cstdint>
namespace cg = cooperative_groups;

#define LAS __attribute__((address_space(3)))
typedef unsigned short bf16;
typedef short bf16x8 __attribute__((ext_vector_type(8)));
typedef short s16x4 __attribute__((ext_vector_type(4)));
typedef float f32x4 __attribute__((ext_vector_type(4)));
typedef float f32x2 __attribute__((ext_vector_type(2)));
typedef float f32x16 __attribute__((ext_vector_type(16)));
typedef unsigned u32x4 __attribute__((ext_vector_type(4)));
typedef unsigned u32x2 __attribute__((ext_vector_type(2)));
typedef int i32x2 __attribute__((ext_vector_type(2)));

constexpr int BATCH = 16, SEQ = 2048, DM = 1024, MTOK = BATCH * SEQ;
constexpr int NIN = 3584;
constexpr int C_RQ = 0, C_RK = 512, C_RV = 1024, C_RG = 1536, C_DQ = 2048, C_DK = 2560, C_DV = 3072;
constexpr int NQ = 2048;
constexpr int NEXP = 16384;
constexpr float RMS_EPS = 1e-6f;
constexpr float LOG2E = 1.4426950408889634f;
constexpr float QSCALE2 = 0.125f * LOG2E;
constexpr float RK_SCALE = 0.08838834764831845f;

constexpr size_t MiB = 1u << 20;
constexpr size_t WS_CTL = 0, CTL_BYTES = 1 * MiB;
constexpr size_t WS_WIN = 1 * MiB;
constexpr size_t WS_WOUT = 8 * MiB;
constexpr size_t WS_WQ = 10 * MiB;
constexpr size_t WS_SK = 14 * MiB;
constexpr size_t WS_RSS = 15 * MiB;
constexpr size_t WS_U = 17 * MiB;
constexpr size_t WS_V = 33 * MiB;
constexpr size_t WS_SU = 49 * MiB, WS_SV = 49 * MiB + 65536;
constexpr size_t WS_H = 81 * MiB;
constexpr size_t WS_PROJ = 145 * MiB;
constexpr size_t WS_XG = WS_PROJ;
constexpr size_t WS_Q = WS_PROJ + 64 * MiB;
constexpr size_t WS_END = WS_PROJ + 224 * MiB;
constexpr int CW_QUEUE = 64;

constexpr int LDS_MAIN = 147456;
constexpr int LDS_BYTES = LDS_MAIN + 256;

__device__ __forceinline__ unsigned f2bf(float f) { unsigned u = __builtin_bit_cast(unsigned, f); return (u + 0x7fffu + ((u >> 16) & 1u)) >> 16; }
__device__ __forceinline__ unsigned pk2(float lo, float hi) { typedef __bf16 bf16x2_t __attribute__((ext_vector_type(2))); f32x2 v = {lo, hi}; bf16x2_t b = __builtin_convertvector(v, bf16x2_t); return __builtin_bit_cast(unsigned, b); }
__device__ __forceinline__ float bf_lo(unsigned u) { return __builtin_bit_cast(float, u << 16); }
__device__ __forceinline__ float bf_hi(unsigned u) { return __builtin_bit_cast(float, u & 0xffff0000u); }
__device__ __forceinline__ unsigned off_b(unsigned row, unsigned ch) { return 256u * row + 16u * (ch ^ (((row & 3) << 2) | ((row >> 2) & 3))); }
__device__ __forceinline__ s16x4 lds_tr(const LAS char* p) { typedef short v4i16_t __attribute__((ext_vector_type(4))); return __builtin_bit_cast(s16x4, __builtin_amdgcn_ds_read_tr16_b64_v4i16((LAS v4i16_t*)p)); }
__device__ __forceinline__ bf16x8 cat8(s16x4 lo, s16x4 hi) { return __builtin_shufflevector(lo, hi, 0, 1, 2, 3, 4, 5, 6, 7); }
__device__ __forceinline__ float wave_sum(float v) {
#pragma unroll
    for (int o = 1; o < 64; o <<= 1) v += __shfl_xor(v, o);
    return v;
}
#define DPPF(v, ctrl) __int_as_float(__builtin_amdgcn_update_dpp(0, __float_as_int(v), ctrl, 0xf, 0xf, false))
__device__ __forceinline__ float wave_sum_fast(float v) {
    v += DPPF(v, 0xB1); v += DPPF(v, 0x4E); v += DPPF(v, 0x141); v += DPPF(v, 0x140);
    { auto r = __builtin_amdgcn_permlane16_swap(__float_as_uint(v), __float_as_uint(v), false, false); v = __uint_as_float(r[0]) + __uint_as_float(r[1]); }
    { auto r = __builtin_amdgcn_permlane32_swap(__float_as_uint(v), __float_as_uint(v), false, false); v = __uint_as_float(r[0]) + __uint_as_float(r[1]); }
    return v;
}
__device__ __forceinline__ float wave_max_fast(float v) {
    v = fmaxf(v, DPPF(v, 0xB1)); v = fmaxf(v, DPPF(v, 0x4E)); v = fmaxf(v, DPPF(v, 0x141)); v = fmaxf(v, DPPF(v, 0x140));
    { auto r = __builtin_amdgcn_permlane16_swap(__float_as_uint(v), __float_as_uint(v), false, false); v = fmaxf(__uint_as_float(r[0]), __uint_as_float(r[1])); }
    { auto r = __builtin_amdgcn_permlane32_swap(__float_as_uint(v), __float_as_uint(v), false, false); v = fmaxf(__uint_as_float(r[0]), __uint_as_float(r[1])); }
    return v;
}
namespace pg8 {
#define PG8_LAS __attribute__((address_space(3)))
typedef unsigned short bf16_t;
typedef short bf16x8 __attribute__((ext_vector_type(8)));
typedef float f32x4 __attribute__((ext_vector_type(4)));
typedef unsigned u32x4 __attribute__((ext_vector_type(4)));
constexpr int BM = 256, BK = 64, HALF = 128, HTB = HALF * BK * 2  , STAGE_BYTES = 8 * HTB, NXCD = 8, WGM = 8;

__host__ __device__ __forceinline__ int lds_byte(int r, int c) { const int st = (r >> 4) * 2 + (c >> 5), rr = r & 15, cc = c & 31, ob = rr * 64 + cc * 2; return st * 1024 + (ob ^ (((ob >> 9) & 1) << 5)); }
__host__ __device__ __forceinline__ void stage_rc(int b, int& R, int& C) { const int st = b / 1024, sb = b % 1024, swz = sb ^ (((sb >> 9) & 1) << 5); R = (st >> 1) * 16 + swz / 64; C = (st & 1) * 32 + (swz % 64) / 2; }
__host__ __device__ __forceinline__ int perm32(int rho) { const int n = rho >> 4, i = rho & 15; return 8 * (i >> 2) + 4 * n + (i & 3); }

struct Unit { int pm, pn; };
struct Gemm { const bf16_t* A; const bf16_t* Bt; int M, N, K; };

struct StaticOrder {
    int nM, nN, nwg, G, c;
    __host__ __device__ void init(int M, int N, int G_, int c_) { nM = M / BM; nN = N / BM; nwg = nM * nN; G = G_; c = c_; }
    __host__ __device__ bool next(int i, Unit& u) const {
        const long L = (long)i * G + c; if (L >= nwg) return false;
        int wgid = (int)L; { const int q = nwg / NXCD, r = nwg % NXCD, xcd = wgid % NXCD, off = wgid / NXCD; wgid = (xcd < r ? xcd * (q + 1) : r * (q + 1) + (xcd - r) * q) + off; }
        const int nig = WGM * nN, gid = wgid / nig, fm = gid * WGM, gsz = (nM - fm) < WGM ? (nM - fm) : WGM;
        u.pm = fm + ((wgid % nig) % gsz); u.pn = (wgid % nig) / gsz; return true;
    }
    __device__ __forceinline__ void a_ready(const Unit&) const {}
    __device__ __forceinline__ void done(const Unit&) const {}
};

__device__ __forceinline__ unsigned cvt_pk_bf16(float lo, float hi) { unsigned r; asm volatile("v_cvt_pk_bf16_f32 %0, %1, %2" : "=v"(r) : "v"(lo), "v"(hi)); return r; }
typedef float f32x2 __attribute__((ext_vector_type(2)));
__device__ __forceinline__ f32x2 gelu_pk(f32x2 v) {
    const f32x2 av = __builtin_elementwise_abs(v), d = av * 0.2316418882f + 1.0f;
    f32x2 t; t.x = __builtin_amdgcn_rcpf(d.x); t.y = __builtin_amdgcn_rcpf(d.y);
    f32x2 q = t * 0.5307027145f + (-0.7265760135f); q = q * t + 0.7107068705f; q = q * t + (-0.142248368f); q = q * t + 0.127414796f; q = q * t;
    const f32x2 s = (v * v) * (-0.72134752044f);
    f32x2 e; e.x = __builtin_amdgcn_exp2f(s.x); e.y = __builtin_amdgcn_exp2f(s.y);
    const f32x2 m = v * (q * e), r = v - m;
    f32x2 o; o.x = v.x < 0.f ? m.x : r.x; o.y = v.y < 0.f ? m.y : r.y; return o;
}

template <class Epi, class Sched, bool ALIGN_EPI = false, bool SP2 = false>
__device__ __forceinline__ void gemm_phase(PG8_LAS unsigned char* lds, const Gemm g, const Sched& S, const Epi& E) {
    const int tid = threadIdx.x, wid = __builtin_amdgcn_readfirstlane(tid >> 6), lane = tid & 63, wr = wid >> 2, wc = wid & 3, fr = lane & 15, fq = lane >> 4;
    const int K = g.K, nt = K / BK;
    unsigned voffA[2], voffB[2];
#pragma unroll
    for (int i = 0; i < 2; ++i) { int R, C; stage_rc(tid * 16 + i * 8192, R, C); const int Rb = Epi::PERM ? ((R & ~31) + perm32(R & 31)) : R;
        voffA[i] = (unsigned)(R * K + C) * 2u; voffB[i] = (unsigned)(Rb * K + C) * 2u; }
    const size_t kstep = (size_t)(BK * 2);
    const size_t hstep = (size_t)HALF * K * 2;
    const size_t tstep = 2 * hstep;
    const unsigned ldsw = (unsigned)wid * 1024u;
    const int aoff = lds_byte(wr * 64 + fr, fq * 8), boff = lds_byte(wc * 32 + fr, fq * 8);
#define PG8_SA(b, h) (((b) * 2 + (h)) * HTB)
#define PG8_SB(b, h) ((4 + (b) * 2 + (h)) * HTB)
#define PG8_STAGE(bufoff, gbase, voff) do { _Pragma("unroll") for (int _i = 0; _i < 2; ++_i) \
        __builtin_amdgcn_global_load_lds((const unsigned*)((const char*)(gbase) + (voff)[_i]), (PG8_LAS unsigned*)(lds + (bufoff) + ldsw + _i * 8192), 16, 0, 0); } while (0)
#define PG8_LDA(dst, b, h) do { _Pragma("unroll") for (int m = 0; m < 4; ++m) _Pragma("unroll") for (int k = 0; k < 2; ++k) dst[m][k] = *(const PG8_LAS bf16x8*)(lds + PG8_SA(b, h) + aoff + m * 2048 + k * 1024); } while (0)
#define PG8_LDB(dst, b, h) do { _Pragma("unroll") for (int n = 0; n < 2; ++n) _Pragma("unroll") for (int k = 0; k < 2; ++k) dst[n][k] = *(const PG8_LAS bf16x8*)(lds + PG8_SB(b, h) + boff + n * 2048 + k * 1024); } while (0)
#define PG8_MMA(ai, bj, At, Bt) do { __builtin_amdgcn_s_setprio(1); _Pragma("unroll") for (int m = 0; m < 4; ++m) _Pragma("unroll") for (int n = 0; n < 2; ++n) _Pragma("unroll") for (int k = 0; k < 2; ++k) \
        acc[ai][bj][m][n] = __builtin_amdgcn_mfma_f32_16x16x32_bf16(Bt[n][k], At[m][k], acc[ai][bj][m][n], 0, 0, 0); __builtin_amdgcn_s_setprio(0); } while (0)
#define PG8_WAIT_V(n) asm volatile("s_waitcnt vmcnt(" #n ")" ::: "memory")
#define PG8_WAIT_L(n) asm volatile("s_waitcnt lgkmcnt(" #n ")" ::: "memory")
#define PG8_BAR __builtin_amdgcn_s_barrier()
#define PG8_SCHED __builtin_amdgcn_sched_barrier(0)
    Unit cur, nxt; int ui = 0;
    if (!S.next(0, cur)) return;
    f32x4 acc[2][2][4][2];
#pragma unroll
    for (int a = 0; a < 2; ++a)
#pragma unroll
        for (int b = 0; b < 2; ++b)
#pragma unroll
            for (int m = 0; m < 4; ++m)
#pragma unroll
                for (int n = 0; n < 2; ++n) acc[a][b][m][n] = (f32x4){0.f, 0.f, 0.f, 0.f};
    bf16x8 At[4][2], B0[2][2], B1[2][2];
    const char* cA = (const char*)g.A + (size_t)cur.pm * tstep; const char* cB = (const char*)g.Bt + (size_t)cur.pn * tstep;
    S.a_ready(cur);
    if constexpr (SP2) {
        PG8_STAGE(PG8_SB(0, 0), cB, voffB); PG8_STAGE(PG8_SB(0, 1), cB + hstep, voffB); PG8_STAGE(PG8_SA(0, 0), cA, voffA); PG8_STAGE(PG8_SA(0, 1), cA + hstep, voffA);
        if (wr == 1) PG8_BAR;
        PG8_WAIT_V(2); PG8_BAR;
        PG8_STAGE(PG8_SB(1, 0), cB + kstep, voffB); PG8_STAGE(PG8_SA(1, 0), cA + kstep, voffA); PG8_STAGE(PG8_SB(1, 1), cB + hstep + kstep, voffB);
        PG8_WAIT_V(6); PG8_BAR;
    } else {
        PG8_STAGE(PG8_SB(0, 0), cB, voffB); PG8_STAGE(PG8_SA(0, 0), cA, voffA); PG8_STAGE(PG8_SB(0, 1), cB + hstep, voffB); PG8_STAGE(PG8_SA(0, 1), cA + hstep, voffA);
        if (wr == 1) PG8_BAR;
        PG8_WAIT_V(4); PG8_BAR;
        PG8_STAGE(PG8_SB(1, 0), cB + kstep, voffB); PG8_STAGE(PG8_SA(1, 0), cA + kstep, voffA); PG8_STAGE(PG8_SB(1, 1), cB + hstep + kstep, voffB);
        PG8_WAIT_V(6); PG8_BAR;
    }
    for (;;) {
        const bool has_next = S.next(ui + 1, nxt);
        const char* nA = has_next ? (const char*)g.A + (size_t)nxt.pm * tstep : cA; const char* nB = has_next ? (const char*)g.Bt + (size_t)nxt.pn * tstep : cB;
        for (int t = 0; t < nt; t += 2) {
            const bool last = (t == nt - 2);
            const char* a1 = cA + (size_t)(t + 1) * kstep;
            const char* a2 = last ? nA : cA + (size_t)(t + 2) * kstep; const char* b2 = last ? nB : cB + (size_t)(t + 2) * kstep;
            const char* a3 = a2 + kstep; const char* b3 = b2 + kstep;
            if (last && has_next) S.a_ready(nxt);
            if constexpr (SP2) {
            PG8_LDB(B0, 0, 0); PG8_LDB(B1, 0, 1); PG8_SCHED; PG8_LDA(At, 0, 0); PG8_STAGE(PG8_SA(1, 1), a1 + hstep, voffA);
            PG8_WAIT_V(8); PG8_WAIT_L(0); PG8_BAR; PG8_MMA(0, 0, At, B0); PG8_MMA(0, 1, At, B1); PG8_BAR; PG8_SCHED;
            PG8_LDA(At, 0, 1); PG8_STAGE(PG8_SB(0, 0), b2, voffB); PG8_STAGE(PG8_SB(0, 1), b2 + hstep, voffB); PG8_STAGE(PG8_SA(0, 0), a2, voffA);
            PG8_WAIT_V(8); PG8_WAIT_L(0); PG8_BAR; PG8_MMA(1, 0, At, B0); PG8_MMA(1, 1, At, B1); PG8_BAR; PG8_SCHED;
            PG8_LDB(B0, 1, 0); PG8_LDB(B1, 1, 1); PG8_SCHED; PG8_LDA(At, 1, 0); PG8_STAGE(PG8_SA(0, 1), a2 + hstep, voffA);
            PG8_WAIT_V(8); PG8_WAIT_L(0); PG8_BAR; PG8_MMA(0, 0, At, B0); PG8_MMA(0, 1, At, B1); PG8_BAR; PG8_SCHED;
            PG8_LDA(At, 1, 1); PG8_STAGE(PG8_SB(1, 0), b3, voffB); PG8_STAGE(PG8_SB(1, 1), b3 + hstep, voffB); PG8_STAGE(PG8_SA(1, 0), a3, voffA);
            PG8_WAIT_V(8); PG8_WAIT_L(0); PG8_BAR; PG8_MMA(1, 0, At, B0); PG8_MMA(1, 1, At, B1); PG8_BAR; PG8_SCHED;
            } else {
            PG8_LDB(B0, 0, 0); PG8_SCHED; PG8_LDA(At, 0, 0); PG8_STAGE(PG8_SA(1, 1), a1 + hstep, voffA);
            PG8_WAIT_L(8); PG8_BAR; PG8_WAIT_L(0); PG8_MMA(0, 0, At, B0); PG8_BAR; PG8_SCHED;
            PG8_LDB(B1, 0, 1); PG8_STAGE(PG8_SB(0, 0), b2, voffB);
            PG8_BAR; PG8_WAIT_L(0); PG8_MMA(0, 1, At, B1); PG8_BAR;
            PG8_LDA(At, 0, 1); PG8_STAGE(PG8_SA(0, 0), a2, voffA);
            PG8_BAR; PG8_WAIT_L(0); PG8_MMA(1, 0, At, B0); PG8_BAR; PG8_SCHED;
            PG8_STAGE(PG8_SB(0, 1), b2 + hstep, voffB);
            PG8_WAIT_V(6); PG8_BAR; PG8_MMA(1, 1, At, B1); PG8_BAR;
            PG8_LDB(B0, 1, 0); PG8_SCHED; PG8_LDA(At, 1, 0); PG8_STAGE(PG8_SA(0, 1), a2 + hstep, voffA);
            PG8_WAIT_L(8); PG8_BAR; PG8_WAIT_L(0); PG8_MMA(0, 0, At, B0); PG8_BAR; PG8_SCHED;
            PG8_LDB(B1, 1, 1); PG8_STAGE(PG8_SB(1, 0), b3, voffB);
            PG8_BAR; PG8_WAIT_L(0); PG8_MMA(0, 1, At, B1); PG8_BAR;
            PG8_LDA(At, 1, 1); PG8_STAGE(PG8_SA(1, 0), a3, voffA);
            PG8_BAR; PG8_WAIT_L(0); PG8_MMA(1, 0, At, B0); PG8_BAR; PG8_SCHED;
            PG8_STAGE(PG8_SB(1, 1), b3 + hstep, voffB);
            PG8_WAIT_V(6); PG8_BAR; PG8_MMA(1, 1, At, B1); PG8_BAR;
            }
        }
        if constexpr (ALIGN_EPI) { if (wr == 0) PG8_BAR; }
        if constexpr (!Epi::AFTER_DRAIN) { E(acc, cur, wr, wc, fr, fq); S.done(cur); }
        if (!has_next) break;
#pragma unroll
        for (int a = 0; a < 2; ++a)
#pragma unroll
            for (int b = 0; b < 2; ++b)
#pragma unroll
                for (int m = 0; m < 4; ++m)
#pragma unroll
                    for (int n = 0; n < 2; ++n) acc[a][b][m][n] = (f32x4){0.f, 0.f, 0.f, 0.f};
        cur = nxt; cA = nA; cB = nB; ++ui;
        if constexpr (ALIGN_EPI) { if (wr == 1) PG8_BAR; }
    }
    PG8_WAIT_V(0);
    if constexpr (!ALIGN_EPI) { if (wr == 0) PG8_BAR; }
    PG8_BAR;
    if constexpr (Epi::AFTER_DRAIN) { E.fused(acc, cur, wr, wc, fr, fq, lds, wid, lane); S.done(cur); }
#undef PG8_SA
#undef PG8_SB
#undef PG8_STAGE
#undef PG8_LDA
#undef PG8_LDB
#undef PG8_MMA
#undef PG8_WAIT_V
#undef PG8_WAIT_L
#undef PG8_BAR
#undef PG8_SCHED
}
}
namespace pg8 {
struct EpiProj {
    static constexpr bool PERM = true, AFTER_DRAIN = false;
    bf16_t* O;
    __device__ __forceinline__ void operator()(const f32x4 (&acc)[2][2][4][2], const Unit& u, int wr, int wc, int fr, int fq) const {
        const int row0 = u.pm * BM + wr * 64 + fr, col0 = u.pn * BM + wc * 32 + 8 * fq;
        const float sc = (u.pn == 2 || u.pn == 3) ? RK_SCALE : ((u.pn == 8 || u.pn == 9) ? QSCALE2 : 1.f);
#pragma unroll
        for (int ai = 0; ai < 2; ++ai)
#pragma unroll
            for (int m = 0; m < 4; ++m) { bf16_t* rowp = O + (size_t)(row0 + ai * HALF + m * 16) * NIN + col0;
#pragma unroll
                for (int bj = 0; bj < 2; ++bj) { const f32x4 v0 = acc[ai][bj][m][0] * sc, v1 = acc[ai][bj][m][1] * sc;
                    u32x4 w; w.x = cvt_pk_bf16(v0[0], v0[1]); w.y = cvt_pk_bf16(v0[2], v0[3]); w.z = cvt_pk_bf16(v1[0], v1[1]); w.w = cvt_pk_bf16(v1[2], v1[3]);
                    *(u32x4*)(rowp + bj * HALF) = w; } }
    }
};
struct EpiOut {
    static constexpr bool PERM = true, AFTER_DRAIN = false;
    const float* X; bf16_t* XB; float* RSS;
    __device__ __forceinline__ void operator()(const f32x4 (&acc)[2][2][4][2], const Unit& u, int wr, int wc, int fr, int fq) const {
        const int row0 = u.pm * BM + wr * 64 + fr, col0 = u.pn * BM + wc * 32 + 8 * fq;
#pragma unroll
        for (int ai = 0; ai < 2; ++ai)
#pragma unroll
            for (int m = 0; m < 4; ++m) { const int row = row0 + ai * HALF + m * 16; const size_t off = (size_t)row * DM + col0; float ss = 0.f;
#pragma unroll
                for (int bj = 0; bj < 2; ++bj) {
                    const f32x4 a0 = *(const f32x4*)(X + off + bj * HALF) + acc[ai][bj][m][0], a1 = *(const f32x4*)(X + off + bj * HALF + 4) + acc[ai][bj][m][1];
                    ss += (a0[0] * a0[0] + a0[1] * a0[1]) + (a0[2] * a0[2] + a0[3] * a0[3]) + (a1[0] * a1[0] + a1[1] * a1[1]) + (a1[2] * a1[2] + a1[3] * a1[3]);
                    u32x4 w; w.x = cvt_pk_bf16(a0[0], a0[1]); w.y = cvt_pk_bf16(a0[2], a0[3]); w.z = cvt_pk_bf16(a1[0], a1[1]); w.w = cvt_pk_bf16(a1[2], a1[3]);
                    *(u32x4*)(XB + off + bj * HALF) = w; }
                ss += __shfl_xor(ss, 16); ss += __shfl_xor(ss, 32);
                if (fq == 0) RSS[(size_t)row * 16 + u.pn * 4 + wc] = ss; }
    }
};
struct EpiQ {
    static constexpr bool PERM = true, AFTER_DRAIN = false;
    const float* RSS; bf16_t* Q;
    __device__ __forceinline__ void operator()(const f32x4 (&acc)[2][2][4][2], const Unit& u, int wr, int wc, int fr, int fq) const {
        const int row0 = u.pm * BM + wr * 64 + fr, col0 = u.pn * BM + wc * 32 + 8 * fq;
#pragma unroll
        for (int ai = 0; ai < 2; ++ai)
#pragma unroll
            for (int m = 0; m < 4; ++m) { const int row = row0 + ai * HALF + m * 16;
                const f32x4* rp = (const f32x4*)(RSS + (size_t)row * 16); const f32x4 s0 = rp[0], s1 = rp[1], s2 = rp[2], s3 = rp[3];
                const float ss = ((s0[0] + s0[1]) + (s0[2] + s0[3])) + ((s1[0] + s1[1]) + (s1[2] + s1[3])) + ((s2[0] + s2[1]) + (s2[2] + s2[3])) + ((s3[0] + s3[1]) + (s3[2] + s3[3]));
                const float rstd = 1.0f / sqrtf(ss * (1.0f / DM) + RMS_EPS);
                bf16_t* rowp = Q + (size_t)row * NQ + col0;
#pragma unroll
                for (int bj = 0; bj < 2; ++bj) { const f32x4 v0 = acc[ai][bj][m][0] * rstd, v1 = acc[ai][bj][m][1] * rstd;
                    u32x4 w; w.x = cvt_pk_bf16(v0[0], v0[1]); w.y = cvt_pk_bf16(v0[2], v0[3]); w.z = cvt_pk_bf16(v1[0], v1[1]); w.w = cvt_pk_bf16(v1[2], v1[3]);
                    *(u32x4*)(rowp + bj * HALF) = w; } }
    }
};
}
struct Params {
    const float *x, *norm_mix_g, *w_in, *diff_lambda, *diff_subln_g, *w_out, *norm_ffn_g, *peer_wq, *peer_subkeys, *peer_u, *peer_v, *final_norm_g;
    float* out; unsigned char* ws; int ph_lo, ph_hi;
};
__device__ __forceinline__ void p0_transpose_item(const float* W, int K, int N, bf16* WT, LAS float* scr, int item, int lane, const float* gk = nullptr) {
    const int nblk = N / 32, kb = item / nblk, nb = item % nblk, k0 = 64 * kb, n0 = 32 * nb;
#pragma unroll 8
    for (int i = 0; i < 32; ++i) { const int kk = 2 * i + (lane >> 5); scr[kk * 33 + (lane & 31)] = W[(size_t)(k0 + kk) * N + n0 + (lane & 31)] * (gk ? gk[k0 + kk] : 1.0f); }
    asm volatile("s_waitcnt lgkmcnt(0)" ::: "memory");
    const int c = lane & 7;
#pragma unroll
    for (int j = 0; j < 4; ++j) { const int n = (lane >> 3) + 8 * j; const LAS float* s = scr + (8 * c) * 33 + n;
        u32x4 o; o.x = pk2(s[0 * 33], s[1 * 33]); o.y = pk2(s[2 * 33], s[3 * 33]); o.z = pk2(s[4 * 33], s[5 * 33]); o.w = pk2(s[6 * 33], s[7 * 33]);
        *(u32x4*)(WT + (size_t)(n0 + n) * K + k0 + 8 * c) = o; }
    asm volatile("s_waitcnt lgkmcnt(0)" ::: "memory");
}
__device__ __forceinline__ void p0_convert(const float* src, bf16* dst, size_t n8, int gw, int ngw, int lane) {
    for (size_t g = (size_t)gw * 64 + lane; g < n8; g += (size_t)ngw * 64) {
        const f32x4 a = ((const f32x4*)src)[2 * g], b = ((const f32x4*)src)[2 * g + 1];
        u32x4 o; o.x = pk2(a[0], a[1]); o.y = pk2(a[2], a[3]); o.z = pk2(b[0], b[1]); o.w = pk2(b[2], b[3]);
        ((u32x4*)dst)[g] = o; }
}
__device__ __forceinline__ void p0_fp8_rows(const float* src, unsigned char* dst, float* inv, int gw, int ngw, int lane) {
    float cal; { float one28 = 128.f; asm volatile("" : "+v"(one28)); const int enc = __builtin_amdgcn_cvt_pk_fp8_f32(one28, one28, 0, false); const f32x2 dec = __builtin_amdgcn_cvt_pk_f32_fp8(enc, false); cal = 128.f / dec.x; }
    for (int row0 = gw; row0 < NEXP; row0 += 2 * ngw) {
        f32x4 v[2][4]; float m[2];
#pragma unroll
        for (int q = 0; q < 2; ++q) { const f32x4* sp = (const f32x4*)(src + (size_t)(row0 + q * ngw) * DM + 16 * lane);
#pragma unroll
            for (int j = 0; j < 4; ++j) v[q][j] = sp[j]; }
#pragma unroll
        for (int q = 0; q < 2; ++q) { float mm = 0.f;
#pragma unroll
            for (int j = 0; j < 4; ++j) mm = fmaxf(mm, fmaxf(fmaxf(fabsf(v[q][j][0]), fabsf(v[q][j][1])), fmaxf(fabsf(v[q][j][2]), fabsf(v[q][j][3]))));
#pragma unroll
            for (int o = 1; o < 64; o <<= 1) mm = fmaxf(mm, __shfl_xor(mm, o));
            m[q] = mm; }
#pragma unroll
        for (int q = 0; q < 2; ++q) { const int row = row0 + q * ngw; const float sc = m[q] > 0.f ? 224.f / m[q] : 1.f;
            u32x4 o;
#pragma unroll
            for (int j = 0; j < 4; ++j) { int pk = __builtin_amdgcn_cvt_pk_fp8_f32(v[q][j][0] * sc, v[q][j][1] * sc, 0, false); pk = __builtin_amdgcn_cvt_pk_fp8_f32(v[q][j][2] * sc, v[q][j][3] * sc, pk, true); o[j] = (unsigned)pk; }
            *(u32x4*)(dst + (size_t)row * DM + 16 * lane) = o;
            if (lane == 0) inv[row] = (m[q] > 0.f ? m[q] * (1.0f / 224.f) : 1.f) * cal; }
    }
}
__device__ __forceinline__ void p0_norm_row(const float* xrow, const float* g, bf16* orow, int lane) {
    const f32x4* xr = (const f32x4*)xrow + lane; const f32x4* gr = (const f32x4*)g + lane;
    f32x4 v[4]; float s = 0.f;
#pragma unroll
    for (int j = 0; j < 4; ++j) { v[j] = xr[64 * j]; s += (v[j][0] * v[j][0] + v[j][1] * v[j][1]) + (v[j][2] * v[j][2] + v[j][3] * v[j][3]); }
    const float rstd = 1.0f / sqrtf(wave_sum(s) * (1.f / DM) + RMS_EPS);
    u32x2* o8 = (u32x2*)orow + lane;
#pragma unroll
    for (int j = 0; j < 4; ++j) { const f32x4 gg = gr[64 * j]; u32x2 o; o.x = pk2(v[j][0] * rstd * gg[0], v[j][1] * rstd * gg[1]); o.y = pk2(v[j][2] * rstd * gg[2], v[j][3] * rstd * gg[3]); o8[64 * j] = o; }
}
__device__ __forceinline__ void p0_norm_row2(const float* xrow0, const float* xrow1, const float* g, bf16* orow0, bf16* orow1, int lane) {
    const f32x4* x0 = (const f32x4*)xrow0 + lane; const f32x4* x1 = (const f32x4*)xrow1 + lane; const f32x4* gr = (const f32x4*)g + lane;
    f32x4 a[4], b[4]; float sa = 0.f, sb = 0.f;
#pragma unroll
    for (int j = 0; j < 4; ++j) { a[j] = x0[64 * j]; b[j] = x1[64 * j]; }
#pragma unroll
    for (int j = 0; j < 4; ++j) { sa += (a[j][0] * a[j][0] + a[j][1] * a[j][1]) + (a[j][2] * a[j][2] + a[j][3] * a[j][3]); sb += (b[j][0] * b[j][0] + b[j][1] * b[j][1]) + (b[j][2] * b[j][2] + b[j][3] * b[j][3]); }
    const float ra = 1.0f / sqrtf(wave_sum(sa) * (1.f / DM) + RMS_EPS), rb = 1.0f / sqrtf(wave_sum(sb) * (1.f / DM) + RMS_EPS);
    u32x2* oa = (u32x2*)orow0 + lane; u32x2* ob = (u32x2*)orow1 + lane;
#pragma unroll
    for (int j = 0; j < 4; ++j) { const f32x4 gg = gr[64 * j];
        u32x2 o; o.x = pk2(a[j][0] * ra * gg[0], a[j][1] * ra * gg[1]); o.y = pk2(a[j][2] * ra * gg[2], a[j][3] * ra * gg[3]); oa[64 * j] = o;
        u32x2 q; q.x = pk2(b[j][0] * rb * gg[0], b[j][1] * rb * gg[1]); q.y = pk2(b[j][2] * rb * gg[2], b[j][3] * rb * gg[3]); ob[64 * j] = q; }
}
__device__ __forceinline__ void p0_i8_rows(const float* src, const float* gain, unsigned char* dst, float* inv, int gw, int ngw, int lane) {
    f32x4 gq[4];
#pragma unroll
    for (int j = 0; j < 4; ++j) gq[j] = *(const f32x4*)(gain + 16 * lane + 4 * j);
    for (int row0 = gw; row0 < NEXP; row0 += 2 * ngw) {
        f32x4 v[2][4]; float m[2];
#pragma unroll
        for (int q = 0; q < 2; ++q) { const f32x4* sp = (const f32x4*)(src + (size_t)(row0 + q * ngw) * DM + 16 * lane);
#pragma unroll
            for (int j = 0; j < 4; ++j) v[q][j] = sp[j] * gq[j]; }
#pragma unroll
        for (int q = 0; q < 2; ++q) { float mm = 0.f;
#pragma unroll
            for (int j = 0; j < 4; ++j) mm = fmaxf(mm, fmaxf(fmaxf(fabsf(v[q][j][0]), fabsf(v[q][j][1])), fmaxf(fabsf(v[q][j][2]), fabsf(v[q][j][3]))));
#pragma unroll
            for (int o = 1; o < 64; o <<= 1) mm = fmaxf(mm, __shfl_xor(mm, o));
            m[q] = mm; }
#pragma unroll
        for (int q = 0; q < 2; ++q) { const int row = row0 + q * ngw; const float sc = m[q] > 0.f ? 127.f / m[q] : 1.f;
            u32x4 o;
#pragma unroll
            for (int j = 0; j < 4; ++j) { const int b0 = (int)rintf(v[q][j][0] * sc), b1 = (int)rintf(v[q][j][1] * sc), b2 = (int)rintf(v[q][j][2] * sc), b3 = (int)rintf(v[q][j][3] * sc);
                o[j] = ((unsigned)b0 & 255u) | (((unsigned)b1 & 255u) << 8) | (((unsigned)b2 & 255u) << 16) | (((unsigned)b3 & 255u) << 24); }
            *(u32x4*)(dst + (size_t)row * DM + 16 * lane) = o;
            if (lane == 0) inv[row] = m[q] > 0.f ? m[q] * (1.0f / 127.f) : 1.f; }
    }
}
__device__ __forceinline__ void p0_prologue(const Params& P, LAS unsigned char* lds, int wave, int lane) {
    LAS float* scr = (LAS float*)(lds + wave * 16384);
    const int gw = blockIdx.x * 8 + wave, ngw = gridDim.x * 8;
    constexpr int I_IN = (DM / 64) * (NIN / 32), I_OUT = (DM / 64) * (DM / 32), I_WQ = (DM / 64) * (NQ / 32), NIT = I_IN + I_OUT + I_WQ;
    bf16* WinT = (bf16*)(P.ws + WS_WIN); bf16* WoutT = (bf16*)(P.ws + WS_WOUT); bf16* WqT = (bf16*)(P.ws + WS_WQ);
    for (int it = gw; it < NIT; it += ngw) {
        int r = it;
        if (r < I_IN) { p0_transpose_item(P.w_in, DM, NIN, WinT, scr, r, lane); continue; } r -= I_IN;
        if (r < I_OUT) { p0_transpose_item(P.w_out, DM, DM, WoutT, scr, r, lane); continue; } r -= I_OUT;
        p0_transpose_item(P.peer_wq, DM, NQ, WqT, scr, r, lane, P.norm_ffn_g);
    }
    p0_convert(P.peer_subkeys, (bf16*)(P.ws + WS_SK), (size_t)16 * 128 * 128 / 8, gw, ngw, lane);
    p0_i8_rows(P.peer_u, P.norm_ffn_g, P.ws + WS_U, (float*)(P.ws + WS_SU), gw, ngw, lane);
    p0_fp8_rows(P.peer_v, P.ws + WS_V, (float*)(P.ws + WS_SV), gw, ngw, lane);
    bf16* H = (bf16*)(P.ws + WS_H);
    for (int m = gw; m < MTOK; m += 2 * ngw) p0_norm_row2(P.x + (size_t)m * DM, P.x + (size_t)(m + ngw) * DM, P.norm_mix_g, H + (size_t)m * DM, H + (size_t)(m + ngw) * DM, lane);
}
#define MFMA32(a, b, c) __builtin_amdgcn_mfma_f32_32x32x16_bf16((a), (b), (c), 0, 0, 0)
#define MFMA16(a, b, c) __builtin_amdgcn_mfma_f32_16x16x32_bf16((a), (b), (c), 0, 0, 0)
__device__ __forceinline__ float swap_max(float v) { auto rr = __builtin_amdgcn_permlane32_swap(__float_as_uint(v), __float_as_uint(v), false, false); return fmaxf(__uint_as_float(rr[0]), __uint_as_float(rr[1])); }
__device__ __forceinline__ float swap_add(float v) { auto rr = __builtin_amdgcn_permlane32_swap(__float_as_uint(v), __float_as_uint(v), false, false); return __uint_as_float(rr[0]) + __uint_as_float(rr[1]); }
__device__ __forceinline__ bf16x8 pack8(const f32x16& x, int s) {
    u32x4 p; p.x = pk2(x[8 * s], x[8 * s + 1]); p.y = pk2(x[8 * s + 2], x[8 * s + 3]); p.z = pk2(x[8 * s + 4], x[8 * s + 5]); p.w = pk2(x[8 * s + 6], x[8 * s + 7]);
    return __builtin_bit_cast(bf16x8, p);
}
constexpr float ATT_THR = 8.0f;
constexpr float ATT_NEG = -1.0e30f;

constexpr int PR = 272, PT = 320;
constexpr int AT_Q = 0, AT_KV = 256 * PR, AT_KVSZ = 64 * PR + 64 * PT;
static_assert(AT_KV + 2 * AT_KVSZ <= LDS_MAIN, "attention LDS");
__device__ __forceinline__ void attn_unit(const bf16* PROJ, bf16* Y, const float* subln_g, float lam, int b, int h, int qb, LAS unsigned char* lds) {
    int tid = threadIdx.x; asm volatile("" : "+v"(tid));
    const int lane = tid & 63, r32 = lane & 31, hi = lane >> 5;
    const int w = __builtin_amdgcn_readfirstlane(tid >> 6);
    const size_t rowbase = (size_t)b * SEQ;
    const float slope2 = exp2f(-2.f * (float)(h + 1)) * LOG2E;
    const int srow = tid >> 4, sch = tid & 15;
    const char* gbase = (const char*)(PROJ + rowbase * NIN + h * 128);
    const unsigned soff = (unsigned)(srow * NIN + sch * 8) * 2u;
    {   const char* qb_ = gbase + ((size_t)qb * 256 * NIN + C_DQ) * 2;
#pragma unroll
        for (int i = 0; i < 8; ++i) { const int row = srow + 32 * i; const u32x4 v = *(const u32x4*)(qb_ + (soff + (unsigned)(32 * i * NIN * 2))); *(LAS u32x4*)(lds + AT_Q + row * PR + sch * 16) = v; } }
    u32x4 sk[2], sv[2];
#define A_LOAD(j) do { const char* kb_ = gbase + ((size_t)(64 * (j)) * NIN + C_DK) * 2; const char* vb_ = gbase + ((size_t)(64 * (j)) * NIN + C_DV) * 2; \
        _Pragma("unroll") for (int i_ = 0; i_ < 2; ++i_) { sk[i_] = *(const u32x4*)(kb_ + (soff + (unsigned)(32 * i_ * NIN * 2))); sv[i_] = *(const u32x4*)(vb_ + (soff + (unsigned)(32 * i_ * NIN * 2))); } } while (0)
#define A_STORE(buf) do { _Pragma("unroll") for (int i_ = 0; i_ < 2; ++i_) { \
        *(LAS u32x4*)(lds + AT_KV + (buf) * AT_KVSZ + (srow + 32 * i_) * PR + sch * 16) = sk[i_]; *(LAS u32x4*)(lds + AT_KV + (buf) * AT_KVSZ + 64 * PR + (srow + 32 * i_) * PT + sch * 16) = sv[i_]; } } while (0)
    const int nt = 4 * qb + 4, jd = 4 * qb + (w >> 1);
    const int qpos = qb * 256 + 32 * w + r32;
    unsigned qbase = AT_Q + (32 * w + r32) * PR + hi * 16, kbase = r32 * PR + hi * 16;
    unsigned vbase = 64 * PR + (4 * hi + ((lane & 15) >> 2)) * PT + ((lane >> 4) & 1) * 32 + (lane & 3) * 8;
    f32x16 O1[4], O2[4];
#pragma unroll
    for (int c = 0; c < 4; ++c)
#pragma unroll
        for (int r = 0; r < 16; ++r) { O1[c][r] = 0.f; O2[c][r] = 0.f; }
    float mref[2] = {0.f, 0.f}, lsum[2] = {0.f, 0.f};
    bool started = false;
    A_LOAD(nt - 1); A_STORE(0); if (nt > 1) A_LOAD(nt - 2);
    __syncthreads();
    for (int it = 0; it < nt; ++it) {
        const int j = nt - 1 - it, cur = it & 1;
        asm volatile("" : "+v"(qbase), "+v"(kbase), "+v"(vbase));
        if (it + 1 < nt) A_STORE(cur ^ 1);
        if (it + 2 < nt) A_LOAD(j - 2);
        if (j <= jd) {
            const unsigned kvo = AT_KV + cur * AT_KVSZ;
            for (int kb = 1; kb >= 0; --kb) {
                const bool diag = (j == jd);
                if (diag && kb > (w & 1)) continue;
                const bool domask = diag && kb == (w & 1);
                bf16x8 Pb[2][2];
#pragma unroll
                for (int p = 0; p < 2; ++p) {
                    f32x16 S;
                    const float tb = slope2 * (float)(64 * j + 32 * kb - qpos + 4 * hi) - mref[p];
#pragma unroll
                    for (int r = 0; r < 16; ++r) S[r] = tb + slope2 * (float)((r & 3) + 8 * (r >> 2));
#pragma unroll
                    for (int ks = 0; ks < 4; ++ks) {
                        const bf16x8 qf = *(const LAS bf16x8*)(lds + qbase + (8 * p + 2 * ks) * 16);
                        const bf16x8 kf = *(const LAS bf16x8*)(lds + (kbase + kvo + kb * (32 * PR)) + (8 * p + 2 * ks) * 16);
                        S = MFMA32(kf, qf, S);
                    }
                    if (domask) {
#pragma unroll
                        for (int r = 0; r < 16; ++r) { const int kv = (r & 3) + 8 * (r >> 2) + 4 * hi; if (kv > r32) S[r] = ATT_NEG; } }
                    float rm = fmaxf(S[0], S[1]);
#pragma unroll
                    for (int r = 2; r < 16; ++r) rm = fmaxf(rm, S[r]);
                    rm = swap_max(rm);
                    if (!started) {
                        mref[p] = rm;
#pragma unroll
                        for (int r = 0; r < 16; ++r) S[r] -= rm;
                    } else if (__any(rm > ATT_THR)) {
                        const float dl = fmaxf(rm, 0.f); mref[p] += dl;
#pragma unroll
                        for (int r = 0; r < 16; ++r) S[r] -= dl;
                        const float f = exp2f(-dl); lsum[p] *= f;
                        if (p == 0) {
#pragma unroll
                            for (int c = 0; c < 4; ++c) O1[c] = O1[c] * f;
                        } else {
#pragma unroll
                            for (int c = 0; c < 4; ++c) O2[c] = O2[c] * f;
                        }
                    }
                    float ls = 0.f;
#pragma unroll
                    for (int r = 0; r < 16; ++r) { S[r] = __builtin_amdgcn_exp2f(S[r]); ls += S[r]; }
                    lsum[p] += ls;
                    Pb[p][0] = pack8(S, 0); Pb[p][1] = pack8(S, 1);
                }
                started = true;
#pragma unroll
                for (int c = 0; c < 4; ++c)
#pragma unroll
                    for (int ss = 0; ss < 2; ++ss) {
                        const LAS char* vp = (const LAS char*)lds + (vbase + kvo + kb * (32 * PT));
                        const bf16x8 vf = cat8(lds_tr(vp + ((16 * ss) * PT + c * 64)), lds_tr(vp + ((16 * ss + 8) * PT + c * 64)));
                        O1[c] = MFMA32(vf, Pb[0][ss], O1[c]); O2[c] = MFMA32(vf, Pb[1][ss], O2[c]);
                    }
            }
        }
        __syncthreads();
    }
#undef A_LOAD
#undef A_STORE
    const float inv1 = 1.0f / swap_add(lsum[0]), inv2 = lam / swap_add(lsum[1]);
    float ss = 0.f;
#pragma unroll
    for (int c = 0; c < 4; ++c)
#pragma unroll
        for (int r = 0; r < 16; ++r) { const float o = O1[c][r] * inv1 - O2[c][r] * inv2; O1[c][r] = o; ss += o * o; }
    ss = swap_add(ss);
    const float rstd = (1.0f / sqrtf(ss * (1.0f / 128.f) + RMS_EPS)) * 0.8f;
    bf16* yrow = Y + (rowbase + qpos) * DM + 512 + h * 128;
#pragma unroll
    for (int c = 0; c < 4; ++c)
#pragma unroll
        for (int g4 = 0; g4 < 4; ++g4) { const int dv0 = 32 * c + 8 * g4 + 4 * hi; const f32x4 gg = *(const f32x4*)(subln_g + dv0);
            u32x2 o; o.x = pk2(O1[c][4 * g4] * rstd * gg[0], O1[c][4 * g4 + 1] * rstd * gg[1]); o.y = pk2(O1[c][4 * g4 + 2] * rstd * gg[2], O1[c][4 * g4 + 3] * rstd * gg[3]);
            *(u32x2*)(yrow + dv0) = o; }
}

constexpr int RT_P = 0, RT_K = 128 * PR, RT_V = 2 * 128 * PR, RT_ST = 2 * 128 * PR + 128 * PT;
static_assert(RT_ST + 128 * PR <= LDS_MAIN, "retention LDS");
__device__ __forceinline__ u32x4 scale8(u32x4 v, float f) { u32x4 o; o.x = pk2(bf_lo(v.x) * f, bf_hi(v.x) * f); o.y = pk2(bf_lo(v.y) * f, bf_hi(v.y) * f); o.z = pk2(bf_lo(v.z) * f, bf_hi(v.z) * f); o.w = pk2(bf_lo(v.w) * f, bf_hi(v.w) * f); return o; }
__device__ __forceinline__ void ret_unit(const bf16* PROJ, bf16* Y, int b, int h, LAS unsigned char* lds) {
    int tid = threadIdx.x; asm volatile("" : "+v"(tid));
    const int lane = tid & 63, l15 = lane & 15, g = lane >> 4;
    const int w = __builtin_amdgcn_readfirstlane(tid >> 6);
    const size_t rowbase = (size_t)b * SEQ;
    const float gam = 1.0f - exp2f(-5.f - (float)h), lg = log2f(gam), cdec = exp2f(128.f * lg), g127 = exp2f(127.f * lg);
    const int srow = tid >> 4, sch = tid & 15;
    const char* gbase = (const char*)(PROJ + rowbase * NIN + h * 128);
    const unsigned soff = (unsigned)(srow * NIN + sch * 8) * 2u;
    const unsigned qoff = (unsigned)((16 * w + l15) * NIN + C_RQ + 8 * g) * 2u;
    const unsigned toff = (unsigned)((16 * w + l15) * NIN + C_RG + 4 * g) * 2u;
    const float qscale = exp2f(lg * (float)(16 * w + l15));
    u32x4 sk[4], sv[4];
#define R_LOAD(n) do { const char* kb_ = gbase + ((size_t)(128 * (n)) * NIN + C_RK) * 2; const char* vb_ = gbase + ((size_t)(128 * (n)) * NIN + C_RV) * 2; \
        _Pragma("unroll") for (int i_ = 0; i_ < 4; ++i_) { sk[i_] = *(const u32x4*)(kb_ + (soff + (unsigned)(32 * i_ * NIN * 2))); sv[i_] = *(const u32x4*)(vb_ + (soff + (unsigned)(32 * i_ * NIN * 2))); } } while (0)
#define R_STORE() do { _Pragma("unroll") for (int i_ = 0; i_ < 4; ++i_) { const int row_ = srow + 32 * i_; \
        *(LAS u32x4*)(lds + RT_K + row_ * PR + sch * 16) = scale8(sk[i_], exp2f(-lg * (float)row_)); *(LAS u32x4*)(lds + RT_V + row_ * PT + sch * 16) = sv[i_]; } } while (0)
#define Q_LOAD(n) do { const char* qb_ = gbase + (size_t)(128 * (n)) * NIN * 2; _Pragma("unroll") for (int s_ = 0; s_ < 4; ++s_) qraw[s_] = *(const u32x4*)(qb_ + (qoff + 64u * s_)); } while (0)
    f32x4 Sacc[8];
#pragma unroll
    for (int c = 0; c < 8; ++c) Sacc[c] = (f32x4){0.f, 0.f, 0.f, 0.f};
    for (int i = tid; i < 128 * PR / 16; i += 512) *(LAS u32x4*)(lds + RT_ST + i * 16) = (u32x4){0u, 0u, 0u, 0u};
    u32x4 qraw[4];
    R_LOAD(0); Q_LOAD(0); R_STORE();
    __syncthreads();
    const int tq = (lane & 15) >> 2, tp = lane & 3;
    unsigned b_k = RT_K + l15 * PR + g * 16;
    unsigned b_p = RT_P + (16 * w + l15) * PR + g * 16;
    unsigned b_pw = RT_P + (16 * w + l15) * PR + g * 8;
    unsigned b_kt = RT_K + (8 * g + tq) * PR + tp * 8 + w * 32;
    unsigned b_vt = RT_V + (8 * g + tq) * PT + tp * 8;
    unsigned b_st = RT_ST + l15 * PR + g * 16;
    unsigned b_sw = RT_ST + l15 * PR + (16 * w + 4 * g) * 2;
    for (int n = 0; n < SEQ / 128; ++n) {
        asm volatile("" : "+v"(b_k), "+v"(b_p), "+v"(b_pw), "+v"(b_kt), "+v"(b_vt), "+v"(b_st), "+v"(b_sw));
        bf16x8 Qf[4], Pf[4], KTf[4];
#pragma unroll
        for (int s = 0; s < 4; ++s) Qf[s] = __builtin_bit_cast(bf16x8, scale8(qraw[s], qscale));
#pragma unroll
        for (int jb = 0; jb < 8; ++jb) {
            f32x4 a = (f32x4){0.f, 0.f, 0.f, 0.f};
#pragma unroll
            for (int s = 0; s < 4; ++s) { const bf16x8 kf = *(const LAS bf16x8*)(lds + (b_k + jb * (16 * PR) + s * 64)); a = MFMA16(kf, Qf[s], a); }
            const int ii = 16 * w + l15, jj = 16 * jb + 4 * g;
            u32x2 pw; pw.x = pk2(jj <= ii ? a[0] : 0.f, jj + 1 <= ii ? a[1] : 0.f); pw.y = pk2(jj + 2 <= ii ? a[2] : 0.f, jj + 3 <= ii ? a[3] : 0.f);
            *(LAS u32x2*)(lds + (b_pw + jb * 32)) = pw;
        }
#pragma unroll
        for (int s = 0; s < 4; ++s) { Pf[s] = *(const LAS bf16x8*)(lds + (b_p + s * 64));
            KTf[s] = cat8(lds_tr((const LAS char*)lds + (b_kt + (32 * s) * PR)), lds_tr((const LAS char*)lds + (b_kt + (32 * s + 4) * PR))); }
        f32x4 OT[8];
#pragma unroll
        for (int c = 0; c < 8; ++c) {
            f32x4 o = (f32x4){0.f, 0.f, 0.f, 0.f}, t4 = (f32x4){0.f, 0.f, 0.f, 0.f};
#pragma unroll
            for (int s = 0; s < 4; ++s) {
                const bf16x8 vf = cat8(lds_tr((const LAS char*)lds + (b_vt + (32 * s) * PT + c * 32)), lds_tr((const LAS char*)lds + (b_vt + (32 * s + 4) * PT + c * 32)));
                const bf16x8 stf = *(const LAS bf16x8*)(lds + (b_st + c * (16 * PR) + s * 64));
                o = MFMA16(stf, Qf[s], o); o = MFMA16(vf, Pf[s], o); t4 = MFMA16(KTf[s], vf, t4);
            }
            OT[c] = o; Sacc[c] = Sacc[c] * cdec + t4 * g127;
            __builtin_amdgcn_sched_barrier(0);
        }
        if (n + 1 < SEQ / 128) { Q_LOAD(n + 1); R_LOAD(n + 1); }
        float ss = 0.f;
#pragma unroll
        for (int c = 0; c < 8; ++c) ss += (OT[c][0] * OT[c][0] + OT[c][1] * OT[c][1]) + (OT[c][2] * OT[c][2] + OT[c][3] * OT[c][3]);
        ss += __shfl_xor(ss, 16); ss += __shfl_xor(ss, 32);
        const float rstd = __builtin_amdgcn_rsqf(ss * (1.0f / 128.f) + RMS_EPS);
        const char* rgb = gbase + (size_t)(128 * n) * NIN * 2;
        char* yb = (char*)(Y + (rowbase + (size_t)n * 128) * DM + h * 128); const unsigned yoff = (unsigned)((16 * w + l15) * DM + 4 * g) * 2u;
#pragma unroll
        for (int c = 0; c < 8; ++c) { const u32x2 rg = *(const u32x2*)(rgb + (toff + 32u * c));
            const float r0 = bf_lo(rg.x), r1 = bf_hi(rg.x), r2 = bf_lo(rg.y), r3 = bf_hi(rg.y);
            const float s0 = r0 * __builtin_amdgcn_rcpf(1.f + __expf(-r0)), s1 = r1 * __builtin_amdgcn_rcpf(1.f + __expf(-r1)), s2 = r2 * __builtin_amdgcn_rcpf(1.f + __expf(-r2)), s3 = r3 * __builtin_amdgcn_rcpf(1.f + __expf(-r3));
            u32x2 o; o.x = pk2(OT[c][0] * rstd * s0, OT[c][1] * rstd * s1); o.y = pk2(OT[c][2] * rstd * s2, OT[c][3] * rstd * s3);
            *(u32x2*)(yb + (yoff + 32u * c)) = o; }
        __syncthreads();
#pragma unroll
        for (int c = 0; c < 8; ++c) { u32x2 o; o.x = pk2(Sacc[c][0] * gam, Sacc[c][1] * gam); o.y = pk2(Sacc[c][2] * gam, Sacc[c][3] * gam);
            *(LAS u32x2*)(lds + (b_sw + c * (16 * PR))) = o; }
        if (n + 1 < SEQ / 128) R_STORE();
        __syncthreads();
    }
#undef R_LOAD
#undef R_STORE
#undef Q_LOAD
}

constexpr int P2_NRET = BATCH * 4, P2_NATT = BATCH * 4 * 8, P2_NITEMS = P2_NRET + P2_NATT;
__device__ __forceinline__ void p2_mixers(const Params& P, LAS unsigned char* lds) {
    const int tid = threadIdx.x;
    unsigned* ctl = (unsigned*)(P.ws + WS_CTL);
    volatile LAS int* lctl = (volatile LAS int*)(lds + LDS_MAIN);
    const bf16* PROJ = (const bf16*)(P.ws + WS_PROJ); bf16* Y = (bf16*)(P.ws + WS_H);
    float d1 = 0.f, d2 = 0.f;
    for (int i = 0; i < 64; ++i) { d1 += P.diff_lambda[i] * P.diff_lambda[64 + i]; d2 += P.diff_lambda[128 + i] * P.diff_lambda[192 + i]; }
    const float lam = expf(d1) - expf(d2) + 0.2f;
    for (;;) {
        if (tid == 0) lctl[0] = (int)atomicAdd(ctl + CW_QUEUE, 1u);
        __syncthreads();
        const int item = __builtin_amdgcn_readfirstlane(lctl[0]);
        __syncthreads();
        if (item >= P2_NITEMS) break;
        if (item < P2_NRET) ret_unit(PROJ, Y, item >> 2, item & 3, lds);
        else { const int idx = item - P2_NRET; attn_unit(PROJ, Y, P.diff_subln_g, lam, (idx & 63) >> 2, idx & 3, 7 - (idx >> 6), lds); }
    }
}
#define XB_TMO      128
#define XB_XCNT(j)  (256  + 64 * (j))
#define XB_XSUB(j)  (1280 + 64 * (j))
#define XB_XGEN(j)  (2304 + 64 * (j))
#define XB_TOP      3328
#define XB_TOPGEN   3392
#define XCD_BAR_WORDS 3456
#define XB_SPIN_CAP (1u << 18)

__device__ __forceinline__ unsigned xb_ld(unsigned* p)              { return __hip_atomic_load(p, __ATOMIC_RELAXED, __HIP_MEMORY_SCOPE_AGENT); }
__device__ __forceinline__ unsigned xb_add(unsigned* p, unsigned v) { return __hip_atomic_fetch_add(p, v, __ATOMIC_RELAXED, __HIP_MEMORY_SCOPE_AGENT); }
__device__ __forceinline__ unsigned xb_xcc_id() { return (unsigned)__builtin_amdgcn_s_getreg((3 << 11) | 20) & 0xFu; }
#define XB_SPIN(cond, bar) do { unsigned _sp = 0; while (cond) { __builtin_amdgcn_s_sleep(1); \
    if ((++_sp & 255u) == 0u) { if (xb_ld(&(bar)[XB_TMO])) break; if (_sp > XB_SPIN_CAP) { atomicAdd(&(bar)[XB_TMO], 1u); break; } } } } while (0)

struct XcdBarrier {
    unsigned* bar; unsigned x;
    volatile LAS unsigned* st;
};

__device__ __forceinline__ XcdBarrier xcd_barrier_post(unsigned* bar, volatile LAS unsigned* st) {
    XcdBarrier b; b.bar = bar; b.x = xb_xcc_id(); b.st = st;
    if (threadIdx.x == 0) (void)xb_add(&bar[XB_XCNT(b.x)], 1u);
    return b;
}
__device__ __forceinline__ void xcd_barrier_complete(unsigned* bar, unsigned x, unsigned& nloc, unsigned& nx) {
    const unsigned G = gridDim.x * gridDim.y * gridDim.z;
    unsigned sum, cnt, mine, sp = 0u;
    for (;;) {
        sum = 0u; cnt = 0u; mine = 0u;
#pragma unroll
        for (unsigned j = 0; j < 16; ++j) { const unsigned c = xb_ld(&bar[XB_XCNT(j)]); sum += c; cnt += (c > 0u) ? 1u : 0u; mine = (j == x) ? c : mine; }
        if (sum == G) break;
        __builtin_amdgcn_s_sleep(1);
        if ((++sp & 255u) == 0u) { if (xb_ld(&bar[XB_TMO])) break; if (sp > XB_SPIN_CAP) { atomicAdd(&bar[XB_TMO], 1u); break; } }
    }
    nloc = mine > 0u ? mine : 1u; nx = cnt > 0u ? cnt : 1u;
}

__device__ __forceinline__ void xcd_barrier(const XcdBarrier& b) {
    asm volatile("s_waitcnt vmcnt(0)" ::: "memory");
    __syncthreads();
    if (threadIdx.x == 0) {
        unsigned* bar = b.bar;
        __builtin_amdgcn_s_waitcnt(0);
        unsigned nloc = b.st[0], nx = b.st[1];
        if (nloc == 0u) { xcd_barrier_complete(bar, b.x, nloc, nx); b.st[0] = nloc; b.st[1] = nx; }
        const unsigned old = xb_add(&bar[XB_XSUB(b.x)], 1u);
        const unsigned gen = old / nloc;
        if (old + 1u == (gen + 1u) * nloc) {
            __builtin_amdgcn_fence(__ATOMIC_RELEASE, "agent");
            asm volatile("s_waitcnt vmcnt(0)" ::: "memory");
            const unsigned og = xb_add(&bar[XB_TOP], 1u);
            const unsigned tg = og / nx;
            if (og + 1u == (tg + 1u) * nx) xb_add(&bar[XB_TOPGEN], 1u);
            else XB_SPIN(xb_ld(&bar[XB_TOPGEN]) == tg, bar);
            __builtin_amdgcn_fence(__ATOMIC_ACQUIRE, "agent");
            xb_add(&bar[XB_XGEN(b.x)], 1u);
            asm volatile("s_waitcnt vmcnt(0)" ::: "memory");
        } else {
            XB_SPIN(xb_ld(&bar[XB_XGEN(b.x)]) == gen, bar);
            __builtin_amdgcn_fence(__ATOMIC_ACQUIRE, "agent");
            asm volatile("s_waitcnt vmcnt(0)" ::: "memory");
        }
    }
    __syncthreads();
}
__device__ __forceinline__ int ord_key(float s) { const int b = __float_as_int(s); return b ^ ((b >> 31) & 0x7fffffff); }
__device__ __forceinline__ float ord_val(int k) { return __int_as_float(k ^ ((k >> 31) & 0x7fffffff)); }
__device__ __forceinline__ int med3i(int a, int b, int c) { int r; asm("v_med3_i32 %0, %1, %2, %3" : "=v"(r) : "v"(a), "v"(b), "v"(c)); return r; }
__device__ __forceinline__ int imax(int a, int b) { return a > b ? a : b; }
__device__ __forceinline__ int imin(int a, int b) { return a < b ? a : b; }
#define INS16(L, x) do { const int x_ = (x); _Pragma("unroll") for (int i_ = 15; i_ >= 1; --i_) L[i_] = med3i(L[i_ - 1], L[i_], x_); L[0] = imax(L[0], x_); } while (0)
__device__ __forceinline__ void merge_halves16(int (&L)[16]) {
    int c[16];
#pragma unroll
    for (int i = 0; i < 8; ++i) {
        auto r0 = __builtin_amdgcn_permlane32_swap((unsigned)L[i], (unsigned)L[15 - i], false, false);
        auto r1 = __builtin_amdgcn_permlane32_swap((unsigned)L[15 - i], (unsigned)L[i], false, false);
        const bool hi = (threadIdx.x & 32) != 0;
        const int pa_i = hi ? (int)r1[0] : (int)r0[1], pa_15i = hi ? (int)r0[0] : (int)r1[1];
        c[i] = imax(L[i], pa_15i); c[15 - i] = imax(L[15 - i], pa_i);
    }
#define BSTAGE(d) _Pragma("unroll") for (int i = 0; i < 16; ++i) if ((i & (d)) == 0) { const int a = c[i], b = c[i + (d)]; c[i] = imax(a, b); c[i + (d)] = imin(a, b); }
    BSTAGE(8) BSTAGE(4) BSTAGE(2) BSTAGE(1)
#undef BSTAGE
#pragma unroll
    for (int i = 0; i < 16; ++i) L[i] = c[i];
}
__device__ __forceinline__ float dpp_add(float v, const int ctrl_sel) {
    int m;
    if (ctrl_sel == 0) m = __builtin_amdgcn_update_dpp(0, __float_as_int(v), 0xB1, 0xf, 0xf, false);
    else if (ctrl_sel == 1) m = __builtin_amdgcn_update_dpp(0, __float_as_int(v), 0x4E, 0xf, 0xf, false);
    else if (ctrl_sel == 2) m = __builtin_amdgcn_update_dpp(0, __float_as_int(v), 0x141, 0xf, 0xf, false);
    else m = __builtin_amdgcn_update_dpp(0, __float_as_int(v), 0x128, 0xf, 0xf, false);
    return v + __int_as_float(m);
}
__device__ __forceinline__ float dot2bf(unsigned a, unsigned b, float acc) {
    typedef __bf16 bf2 __attribute__((ext_vector_type(2)));
    return __builtin_amdgcn_fdot2_f32_bf16(__builtin_bit_cast(bf2, a), __builtin_bit_cast(bf2, b), acc, false);
}
__device__ __forceinline__ float dot8(u32x4 a, u32x4 b, float acc) {
    const unsigned a0 = a.x, a1 = a.y, a2 = a.z, a3 = a.w, b0 = b.x, b1 = b.y, b2 = b.z, b3 = b.w;
    acc = dot2bf(a0, b0, acc); acc = dot2bf(a1, b1, acc); acc = dot2bf(a2, b2, acc); acc = dot2bf(a3, b3, acc);
    return acc;
}
#define AXPY8(accp, wk, v) do { (accp)[0] += (wk) * bf_lo((v).x); (accp)[1] += (wk) * bf_hi((v).x); (accp)[2] += (wk) * bf_lo((v).y); (accp)[3] += (wk) * bf_hi((v).y); \
        (accp)[4] += (wk) * bf_lo((v).z); (accp)[5] += (wk) * bf_hi((v).z); (accp)[6] += (wk) * bf_lo((v).w); (accp)[7] += (wk) * bf_hi((v).w); } while (0)


__device__ __forceinline__ void p5_scores(const Params& P, LAS unsigned char* lds) {
    int tid = threadIdx.x; asm volatile("" : "+v"(tid));
    const int lane = tid & 63, r32 = lane & 31, hi = lane >> 5;
    const int w = __builtin_amdgcn_readfirstlane(tid >> 6), tg = w >> 1, ph = w & 1;
    const int tok0 = blockIdx.x * 128;
    const bf16* SKb = (const bf16*)(P.ws + WS_SK); const bf16* Qb = (const bf16*)(P.ws + WS_Q);
    u32x2* ENT = (u32x2*)(P.ws + WS_H);
    LAS int* lists = (LAS int*)(lds + 131072);
    u32x4 st[8];
#define S_LOAD(h) do { _Pragma("unroll") for (int i_ = 0; i_ < 8; ++i_) { const int n_ = tid + 512 * i_; st[i_] = *(const u32x4*)(SKb + ((size_t)(h) * 256 + (n_ >> 4)) * 128 + (n_ & 15) * 8); } } while (0)
#define S_STORE(buf) do { _Pragma("unroll") for (int i_ = 0; i_ < 8; ++i_) { const int n_ = tid + 512 * i_; *(LAS u32x4*)(lds + (buf) * 65536 + (n_ >> 11) * 32768 + off_b((n_ >> 4) & 127, n_ & 15)) = st[i_]; } } while (0)
    S_LOAD(0); S_STORE(0); S_LOAD(1);
    const bf16* qrow0 = Qb + (size_t)(tok0 + 32 * tg + r32) * NQ + ph * 128 + 8 * hi;
    bf16x8 qf[8];
#pragma unroll
    for (int ks = 0; ks < 8; ++ks) qf[ks] = *(const bf16x8*)(qrow0 + 16 * ks);
    __syncthreads();
    for (int h = 0; h < 8; ++h) {
        const int cur = h & 1;
        int L[16];
        {
            f32x16 acc[4];
#pragma unroll
            for (int kb = 0; kb < 4; ++kb)
#pragma unroll
                for (int r = 0; r < 16; ++r) acc[kb][r] = 0.f;
            const LAS unsigned char* SKl = lds + cur * 65536 + ph * 32768;
#pragma unroll
            for (int ks = 0; ks < 8; ++ks)
#pragma unroll
                for (int kb = 0; kb < 4; ++kb) { const bf16x8 a = *(const LAS bf16x8*)(SKl + off_b(32 * kb + r32, 2 * ks + hi)); acc[kb] = MFMA32(a, qf[ks], acc[kb]); }
            asm volatile("" : "+v"(acc[0]), "+v"(acc[1]), "+v"(acc[2]), "+v"(acc[3]));
            {   const bf16* qn = qrow0 + ((h + 1) & 7) * 256;
#pragma unroll
                for (int ks = 0; ks < 8; ++ks) qf[ks] = *(const bf16x8*)(qn + 16 * ks); }
#pragma unroll
            for (int i = 0; i < 16; ++i) L[i] = (int)0x80000000;
#pragma unroll
            for (int kb = 0; kb < 4; ++kb)
#pragma unroll
                for (int r = 0; r < 16; ++r) { const int key = 32 * kb + (r & 3) + 8 * (r >> 2) + 4 * hi; const int x = (ord_key(acc[kb][r]) & ~127) | key; INS16(L, x); }
        }
        merge_halves16(L);
        if (hi == 0) { LAS int* lp = lists + ((tg * 2 + ph) * 32 + r32) * 16;
#pragma unroll
            for (int i = 0; i < 4; ++i) *(LAS u32x4*)(lp + 4 * i) = (u32x4){(unsigned)L[4 * i], (unsigned)L[4 * i + 1], (unsigned)L[4 * i + 2], (unsigned)L[4 * i + 3]}; }
        if (h + 1 < 8) { S_STORE(cur ^ 1); if (h + 2 < 8) S_LOAD(h + 2); }
        __syncthreads();
        if (ph == 0) {
            const LAS int* la = lists + ((tg * 2 + 0) * 32 + r32) * 16; const LAS int* lb = lists + ((tg * 2 + 1) * 32 + r32) * 16;
            float A[16], B[16];
            {   int bl[16];
#pragma unroll
                for (int i = 0; i < 4; ++i) { const u32x4 v = *(const LAS u32x4*)(lb + 4 * i); bl[4 * i] = (int)v.x; bl[4 * i + 1] = (int)v.y; bl[4 * i + 2] = (int)v.z; bl[4 * i + 3] = (int)v.w; }
#pragma unroll
                for (int i = 0; i < 16; ++i) { const float av = ord_val(L[i] & ~127), bv = ord_val(bl[i] & ~127); A[i] = hi ? bv : av; B[i] = hi ? av : bv; } }
            int C[16];
#pragma unroll
            for (int i = 0; i < 16; ++i) C[i] = (int)0x80000000;
#define CAND(i, j) do { const float v_ = A[i] + B[j]; const int code_ = hi ? ((j) * 16 + (i)) : ((i) * 16 + (j)); const int x2_ = (ord_key(v_) & ~255) | code_; INS16(C, x2_); } while (0)
#pragma unroll
            for (int j = 1; j < 16; ++j) CAND(0, j);
#pragma unroll
            for (int j = 2; j < 8; ++j) CAND(1, j);
            CAND(2, 3); CAND(2, 4);
            {
                const float v0 = hi ? (A[2] + B[2]) : (A[0] + B[0]), v1 = hi ? (A[3] + B[3]) : (A[1] + B[1]);
                const int x0 = (ord_key(v0) & ~255) | (hi ? 0x22 : 0x00), x1 = (ord_key(v1) & ~255) | (hi ? 0x33 : 0x11);
                INS16(C, x0); INS16(C, x1); }
#undef CAND
            merge_halves16(C);
            float gsum = 0.f, e[16];
            const float vmax = ord_val(C[0] & ~255);
#pragma unroll
            for (int i = 0; i < 16; ++i) { e[i] = __expf(ord_val(C[i] & ~255) - vmax); gsum += e[i]; }
            const float ginv = 1.0f / gsum;
            u32x2* ep = ENT + (size_t)(tok0 + 32 * tg + r32) * 128 + h * 16 + hi * 8;
            int Cs[8]; float Gs[8];
#pragma unroll
            for (int i = 0; i < 8; ++i) { int c0 = C[i], c1 = C[i + 8]; float e0 = e[i], e1 = e[i + 8]; asm volatile("" : "+v"(c0), "+v"(c1), "+v"(e0), "+v"(e1)); Cs[i] = hi ? c1 : c0; Gs[i] = (hi ? e1 : e0) * ginv; }
#pragma unroll
            for (int i = 0; i < 8; i += 2) {
                u32x4 o;
                { const int code = Cs[i] & 255; const int i1 = la[code >> 4] & 127, i2 = lb[code & 15] & 127; o.x = (unsigned)(i1 * 128 + i2); o.y = __float_as_uint(Gs[i]); }
                { const int code = Cs[i + 1] & 255; const int i1 = la[code >> 4] & 127, i2 = lb[code & 15] & 127; o.z = (unsigned)(i1 * 128 + i2); o.w = __float_as_uint(Gs[i + 1]); }
                *(u32x4*)(ep + i) = o;
            }
        }
        __syncthreads();
    }
#undef S_LOAD
#undef S_STORE
}
__device__ __forceinline__ void fp8x16_to_f32(u32x4 v, float (&f)[16]) {
#pragma unroll
    for (int j = 0; j < 4; ++j) { const int wv_ = (int)v[j]; const f32x2 lo = __builtin_amdgcn_cvt_pk_f32_fp8(wv_, false), hi = __builtin_amdgcn_cvt_pk_f32_fp8(wv_, true);
        f[4 * j] = lo.x; f[4 * j + 1] = lo.y; f[4 * j + 2] = hi.x; f[4 * j + 3] = hi.y; }
}
constexpr int CW_PACE = 65536;
__device__ __forceinline__ void xcc_pace(unsigned* ctl, const XcdBarrier& b, unsigned step) {
    __syncthreads();
    if (threadIdx.x == 0) {
        unsigned* c = ctl + CW_PACE + 64 * b.x; const unsigned nloc = b.st[0];
        if (nloc != 0u) { xb_add(c, 1u); const unsigned want = (step + 1u) * nloc; unsigned sp = 0;
            while (xb_ld(c) < want) { __builtin_amdgcn_s_sleep(1); if (++sp > (1u << 16)) break; } }
    }
    __syncthreads();
}
#define P6_REP(k) (32 * ((k) >> 2) + 16 * (((k) >> 1) & 1) + 8 * ((k) & 1))
__device__ __forceinline__ void p6_gather(const Params& P, LAS unsigned char* lds, const XcdBarrier& xbar) {
    int tid = threadIdx.x; asm volatile("" : "+v"(tid));
    const int lane = tid & 63, l7 = lane & 7;
    const int w = __builtin_amdgcn_readfirstlane(tid >> 6);
    const int tok0 = blockIdx.x * 128;
    const u32x2* ENT = (const u32x2*)(P.ws + WS_H);
    const bf16* XG = (const bf16*)(P.ws + WS_XG); const unsigned char* U8 = P.ws + WS_U; const unsigned char* V8 = P.ws + WS_V;
    const float* SU = (const float*)(P.ws + WS_SU); const float* SV = (const float*)(P.ws + WS_SV);
    const float* RSS = (const float*)(P.ws + WS_RSS);
    const int kk = 4 * (lane >> 5) + 2 * ((lane >> 4) & 1) + ((lane >> 3) & 1);
    const unsigned xsb = (unsigned)w * 8192u + (unsigned)lane * 16u;
    const unsigned ssb = 65536u + (unsigned)w * 8192u;
    const unsigned ska = ssb + (unsigned)kk * 8u;
    const unsigned skv = ssb + (unsigned)l7 * 8u;
    const unsigned rowoff = 16u * (unsigned)lane;
    xcd_barrier(xbar);
    unsigned pace_step = 0;
    for (int r = 0; r < 2; ++r) {
        if (r > 0) xcc_pace((unsigned*)(P.ws + WS_CTL), xbar, pace_step++);
        float rstd[8];
#pragma unroll
        for (int t = 0; t < 8; ++t) {
            const size_t tok = (size_t)tok0 + 64 * r + 8 * w + t;
            const u32x4 e4 = ((const u32x4*)ENT)[tok * 64 + lane];
            float xscale;
            {
                const u32x4 xa = *(const u32x4*)(XG + tok * DM + 16 * lane), xb = *(const u32x4*)(XG + tok * DM + 16 * lane + 8); float xf[16];
#pragma unroll
                for (int j = 0; j < 4; ++j) { xf[2 * j] = bf_lo(xa[j]); xf[2 * j + 1] = bf_hi(xa[j]); xf[8 + 2 * j] = bf_lo(xb[j]); xf[8 + 2 * j + 1] = bf_hi(xb[j]); }
                float mx = 0.f;
#pragma unroll
                for (int i = 0; i < 16; ++i) mx = fmaxf(mx, fabsf(xf[i]));
                mx = wave_max_fast(mx);
                const float qs = mx > 0.f ? 127.f / mx : 1.f; u32x4 xq;
#pragma unroll
                for (int j = 0; j < 4; ++j) { const int b0 = (int)rintf(xf[4 * j] * qs), b1 = (int)rintf(xf[4 * j + 1] * qs), b2 = (int)rintf(xf[4 * j + 2] * qs), b3 = (int)rintf(xf[4 * j + 3] * qs);
                    xq[j] = ((unsigned)b0 & 255u) | (((unsigned)b1 & 255u) << 8) | (((unsigned)b2 & 255u) << 16) | (((unsigned)b3 & 255u) << 24); }
                *(LAS u32x4*)(lds + xsb + t * 1024) = xq; xscale = mx > 0.f ? mx * (1.0f / 127.f) : 1.f; }
            const f32x4* rp = (const f32x4*)(RSS + tok * 16); const f32x4 s0 = rp[0], s1 = rp[1], s2 = rp[2], s3 = rp[3];
            const float ssq = ((s0[0] + s0[1]) + (s0[2] + s0[3])) + ((s1[0] + s1[1]) + (s1[2] + s1[3])) + ((s2[0] + s2[1]) + (s2[2] + s2[3])) + ((s3[0] + s3[1]) + (s3[2] + s3[3]));
            rstd[t] = (1.0f / sqrtf(ssq * (1.0f / DM) + RMS_EPS)) * xscale;
            const unsigned bA = e4.x >> 10, bB = e4.z >> 10; int posA = 0, posB = 0, base = 0;
            for (int s = 0; s < 16; ++s) {
                const unsigned long long mA = __ballot(bA == (unsigned)s), mB = __ballot(bB == (unsigned)s);
                const int cA = __popcll(mA), cB = __popcll(mB);
                const int rA = (int)__builtin_amdgcn_mbcnt_hi((unsigned)(mA >> 32), __builtin_amdgcn_mbcnt_lo((unsigned)mA, 0u));
                const int rB = (int)__builtin_amdgcn_mbcnt_hi((unsigned)(mB >> 32), __builtin_amdgcn_mbcnt_lo((unsigned)mB, 0u));
                if (bA == (unsigned)s) posA = base + rA;
                if (bB == (unsigned)s) posB = base + cA + rB;
                base += cA + cB;
            }
            *(LAS u32x2*)(lds + ssb + t * 1024 + posA * 8) = (u32x2){e4.x, e4.y}; *(LAS u32x2*)(lds + ssb + t * 1024 + posB * 8) = (u32x2){e4.z, e4.w};
        }
        {   u32x4 ua[8]; u32x2 entN; float suN, svN;
#define PA_PRE(B, T) do { entN = *(const LAS u32x2*)(lds + ska + (T) * 1024 + (B) * 64); suN = SU[entN.x]; svN = SV[entN.x]; \
            _Pragma("unroll") for (int k = 0; k < 8; ++k) { const unsigned ex_ = (unsigned)__builtin_amdgcn_readlane((int)entN.x, P6_REP(k)); ua[k] = *(const u32x4*)(U8 + (ex_ * 1024u + rowoff)); } } while (0)
#define PA_BODY(B, T, NB, NT) do { \
            const u32x2 ent = entN; const float suk = suN, svk = svN; \
            const u32x4 xq = *(const LAS u32x4*)(lds + xsb + (T) * 1024); \
            int d[8]; \
            _Pragma("unroll") for (int k = 0; k < 8; ++k) d[k] = __builtin_amdgcn_sdot4((int)ua[k].x, (int)xq.x, __builtin_amdgcn_sdot4((int)ua[k].y, (int)xq.y, __builtin_amdgcn_sdot4((int)ua[k].z, (int)xq.z, __builtin_amdgcn_sdot4((int)ua[k].w, (int)xq.w, 0, false), false), false), false); \
            asm volatile("" : "+v"(d[0]), "+v"(d[1]), "+v"(d[2]), "+v"(d[3]), "+v"(d[4]), "+v"(d[5]), "+v"(d[6]), "+v"(d[7])); \
            PA_PRE(NB, NT);     \
            int s4[4], t2[2]; \
            _Pragma("unroll") for (int k = 0; k < 4; ++k) { auto rr = __builtin_amdgcn_permlane32_swap((unsigned)d[k], (unsigned)d[k + 4], false, false); s4[k] = (int)rr[0] + (int)rr[1]; } \
            _Pragma("unroll") for (int k = 0; k < 2; ++k) { auto rr = __builtin_amdgcn_permlane16_swap((unsigned)s4[k], (unsigned)s4[k + 2], false, false); t2[k] = (int)rr[0] + (int)rr[1]; } \
            const bool b3 = (lane & 8) != 0; \
            const int keep = b3 ? t2[1] : t2[0], give = b3 ? t2[0] : t2[1]; \
            int di = keep + __builtin_amdgcn_update_dpp(0, give, 0x128, 0xf, 0xf, false); \
            di += __builtin_amdgcn_update_dpp(0, di, 0xB1, 0xf, 0xf, false); di += __builtin_amdgcn_update_dpp(0, di, 0x4E, 0xf, 0xf, false); di += __builtin_amdgcn_update_dpp(0, di, 0x141, 0xf, 0xf, false); \
            const float a = rstd[T] * suk * (float)di; \
            const float wv = __uint_as_float(ent.y) * svk * (0.5f * a * (1.0f + erff(a * 0.70710678118654752f))); \
            if ((lane & 7) == 0) *(LAS float*)(lds + ska + (T) * 1024 + (B) * 64 + 4) = wv;     \
            __builtin_amdgcn_sched_barrier(0); \
        } while (0)
            {
            PA_PRE(0, 0);
#pragma unroll 1
            for (int b = 0; b < 16; ++b) {
                PA_BODY(b, 0, b, 1); PA_BODY(b, 1, b, 2); PA_BODY(b, 2, b, 3); PA_BODY(b, 3, b, 4);
                PA_BODY(b, 4, b, 5); PA_BODY(b, 5, b, 6); PA_BODY(b, 6, b, 7);
                PA_BODY(b, 7, (b + 1) & 15, 0);
            }
            }
#undef PA_PRE
#undef PA_BODY
        }
        asm volatile("s_waitcnt vmcnt(0) lgkmcnt(0)" ::: "memory");
        float acc[8][16];
#pragma unroll
        for (int t = 0; t < 8; ++t)
#pragma unroll
            for (int i = 0; i < 16; ++i) acc[t][i] = 0.f;
        {   u32x4 va[8]; u32x2 evN;
#define PB_ENT(B, T) do { evN = *(const LAS u32x2*)(lds + skv + (T) * 1024 + (B) * 64); } while (0)
#define PB_LDV(k) do { const unsigned ex_ = (unsigned)__builtin_amdgcn_readlane((int)evN.x, (k)); va[k] = *(const u32x4*)(V8 + (ex_ * 1024u + rowoff)); } while (0)
#define PB_BODY(B, T, NB, NT) do { float (&accT)[16] = acc[T]; \
            const float wvv = __uint_as_float(evN.y);     \
            PB_ENT(NB, NT); \
            _Pragma("unroll") for (int k = 0; k < 8; ++k) { \
                const float wk_ = __int_as_float(__builtin_amdgcn_readlane(__float_as_int(wvv), k)); float vf_[16]; fp8x16_to_f32(va[k], vf_); \
                _Pragma("unroll") for (int i = 0; i < 16; ++i) accT[i] += wk_ * vf_[i]; \
                asm volatile("" : "+v"(accT[0]), "+v"(accT[1]), "+v"(accT[2]), "+v"(accT[3]), "+v"(accT[4]), "+v"(accT[5]), "+v"(accT[6]), "+v"(accT[7]), "+v"(accT[8]), "+v"(accT[9]), "+v"(accT[10]), "+v"(accT[11]), "+v"(accT[12]), "+v"(accT[13]), "+v"(accT[14]), "+v"(accT[15])); \
                PB_LDV(k); } \
        } while (0)
            {
            PB_ENT(0, 0);
#pragma unroll
            for (int k = 0; k < 8; ++k) PB_LDV(k);
#pragma unroll 1
            for (int b = 0; b < 16; ++b) {
                PB_BODY(b, 0, b, 1); PB_BODY(b, 1, b, 2); PB_BODY(b, 2, b, 3); PB_BODY(b, 3, b, 4);
                PB_BODY(b, 4, b, 5); PB_BODY(b, 5, b, 6); PB_BODY(b, 6, b, 7);
                PB_BODY(b, 7, (b + 1) & 15, 0);
            }
            }
#undef PB_ENT
#undef PB_LDV
#undef PB_BODY
        }
#pragma unroll
        for (int t = 0; t < 8; ++t) {
            const size_t tok = (size_t)tok0 + 64 * r + 8 * w + t;
            float* orow = P.out + tok * DM + 16 * lane; const float* fg = P.final_norm_g + 16 * lane;
            const u32x4 ra = *(const u32x4*)(XG + tok * DM + 16 * lane), rb = *(const u32x4*)(XG + tok * DM + 16 * lane + 8);
            f32x4 xr[4]; float ss = 0.f;
            xr[0] = (f32x4){bf_lo(ra.x), bf_hi(ra.x), bf_lo(ra.y), bf_hi(ra.y)}; xr[1] = (f32x4){bf_lo(ra.z), bf_hi(ra.z), bf_lo(ra.w), bf_hi(ra.w)};
            xr[2] = (f32x4){bf_lo(rb.x), bf_hi(rb.x), bf_lo(rb.y), bf_hi(rb.y)}; xr[3] = (f32x4){bf_lo(rb.z), bf_hi(rb.z), bf_lo(rb.w), bf_hi(rb.w)};
#pragma unroll
            for (int j = 0; j < 4; ++j) { xr[j] += (f32x4){acc[t][4 * j], acc[t][4 * j + 1], acc[t][4 * j + 2], acc[t][4 * j + 3]};
                ss += (xr[j][0] * xr[j][0] + xr[j][1] * xr[j][1]) + (xr[j][2] * xr[j][2] + xr[j][3] * xr[j][3]); }
            const float rs = 1.0f / sqrtf(wave_sum_fast(ss) * (1.0f / DM) + RMS_EPS);
#pragma unroll
            for (int j = 0; j < 4; ++j) *(f32x4*)(orow + 4 * j) = xr[j] * rs * *(const f32x4*)(fg + 4 * j);
        }
    }
}
constexpr int CW_BAR = 4096;
constexpr int NPHASE = 6;
__global__ void __launch_bounds__(512, 2) fwd(Params P) {
    __shared__ __attribute__((aligned(16))) unsigned char lds_raw[LDS_BYTES];
    LAS unsigned char* lds = (LAS unsigned char*)lds_raw;
    const int tid = threadIdx.x, lane = tid & 63, wave = __builtin_amdgcn_readfirstlane(tid >> 6);
    const int lo = P.ph_lo, hi = P.ph_hi, G = gridDim.x;
#define IN(k) (lo <= (k) && (k) < hi)
#define SEAM(k) do { if (IN(k) && IN((k) + 1)) { if ((k) == 2) cg::this_grid().sync(); else xcd_barrier(xbar); } } while (0)
    bf16* WinT = (bf16*)(P.ws + WS_WIN); bf16* WoutT = (bf16*)(P.ws + WS_WOUT); bf16* WqT = (bf16*)(P.ws + WS_WQ);
    bf16* Hb = (bf16*)(P.ws + WS_H); bf16* PROJ = (bf16*)(P.ws + WS_PROJ); bf16* XG = (bf16*)(P.ws + WS_XG); bf16* Qb = (bf16*)(P.ws + WS_Q);
    float* RSS = (float*)(P.ws + WS_RSS);
    if (tid < 16) ((volatile LAS unsigned*)(lds + LDS_MAIN))[tid] = 0u;
    __syncthreads();
    XcdBarrier xbar = xcd_barrier_post((unsigned*)(P.ws + WS_CTL) + CW_BAR, (volatile LAS unsigned*)(lds + LDS_MAIN + 32));

    if (IN(0)) { p0_prologue(P, lds, wave, lane);
#if defined(DUP_PHASE) && DUP_PHASE == 0
        p0_prologue(P, lds, wave, lane);
#endif
        SEAM(0); }
    if (IN(1)) {
        pg8::Gemm g{Hb, WinT, MTOK, NIN, DM}; pg8::StaticOrder S; S.init(MTOK, NIN, G, (int)blockIdx.x);
        pg8::EpiProj E{PROJ};
        pg8::gemm_phase<pg8::EpiProj, pg8::StaticOrder, true, true>(lds, g, S, E);
#if defined(DUP_PHASE) && DUP_PHASE == 1
        __syncthreads(); pg8::gemm_phase<pg8::EpiProj, pg8::StaticOrder, true, true>(lds, g, S, E);
#endif
        SEAM(1);
    }
    if (IN(2)) { p2_mixers(P, lds); SEAM(2); }
    if (IN(3)) {
        pg8::Gemm g{Hb  , WoutT, MTOK, DM, DM}; pg8::StaticOrder S; S.init(MTOK, DM, G, (int)blockIdx.x);
        pg8::EpiOut E{P.x, XG, RSS};
        pg8::gemm_phase<pg8::EpiOut, pg8::StaticOrder, true, true>(lds, g, S, E);
#if defined(DUP_PHASE) && DUP_PHASE == 3
        __syncthreads(); pg8::gemm_phase<pg8::EpiOut, pg8::StaticOrder, true, true>(lds, g, S, E);
#endif
        SEAM(3);
    }
    if (IN(4)) {
        pg8::Gemm g{XG, WqT, MTOK, NQ, DM}; pg8::StaticOrder S; S.init(MTOK, NQ, G, (int)blockIdx.x);
        pg8::EpiQ E{RSS, Qb};
        pg8::gemm_phase<pg8::EpiQ, pg8::StaticOrder, true, true>(lds, g, S, E);
#if defined(DUP_PHASE) && DUP_PHASE == 4
        __syncthreads(); pg8::gemm_phase<pg8::EpiQ, pg8::StaticOrder, true, true>(lds, g, S, E);
#endif
        SEAM(4);
    }
    if (IN(5)) { p5_scores(P, lds);
#if defined(DUP_PHASE) && DUP_PHASE == 5
        p5_scores(P, lds);
#endif
        p6_gather(P, lds, xbar);
#if defined(DUP_PHASE) && DUP_PHASE == 6
        {
            xcd_barrier(xbar);
            const unsigned char* T0 = P.ws + WS_U; const unsigned char* T1 = P.ws + WS_V;
            unsigned rs = ((unsigned)blockIdx.x * 8u + (unsigned)wave) * 2654435761u + 12345u; unsigned accx = 0;
#if CAL_HALF
            for (int sw = 0; sw < 16; ++sw) { const unsigned char* T = ((sw >> 1) & 1) ? T1 : T0; const unsigned coff = (sw & 1) * 512u + lane * 8u;
                for (int it = 0; it < 512 / CAL_DEPTH; ++it) { u32x2 v[CAL_DEPTH];
#pragma unroll
                    for (int i = 0; i < CAL_DEPTH; ++i) { rs = rs * 1664525u + 1013904223u; const unsigned row = ((unsigned)it * (32u * CAL_DEPTH) + ((rs >> 10) & (CAL_BAND - 1u))) & 16383u; v[i] = *(const u32x2*)(T + (size_t)row * 1024 + coff); }
#pragma unroll
                    for (int i = 0; i < CAL_DEPTH; ++i) accx ^= v[i].x ^ v[i].y; } }
#else
            for (int sw = 0; sw < 8; ++sw) { const unsigned char* T = (sw & 1) ? T1 : T0; const unsigned coff = lane * 16u;
                for (int it = 0; it < 512 / CAL_DEPTH; ++it) { u32x4 v[CAL_DEPTH];
#pragma unroll
                    for (int i = 0; i < CAL_DEPTH; ++i) { rs = rs * 1664525u + 1013904223u; const unsigned row = ((unsigned)it * (32u * CAL_DEPTH) + ((rs >> 10) & (CAL_BAND - 1u))) & 16383u; v[i] = *(const u32x4*)(T + (size_t)row * 1024 + coff); }
#pragma unroll
                    for (int i = 0; i < CAL_DEPTH; ++i) accx ^= v[i].x ^ v[i].y ^ v[i].z ^ v[i].w; } }
#endif
            if (accx == 0x1234567u) P.out[0] = 1.f;
        }
#endif
    }
#undef IN
#undef SEAM
}

extern "C" void kernel_launch(void* const* d_in, const int* in_sizes, int n_in, void* d_out, int out_size, void* d_ws, size_t ws_size, hipStream_t stream) {
    static int grid = 0;
    if (grid == 0) {
        if (n_in != 12 || in_sizes[0] != MTOK * DM || out_size != MTOK * DM || ws_size < WS_END) { fprintf(stderr, "kernel_launch: unexpected shapes (n_in %d, in0 %d, out %d, ws %zu)\n", n_in, n_in > 0 ? in_sizes[0] : -1, out_size, ws_size); grid = -1; return; }
        int dev = 0, cus = 0, per_cu = 0;
        (void)hipGetDevice(&dev); (void)hipDeviceGetAttribute(&cus, hipDeviceAttributeMultiprocessorCount, dev);
        (void)hipOccupancyMaxActiveBlocksPerMultiprocessor(&per_cu, (const void*)fwd, 512, 0);
        (void)hipGetLastError();
        if (per_cu < 1 || cus != 256) { fprintf(stderr, "kernel_launch: occupancy %d, cus %d: need 1 block on each of 256 CUs\n", per_cu, cus); grid = -1; return; }
        grid = cus;
    }
    if (grid < 0) return;
    (void)hipMemsetAsync((char*)d_ws + WS_CTL, 0, CTL_BYTES, stream);
    Params p{};
    p.x = (const float*)d_in[0]; p.norm_mix_g = (const float*)d_in[1]; p.w_in = (const float*)d_in[2]; p.diff_lambda = (const float*)d_in[3];
    p.diff_subln_g = (const float*)d_in[4]; p.w_out = (const float*)d_in[5]; p.norm_ffn_g = (const float*)d_in[6]; p.peer_wq = (const float*)d_in[7];
    p.peer_subkeys = (const float*)d_in[8]; p.peer_u = (const float*)d_in[9]; p.peer_v = (const float*)d_in[10]; p.final_norm_g = (const float*)d_in[11];
    p.out = (float*)d_out; p.ws = (unsigned char*)d_ws;
    p.ph_lo = 0; p.ph_hi = NPHASE;
    void* args[] = {&p};
    hipError_t e = hipLaunchCooperativeKernel((const void*)fwd, dim3(grid), dim3(512), args, 0, stream);
    if (e != hipSuccess) fprintf(stderr, "kernel_launch: cooperative launch failed: %s\n", hipGetErrorString(e));
}
```

```cpp
#include <hip/hip_runtime.h>
#include <hip/hip_cooperative_groups.h>
#include <cstdio>
#include <cstdint>
namespace cg = cooperative_groups;

#define LAS __attribute__((address_space(3)))
typedef unsigned short bf16;
typedef short bf16x8 __attribute__((ext_vector_type(8)));
typedef short s16x4 __attribute__((ext_vector_type(4)));
typedef float f32x4 __attribute__((ext_vector_type(4)));
typedef float f32x2 __attribute__((ext_vector_type(2)));
typedef float f32x16 __attribute__((ext_vector_type(16)));
typedef unsigned u32x4 __attribute__((ext_vector_type(4)));
typedef unsigned u32x2 __attribute__((ext_vector_type(2)));
typedef int i32x2 __attribute__((ext_vector_type(2)));

constexpr int BATCH = 16, SEQ = 2048, DM = 1024, MTOK = BATCH * SEQ;
constexpr int NIN = 3584;
constexpr int C_RQ = 0, C_RK = 512, C_RV = 1024, C_RG = 1536, C_DQ = 2048, C_DK = 2560, C_DV = 3072;
constexpr int NQ = 2048;
constexpr int NEXP = 16384;
constexpr float RMS_EPS = 1e-6f;
constexpr float LOG2E = 1.4426950408889634f;
constexpr float QSCALE2 = 0.125f * LOG2E;
constexpr float RK_SCALE = 0.08838834764831845f;

constexpr size_t MiB = 1u << 20;
constexpr size_t WS_CTL = 0, CTL_BYTES = 1 * MiB;
constexpr size_t WS_WIN = 1 * MiB;
constexpr size_t WS_WOUT = 8 * MiB;
constexpr size_t WS_WQ = 10 * MiB;
constexpr size_t WS_SK = 14 * MiB;
constexpr size_t WS_RSS = 15 * MiB;
constexpr size_t WS_U = 17 * MiB;
constexpr size_t WS_V = 33 * MiB;
constexpr size_t WS_SU = 49 * MiB, WS_SV = 49 * MiB + 65536;
constexpr size_t WS_H = 81 * MiB;
constexpr size_t WS_PROJ = 145 * MiB;
constexpr size_t WS_XG = WS_PROJ;
constexpr size_t WS_Q = WS_PROJ + 64 * MiB;
constexpr size_t WS_END = WS_PROJ + 224 * MiB;
constexpr int CW_QUEUE = 64;

constexpr int LDS_MAIN = 147456;
constexpr int LDS_BYTES = LDS_MAIN + 256;

__device__ __forceinline__ unsigned f2bf(float f) { unsigned u = __builtin_bit_cast(unsigned, f); return (u + 0x7fffu + ((u >> 16) & 1u)) >> 16; }
__device__ __forceinline__ unsigned pk2(float lo, float hi) { typedef __bf16 bf16x2_t __attribute__((ext_vector_type(2))); f32x2 v = {lo, hi}; bf16x2_t b = __builtin_convertvector(v, bf16x2_t); return __builtin_bit_cast(unsigned, b); }
__device__ __forceinline__ float bf_lo(unsigned u) { return __builtin_bit_cast(float, u << 16); }
__device__ __forceinline__ float bf_hi(unsigned u) { return __builtin_bit_cast(float, u & 0xffff0000u); }
__device__ __forceinline__ unsigned off_b(unsigned row, unsigned ch) { return 256u * row + 16u * (ch ^ (((row & 3) << 2) | ((row >> 2) & 3))); }
__device__ __forceinline__ s16x4 lds_tr(const LAS char* p) { typedef short v4i16_t __attribute__((ext_vector_type(4))); return __builtin_bit_cast(s16x4, __builtin_amdgcn_ds_read_tr16_b64_v4i16((LAS v4i16_t*)p)); }
__device__ __forceinline__ bf16x8 cat8(s16x4 lo, s16x4 hi) { return __builtin_shufflevector(lo, hi, 0, 1, 2, 3, 4, 5, 6, 7); }
__device__ __forceinline__ float wave_sum(float v) {
#pragma unroll
    for (int o = 1; o < 64; o <<= 1) v += __shfl_xor(v, o);
    return v;
}
#define DPPF(v, ctrl) __int_as_float(__builtin_amdgcn_update_dpp(0, __float_as_int(v), ctrl, 0xf, 0xf, false))
__device__ __forceinline__ float wave_sum_fast(float v) {
    v += DPPF(v, 0xB1); v += DPPF(v, 0x4E); v += DPPF(v, 0x141); v += DPPF(v, 0x140);
    { auto r = __builtin_amdgcn_permlane16_swap(__float_as_uint(v), __float_as_uint(v), false, false); v = __uint_as_float(r[0]) + __uint_as_float(r[1]); }
    { auto r = __builtin_amdgcn_permlane32_swap(__float_as_uint(v), __float_as_uint(v), false, false); v = __uint_as_float(r[0]) + __uint_as_float(r[1]); }
    return v;
}
__device__ __forceinline__ float wave_max_fast(float v) {
    v = fmaxf(v, DPPF(v, 0xB1)); v = fmaxf(v, DPPF(v, 0x4E)); v = fmaxf(v, DPPF(v, 0x141)); v = fmaxf(v, DPPF(v, 0x140));
    { auto r = __builtin_amdgcn_permlane16_swap(__float_as_uint(v), __float_as_uint(v), false, false); v = fmaxf(__uint_as_float(r[0]), __uint_as_float(r[1])); }
    { auto r = __builtin_amdgcn_permlane32_swap(__float_as_uint(v), __float_as_uint(v), false, false); v = fmaxf(__uint_as_float(r[0]), __uint_as_float(r[1])); }
    return v;
}
namespace pg8 {
#define PG8_LAS __attribute__((address_space(3)))
typedef unsigned short bf16_t;
typedef short bf16x8 __attribute__((ext_vector_type(8)));
typedef float f32x4 __attribute__((ext_vector_type(4)));
typedef unsigned u32x4 __attribute__((ext_vector_type(4)));
constexpr int BM = 256, BK = 64, HALF = 128, HTB = HALF * BK * 2  , STAGE_BYTES = 8 * HTB, NXCD = 8, WGM = 8;

__host__ __device__ __forceinline__ int lds_byte(int r, int c) { const int st = (r >> 4) * 2 + (c >> 5), rr = r & 15, cc = c & 31, ob = rr * 64 + cc * 2; return st * 1024 + (ob ^ (((ob >> 9) & 1) << 5)); }
__host__ __device__ __forceinline__ void stage_rc(int b, int& R, int& C) { const int st = b / 1024, sb = b % 1024, swz = sb ^ (((sb >> 9) & 1) << 5); R = (st >> 1) * 16 + swz / 64; C = (st & 1) * 32 + (swz % 64) / 2; }
__host__ __device__ __forceinline__ int perm32(int rho) { const int n = rho >> 4, i = rho & 15; return 8 * (i >> 2) + 4 * n + (i & 3); }

struct Unit { int pm, pn; };
struct Gemm { const bf16_t* A; const bf16_t* Bt; int M, N, K; };

struct StaticOrder {
    int nM, nN, nwg, G, c;
    __host__ __device__ void init(int M, int N, int G_, int c_) { nM = M / BM; nN = N / BM; nwg = nM * nN; G = G_; c = c_; }
    __host__ __device__ bool next(int i, Unit& u) const {
        const long L = (long)i * G + c; if (L >= nwg) return false;
        int wgid = (int)L; { const int q = nwg / NXCD, r = nwg % NXCD, xcd = wgid % NXCD, off = wgid / NXCD; wgid = (xcd < r ? xcd * (q + 1) : r * (q + 1) + (xcd - r) * q) + off; }
        const int nig = WGM * nN, gid = wgid / nig, fm = gid * WGM, gsz = (nM - fm) < WGM ? (nM - fm) : WGM;
        u.pm = fm + ((wgid % nig) % gsz); u.pn = (wgid % nig) / gsz; return true;
    }
    __device__ __forceinline__ void a_ready(const Unit&) const {}
    __device__ __forceinline__ void done(const Unit&) const {}
};

__device__ __forceinline__ unsigned cvt_pk_bf16(float lo, float hi) { unsigned r; asm volatile("v_cvt_pk_bf16_f32 %0, %1, %2" : "=v"(r) : "v"(lo), "v"(hi)); return r; }
typedef float f32x2 __attribute__((ext_vector_type(2)));
__device__ __forceinline__ f32x2 gelu_pk(f32x2 v) {
    const f32x2 av = __builtin_elementwise_abs(v), d = av * 0.2316418882f + 1.0f;
    f32x2 t; t.x = __builtin_amdgcn_rcpf(d.x); t.y = __builtin_amdgcn_rcpf(d.y);
    f32x2 q = t * 0.5307027145f + (-0.7265760135f); q = q * t + 0.7107068705f; q = q * t + (-0.142248368f); q = q * t + 0.127414796f; q = q * t;
    const f32x2 s = (v * v) * (-0.72134752044f);
    f32x2 e; e.x = __builtin_amdgcn_exp2f(s.x); e.y = __builtin_amdgcn_exp2f(s.y);
    const f32x2 m = v * (q * e), r = v - m;
    f32x2 o; o.x = v.x < 0.f ? m.x : r.x; o.y = v.y < 0.f ? m.y : r.y; return o;
}

template <class Epi, class Sched, bool ALIGN_EPI = false, bool SP2 = false>
__device__ __forceinline__ void gemm_phase(PG8_LAS unsigned char* lds, const Gemm g, const Sched& S, const Epi& E) {
    const int tid = threadIdx.x, wid = __builtin_amdgcn_readfirstlane(tid >> 6), lane = tid & 63, wr = wid >> 2, wc = wid & 3, fr = lane & 15, fq = lane >> 4;
    const int K = g.K, nt = K / BK;
    unsigned voffA[2], voffB[2];
#pragma unroll
    for (int i = 0; i < 2; ++i) { int R, C; stage_rc(tid * 16 + i * 8192, R, C); const int Rb = Epi::PERM ? ((R & ~31) + perm32(R & 31)) : R;
        voffA[i] = (unsigned)(R * K + C) * 2u; voffB[i] = (unsigned)(Rb * K + C) * 2u; }
    const size_t kstep = (size_t)(BK * 2);
    const size_t hstep = (size_t)HALF * K * 2;
    const size_t tstep = 2 * hstep;
    const unsigned ldsw = (unsigned)wid * 1024u;
    const int aoff = lds_byte(wr * 64 + fr, fq * 8), boff = lds_byte(wc * 32 + fr, fq * 8);
#define PG8_SA(b, h) (((b) * 2 + (h)) * HTB)
#define PG8_SB(b, h) ((4 + (b) * 2 + (h)) * HTB)
#define PG8_STAGE(bufoff, gbase, voff) do { _Pragma("unroll") for (int _i = 0; _i < 2; ++_i) \
        __builtin_amdgcn_global_load_lds((const unsigned*)((const char*)(gbase) + (voff)[_i]), (PG8_LAS unsigned*)(lds + (bufoff) + ldsw + _i * 8192), 16, 0, 0); } while (0)
#define PG8_LDA(dst, b, h) do { _Pragma("unroll") for (int m = 0; m < 4; ++m) _Pragma("unroll") for (int k = 0; k < 2; ++k) dst[m][k] = *(const PG8_LAS bf16x8*)(lds + PG8_SA(b, h) + aoff + m * 2048 + k * 1024); } while (0)
#define PG8_LDB(dst, b, h) do { _Pragma("unroll") for (int n = 0; n < 2; ++n) _Pragma("unroll") for (int k = 0; k < 2; ++k) dst[n][k] = *(const PG8_LAS bf16x8*)(lds + PG8_SB(b, h) + boff + n * 2048 + k * 1024); } while (0)
#define PG8_MMA(ai, bj, At, Bt) do { __builtin_amdgcn_s_setprio(1); _Pragma("unroll") for (int m = 0; m < 4; ++m) _Pragma("unroll") for (int n = 0; n < 2; ++n) _Pragma("unroll") for (int k = 0; k < 2; ++k) \
        acc[ai][bj][m][n] = __builtin_amdgcn_mfma_f32_16x16x32_bf16(Bt[n][k], At[m][k], acc[ai][bj][m][n], 0, 0, 0); __builtin_amdgcn_s_setprio(0); } while (0)
#define PG8_WAIT_V(n) asm volatile("s_waitcnt vmcnt(" #n ")" ::: "memory")
#define PG8_WAIT_L(n) asm volatile("s_waitcnt lgkmcnt(" #n ")" ::: "memory")
#define PG8_BAR __builtin_amdgcn_s_barrier()
#define PG8_SCHED __builtin_amdgcn_sched_barrier(0)
    Unit cur, nxt; int ui = 0;
    if (!S.next(0, cur)) return;
    f32x4 acc[2][2][4][2];
#pragma unroll
    for (int a = 0; a < 2; ++a)
#pragma unroll
        for (int b = 0; b < 2; ++b)
#pragma unroll
            for (int m = 0; m < 4; ++m)
#pragma unroll
                for (int n = 0; n < 2; ++n) acc[a][b][m][n] = (f32x4){0.f, 0.f, 0.f, 0.f};
    bf16x8 At[4][2], B0[2][2], B1[2][2];
    const char* cA = (const char*)g.A + (size_t)cur.pm * tstep; const char* cB = (const char*)g.Bt + (size_t)cur.pn * tstep;
    S.a_ready(cur);
    if constexpr (SP2) {
        PG8_STAGE(PG8_SB(0, 0), cB, voffB); PG8_STAGE(PG8_SB(0, 1), cB + hstep, voffB); PG8_STAGE(PG8_SA(0, 0), cA, voffA); PG8_STAGE(PG8_SA(0, 1), cA + hstep, voffA);
        if (wr == 1) PG8_BAR;
        PG8_WAIT_V(2); PG8_BAR;
        PG8_STAGE(PG8_SB(1, 0), cB + kstep, voffB); PG8_STAGE(PG8_SA(1, 0), cA + kstep, voffA); PG8_STAGE(PG8_SB(1, 1), cB + hstep + kstep, voffB);
        PG8_WAIT_V(6); PG8_BAR;
    } else {
        PG8_STAGE(PG8_SB(0, 0), cB, voffB); PG8_STAGE(PG8_SA(0, 0), cA, voffA); PG8_STAGE(PG8_SB(0, 1), cB + hstep, voffB); PG8_STAGE(PG8_SA(0, 1), cA + hstep, voffA);
        if (wr == 1) PG8_BAR;
        PG8_WAIT_V(4); PG8_BAR;
        PG8_STAGE(PG8_SB(1, 0), cB + kstep, voffB); PG8_STAGE(PG8_SA(1, 0), cA + kstep, voffA); PG8_STAGE(PG8_SB(1, 1), cB + hstep + kstep, voffB);
        PG8_WAIT_V(6); PG8_BAR;
    }
    for (;;) {
        const bool has_next = S.next(ui + 1, nxt);
        const char* nA = has_next ? (const char*)g.A + (size_t)nxt.pm * tstep : cA; const char* nB = has_next ? (const char*)g.Bt + (size_t)nxt.pn * tstep : cB;
        for (int t = 0; t < nt; t += 2) {
            const bool last = (t == nt - 2);
            const char* a1 = cA + (size_t)(t + 1) * kstep;
            const char* a2 = last ? nA : cA + (size_t)(t + 2) * kstep; const char* b2 = last ? nB : cB + (size_t)(t + 2) * kstep;
            const char* a3 = a2 + kstep; const char* b3 = b2 + kstep;
            if (last && has_next) S.a_ready(nxt);
            if constexpr (SP2) {
            PG8_LDB(B0, 0, 0); PG8_LDB(B1, 0, 1); PG8_SCHED; PG8_LDA(At, 0, 0); PG8_STAGE(PG8_SA(1, 1), a1 + hstep, voffA);
            PG8_WAIT_V(8); PG8_WAIT_L(0); PG8_BAR; PG8_MMA(0, 0, At, B0); PG8_MMA(0, 1, At, B1); PG8_BAR; PG8_SCHED;
            PG8_LDA(At, 0, 1); PG8_STAGE(PG8_SB(0, 0), b2, voffB); PG8_STAGE(PG8_SB(0, 1), b2 + hstep, voffB); PG8_STAGE(PG8_SA(0, 0), a2, voffA);
            PG8_WAIT_V(8); PG8_WAIT_L(0); PG8_BAR; PG8_MMA(1, 0, At, B0); PG8_MMA(1, 1, At, B1); PG8_BAR; PG8_SCHED;
            PG8_LDB(B0, 1, 0); PG8_LDB(B1, 1, 1); PG8_SCHED; PG8_LDA(At, 1, 0); PG8_STAGE(PG8_SA(0, 1), a2 + hstep, voffA);
            PG8_WAIT_V(8); PG8_WAIT_L(0); PG8_BAR; PG8_MMA(0, 0, At, B0); PG8_MMA(0, 1, At, B1); PG8_BAR; PG8_SCHED;
            PG8_LDA(At, 1, 1); PG8_STAGE(PG8_SB(1, 0), b3, voffB); PG8_STAGE(PG8_SB(1, 1), b3 + hstep, voffB); PG8_STAGE(PG8_SA(1, 0), a3, voffA);
            PG8_WAIT_V(8); PG8_WAIT_L(0); PG8_BAR; PG8_MMA(1, 0, At, B0); PG8_MMA(1, 1, At, B1); PG8_BAR; PG8_SCHED;
            } else {
            PG8_LDB(B0, 0, 0); PG8_SCHED; PG8_LDA(At, 0, 0); PG8_STAGE(PG8_SA(1, 1), a1 + hstep, voffA);
            PG8_WAIT_L(8); PG8_BAR; PG8_WAIT_L(0); PG8_MMA(0, 0, At, B0); PG8_BAR; PG8_SCHED;
            PG8_LDB(B1, 0, 1); PG8_STAGE(PG8_SB(0, 0), b2, voffB);
            PG8_BAR; PG8_WAIT_L(0); PG8_MMA(0, 1, At, B1); PG8_BAR;
            PG8_LDA(At, 0, 1); PG8_STAGE(PG8_SA(0, 0), a2, voffA);
            PG8_BAR; PG8_WAIT_L(0); PG8_MMA(1, 0, At, B0); PG8_BAR; PG8_SCHED;
            PG8_STAGE(PG8_SB(0, 1), b2 + hstep, voffB);
            PG8_WAIT_V(6); PG8_BAR; PG8_MMA(1, 1, At, B1); PG8_BAR;
            PG8_LDB(B0, 1, 0); PG8_SCHED; PG8_LDA(At, 1, 0); PG8_STAGE(PG8_SA(0, 1), a2 + hstep, voffA);
            PG8_WAIT_L(8); PG8_BAR; PG8_WAIT_L(0); PG8_MMA(0, 0, At, B0); PG8_BAR; PG8_SCHED;
            PG8_LDB(B1, 1, 1); PG8_STAGE(PG8_SB(1, 0), b3, voffB);
            PG8_BAR; PG8_WAIT_L(0); PG8_MMA(0, 1, At, B1); PG8_BAR;
            PG8_LDA(At, 1, 1); PG8_STAGE(PG8_SA(1, 0), a3, voffA);
            PG8_BAR; PG8_WAIT_L(0); PG8_MMA(1, 0, At, B0); PG8_BAR; PG8_SCHED;
            PG8_STAGE(PG8_SB(1, 1), b3 + hstep, voffB);
            PG8_WAIT_V(6); PG8_BAR; PG8_MMA(1, 1, At, B1); PG8_BAR;
            }
        }
        if constexpr (ALIGN_EPI) { if (wr == 0) PG8_BAR; }
        if constexpr (!Epi::AFTER_DRAIN) { E(acc, cur, wr, wc, fr, fq); S.done(cur); }
        if (!has_next) break;
#pragma unroll
        for (int a = 0; a < 2; ++a)
#pragma unroll
            for (int b = 0; b < 2; ++b)
#pragma unroll
                for (int m = 0; m < 4; ++m)
#pragma unroll
                    for (int n = 0; n < 2; ++n) acc[a][b][m][n] = (f32x4){0.f, 0.f, 0.f, 0.f};
        cur = nxt; cA = nA; cB = nB; ++ui;
        if constexpr (ALIGN_EPI) { if (wr == 1) PG8_BAR; }
    }
    PG8_WAIT_V(0);
    if constexpr (!ALIGN_EPI) { if (wr == 0) PG8_BAR; }
    PG8_BAR;
    if constexpr (Epi::AFTER_DRAIN) { E.fused(acc, cur, wr, wc, fr, fq, lds, wid, lane); S.done(cur); }
#undef PG8_SA
#undef PG8_SB
#undef PG8_STAGE
#undef PG8_LDA
#undef PG8_LDB
#undef PG8_MMA
#undef PG8_WAIT_V
#undef PG8_WAIT_L
#undef PG8_BAR
#undef PG8_SCHED
}
}
namespace pg8 {
struct EpiProj {
    static constexpr bool PERM = true, AFTER_DRAIN = false;
    bf16_t* O;
    __device__ __forceinline__ void operator()(const f32x4 (&acc)[2][2][4][2], const Unit& u, int wr, int wc, int fr, int fq) const {
        const int row0 = u.pm * BM + wr * 64 + fr, col0 = u.pn * BM + wc * 32 + 8 * fq;
        const float sc = (u.pn == 2 || u.pn == 3) ? RK_SCALE : ((u.pn == 8 || u.pn == 9) ? QSCALE2 : 1.f);
#pragma unroll
        for (int ai = 0; ai < 2; ++ai)
#pragma unroll
            for (int m = 0; m < 4; ++m) { bf16_t* rowp = O + (size_t)(row0 + ai * HALF + m * 16) * NIN + col0;
#pragma unroll
                for (int bj = 0; bj < 2; ++bj) { const f32x4 v0 = acc[ai][bj][m][0] * sc, v1 = acc[ai][bj][m][1] * sc;
                    u32x4 w; w.x = cvt_pk_bf16(v0[0], v0[1]); w.y = cvt_pk_bf16(v0[2], v0[3]); w.z = cvt_pk_bf16(v1[0], v1[1]); w.w = cvt_pk_bf16(v1[2], v1[3]);
                    *(u32x4*)(rowp + bj * HALF) = w; } }
    }
};
struct EpiOut {
    static constexpr bool PERM = true, AFTER_DRAIN = false;
    const float* X; bf16_t* XB; float* RSS;
    __device__ __forceinline__ void operator()(const f32x4 (&acc)[2][2][4][2], const Unit& u, int wr, int wc, int fr, int fq) const {
        const int row0 = u.pm * BM + wr * 64 + fr, col0 = u.pn * BM + wc * 32 + 8 * fq;
#pragma unroll
        for (int ai = 0; ai < 2; ++ai)
#pragma unroll
            for (int m = 0; m < 4; ++m) { const int row = row0 + ai * HALF + m * 16; const size_t off = (size_t)row * DM + col0; float ss = 0.f;
#pragma unroll
                for (int bj = 0; bj < 2; ++bj) {
                    const f32x4 a0 = *(const f32x4*)(X + off + bj * HALF) + acc[ai][bj][m][0], a1 = *(const f32x4*)(X + off + bj * HALF + 4) + acc[ai][bj][m][1];
                    ss += (a0[0] * a0[0] + a0[1] * a0[1]) + (a0[2] * a0[2] + a0[3] * a0[3]) + (a1[0] * a1[0] + a1[1] * a1[1]) + (a1[2] * a1[2] + a1[3] * a1[3]);
                    u32x4 w; w.x = cvt_pk_bf16(a0[0], a0[1]); w.y = cvt_pk_bf16(a0[2], a0[3]); w.z = cvt_pk_bf16(a1[0], a1[1]); w.w = cvt_pk_bf16(a1[2], a1[3]);
                    *(u32x4*)(XB + off + bj * HALF) = w; }
                ss += __shfl_xor(ss, 16); ss += __shfl_xor(ss, 32);
                if (fq == 0) RSS[(size_t)row * 16 + u.pn * 4 + wc] = ss; }
    }
};
struct EpiQ {
    static constexpr bool PERM = true, AFTER_DRAIN = false;
    const float* RSS; bf16_t* Q;
    __device__ __forceinline__ void operator()(const f32x4 (&acc)[2][2][4][2], const Unit& u, int wr, int wc, int fr, int fq) const {
        const int row0 = u.pm * BM + wr * 64 + fr, col0 = u.pn * BM + wc * 32 + 8 * fq;
#pragma unroll
        for (int ai = 0; ai < 2; ++ai)
#pragma unroll
            for (int m = 0; m < 4; ++m) { const int row = row0 + ai * HALF + m * 16;
                const f32x4* rp = (const f32x4*)(RSS + (size_t)row * 16); const f32x4 s0 = rp[0], s1 = rp[1], s2 = rp[2], s3 = rp[3];
                const float ss = ((s0[0] + s0[1]) + (s0[2] + s0[3])) + ((s1[0] + s1[1]) + (s1[2] + s1[3])) + ((s2[0] + s2[1]) + (s2[2] + s2[3])) + ((s3[0] + s3[1]) + (s3[2] + s3[3]));
                const float rstd = 1.0f / sqrtf(ss * (1.0f / DM) + RMS_EPS);
                bf16_t* rowp = Q + (size_t)row * NQ + col0;
#pragma unroll
                for (int bj = 0; bj < 2; ++bj) { const f32x4 v0 = acc[ai][bj][m][0] * rstd, v1 = acc[ai][bj][m][1] * rstd;
                    u32x4 w; w.x = cvt_pk_bf16(v0[0], v0[1]); w.y = cvt_pk_bf16(v0[2], v0[3]); w.z = cvt_pk_bf16(v1[0], v1[1]); w.w = cvt_pk_bf16(v1[2], v1[3]);
                    *(u32x4*)(rowp + bj * HALF) = w; } }
    }
};
}
struct Params {
    const float *x, *norm_mix_g, *w_in, *diff_lambda, *diff_subln_g, *w_out, *norm_ffn_g, *peer_wq, *peer_subkeys, *peer_u, *peer_v, *final_norm_g;
    float* out; unsigned char* ws; int ph_lo, ph_hi;
};
__device__ __forceinline__ void p0_transpose_item(const float* W, int K, int N, bf16* WT, LAS float* scr, int item, int lane, const float* gk = nullptr) {
    const int nblk = N / 32, kb = item / nblk, nb = item % nblk, k0 = 64 * kb, n0 = 32 * nb;
#pragma unroll 8
    for (int i = 0; i < 32; ++i) { const int kk = 2 * i + (lane >> 5); scr[kk * 33 + (lane & 31)] = W[(size_t)(k0 + kk) * N + n0 + (lane & 31)] * (gk ? gk[k0 + kk] : 1.0f); }
    asm volatile("s_waitcnt lgkmcnt(0)" ::: "memory");
    const int c = lane & 7;
#pragma unroll
    for (int j = 0; j < 4; ++j) { const int n = (lane >> 3) + 8 * j; const LAS float* s = scr + (8 * c) * 33 + n;
        u32x4 o; o.x = pk2(s[0 * 33], s[1 * 33]); o.y = pk2(s[2 * 33], s[3 * 33]); o.z = pk2(s[4 * 33], s[5 * 33]); o.w = pk2(s[6 * 33], s[7 * 33]);
        *(u32x4*)(WT + (size_t)(n0 + n) * K + k0 + 8 * c) = o; }
    asm volatile("s_waitcnt lgkmcnt(0)" ::: "memory");
}
__device__ __forceinline__ void p0_convert(const float* src, bf16* dst, size_t n8, int gw, int ngw, int lane) {
    for (size_t g = (size_t)gw * 64 + lane; g < n8; g += (size_t)ngw * 64) {
        const f32x4 a = ((const f32x4*)src)[2 * g], b = ((const f32x4*)src)[2 * g + 1];
        u32x4 o; o.x = pk2(a[0], a[1]); o.y = pk2(a[2], a[3]); o.z = pk2(b[0], b[1]); o.w = pk2(b[2], b[3]);
        ((u32x4*)dst)[g] = o; }
}
__device__ __forceinline__ void p0_fp8_rows(const float* src, unsigned char* dst, float* inv, int gw, int ngw, int lane) {
    float cal; { float one28 = 128.f; asm volatile("" : "+v"(one28)); const int enc = __builtin_amdgcn_cvt_pk_fp8_f32(one28, one28, 0, false); const f32x2 dec = __builtin_amdgcn_cvt_pk_f32_fp8(enc, false); cal = 128.f / dec.x; }
    for (int row0 = gw; row0 < NEXP; row0 += 2 * ngw) {
        f32x4 v[2][4]; float m[2];
#pragma unroll
        for (int q = 0; q < 2; ++q) { const f32x4* sp = (const f32x4*)(src + (size_t)(row0 + q * ngw) * DM + 16 * lane);
#pragma unroll
            for (int j = 0; j < 4; ++j) v[q][j] = sp[j]; }
#pragma unroll
        for (int q = 0; q < 2; ++q) { float mm = 0.f;
#pragma unroll
            for (int j = 0; j < 4; ++j) mm = fmaxf(mm, fmaxf(fmaxf(fabsf(v[q][j][0]), fabsf(v[q][j][1])), fmaxf(fabsf(v[q][j][2]), fabsf(v[q][j][3]))));
#pragma unroll
            for (int o = 1; o < 64; o <<= 1) mm = fmaxf(mm, __shfl_xor(mm, o));
            m[q] = mm; }
#pragma unroll
        for (int q = 0; q < 2; ++q) { const int row = row0 + q * ngw; const float sc = m[q] > 0.f ? 224.f / m[q] : 1.f;
            u32x4 o;
#pragma unroll
            for (int j = 0; j < 4; ++j) { int pk = __builtin_amdgcn_cvt_pk_fp8_f32(v[q][j][0] * sc, v[q][j][1] * sc, 0, false); pk = __builtin_amdgcn_cvt_pk_fp8_f32(v[q][j][2] * sc, v[q][j][3] * sc, pk, true); o[j] = (unsigned)pk; }
            *(u32x4*)(dst + (size_t)row * DM + 16 * lane) = o;
            if (lane == 0) inv[row] = (m[q] > 0.f ? m[q] * (1.0f / 224.f) : 1.f) * cal; }
    }
}
__device__ __forceinline__ void p0_norm_row(const float* xrow, const float* g, bf16* orow, int lane) {
    const f32x4* xr = (const f32x4*)xrow + lane; const f32x4* gr = (const f32x4*)g + lane;
    f32x4 v[4]; float s = 0.f;
#pragma unroll
    for (int j = 0; j < 4; ++j) { v[j] = xr[64 * j]; s += (v[j][0] * v[j][0] + v[j][1] * v[j][1]) + (v[j][2] * v[j][2] + v[j][3] * v[j][3]); }
    const float rstd = 1.0f / sqrtf(wave_sum(s) * (1.f / DM) + RMS_EPS);
    u32x2* o8 = (u32x2*)orow + lane;
#pragma unroll
    for (int j = 0; j < 4; ++j) { const f32x4 gg = gr[64 * j]; u32x2 o; o.x = pk2(v[j][0] * rstd * gg[0], v[j][1] * rstd * gg[1]); o.y = pk2(v[j][2] * rstd * gg[2], v[j][3] * rstd * gg[3]); o8[64 * j] = o; }
}
__device__ __forceinline__ void p0_norm_row2(const float* xrow0, const float* xrow1, const float* g, bf16* orow0, bf16* orow1, int lane) {
    const f32x4* x0 = (const f32x4*)xrow0 + lane; const f32x4* x1 = (const f32x4*)xrow1 + lane; const f32x4* gr = (const f32x4*)g + lane;
    f32x4 a[4], b[4]; float sa = 0.f, sb = 0.f;
#pragma unroll
    for (int j = 0; j < 4; ++j) { a[j] = x0[64 * j]; b[j] = x1[64 * j]; }
#pragma unroll
    for (int j = 0; j < 4; ++j) { sa += (a[j][0] * a[j][0] + a[j][1] * a[j][1]) + (a[j][2] * a[j][2] + a[j][3] * a[j][3]); sb += (b[j][0] * b[j][0] + b[j][1] * b[j][1]) + (b[j][2] * b[j][2] + b[j][3] * b[j][3]); }
    const float ra = 1.0f / sqrtf(wave_sum(sa) * (1.f / DM) + RMS_EPS), rb = 1.0f / sqrtf(wave_sum(sb) * (1.f / DM) + RMS_EPS);
    u32x2* oa = (u32x2*)orow0 + lane; u32x2* ob = (u32x2*)orow1 + lane;
#pragma unroll
    for (int j = 0; j < 4; ++j) { const f32x4 gg = gr[64 * j];
        u32x2 o; o.x = pk2(a[j][0] * ra * gg[0], a[j][1] * ra * gg[1]); o.y = pk2(a[j][2] * ra * gg[2], a[j][3] * ra * gg[3]); oa[64 * j] = o;
        u32x2 q; q.x = pk2(b[j][0] * rb * gg[0], b[j][1] * rb * gg[1]); q.y = pk2(b[j][2] * rb * gg[2], b[j][3] * rb * gg[3]); ob[64 * j] = q; }
}
__device__ __forceinline__ void p0_i8_rows(const float* src, const float* gain, unsigned char* dst, float* inv, int gw, int ngw, int lane) {
    f32x4 gq[4];
#pragma unroll
    for (int j = 0; j < 4; ++j) gq[j] = *(const f32x4*)(gain + 16 * lane + 4 * j);
    for (int row0 = gw; row0 < NEXP; row0 += 2 * ngw) {
        f32x4 v[2][4]; float m[2];
#pragma unroll
        for (int q = 0; q < 2; ++q) { const f32x4* sp = (const f32x4*)(src + (size_t)(row0 + q * ngw) * DM + 16 * lane);
#pragma unroll
            for (int j = 0; j < 4; ++j) v[q][j] = sp[j] * gq[j]; }
#pragma unroll
        for (int q = 0; q < 2; ++q) { float mm = 0.f;
#pragma unroll
            for (int j = 0; j < 4; ++j) mm = fmaxf(mm, fmaxf(fmaxf(fabsf(v[q][j][0]), fabsf(v[q][j][1])), fmaxf(fabsf(v[q][j][2]), fabsf(v[q][j][3]))));
#pragma unroll
            for (int o = 1; o < 64; o <<= 1) mm = fmaxf(mm, __shfl_xor(mm, o));
            m[q] = mm; }
#pragma unroll
        for (int q = 0; q < 2; ++q) { const int row = row0 + q * ngw; const float sc = m[q] > 0.f ? 127.f / m[q] : 1.f;
            u32x4 o;
#pragma unroll
            for (int j = 0; j < 4; ++j) { const int b0 = (int)rintf(v[q][j][0] * sc), b1 = (int)rintf(v[q][j][1] * sc), b2 = (int)rintf(v[q][j][2] * sc), b3 = (int)rintf(v[q][j][3] * sc);
                o[j] = ((unsigned)b0 & 255u) | (((unsigned)b1 & 255u) << 8) | (((unsigned)b2 & 255u) << 16) | (((unsigned)b3 & 255u) << 24); }
            *(u32x4*)(dst + (size_t)row * DM + 16 * lane) = o;
            if (lane == 0) inv[row] = m[q] > 0.f ? m[q] * (1.0f / 127.f) : 1.f; }
    }
}
__device__ __forceinline__ void p0_prologue(const Params& P, LAS unsigned char* lds, int wave, int lane) {
    LAS float* scr = (LAS float*)(lds + wave * 16384);
    const int gw = blockIdx.x * 8 + wave, ngw = gridDim.x * 8;
    constexpr int I_IN = (DM / 64) * (NIN / 32), I_OUT = (DM / 64) * (DM / 32), I_WQ = (DM / 64) * (NQ / 32), NIT = I_IN + I_OUT + I_WQ;
    bf16* WinT = (bf16*)(P.ws + WS_WIN); bf16* WoutT = (bf16*)(P.ws + WS_WOUT); bf16* WqT = (bf16*)(P.ws + WS_WQ);
    for (int it = gw; it < NIT; it += ngw) {
        int r = it;
        if (r < I_IN) { p0_transpose_item(P.w_in, DM, NIN, WinT, scr, r, lane); continue; } r -= I_IN;
        if (r < I_OUT) { p0_transpose_item(P.w_out, DM, DM, WoutT, scr, r, lane); continue; } r -= I_OUT;
        p0_transpose_item(P.peer_wq, DM, NQ, WqT, scr, r, lane, P.norm_ffn_g);
    }
    p0_convert(P.peer_subkeys, (bf16*)(P.ws + WS_SK), (size_t)16 * 128 * 128 / 8, gw, ngw, lane);
    p0_i8_rows(P.peer_u, P.norm_ffn_g, P.ws + WS_U, (float*)(P.ws + WS_SU), gw, ngw, lane);
    p0_fp8_rows(P.peer_v, P.ws + WS_V, (float*)(P.ws + WS_SV), gw, ngw, lane);
    bf16* H = (bf16*)(P.ws + WS_H);
    for (int m = gw; m < MTOK; m += 2 * ngw) p0_norm_row2(P.x + (size_t)m * DM, P.x + (size_t)(m + ngw) * DM, P.norm_mix_g, H + (size_t)m * DM, H + (size_t)(m + ngw) * DM, lane);
}
#define MFMA32(a, b, c) __builtin_amdgcn_mfma_f32_32x32x16_bf16((a), (b), (c), 0, 0, 0)
#define MFMA16(a, b, c) __builtin_amdgcn_mfma_f32_16x16x32_bf16((a), (b), (c), 0, 0, 0)
__device__ __forceinline__ float swap_max(float v) { auto rr = __builtin_amdgcn_permlane32_swap(__float_as_uint(v), __float_as_uint(v), false, false); return fmaxf(__uint_as_float(rr[0]), __uint_as_float(rr[1])); }
__device__ __forceinline__ float swap_add(float v) { auto rr = __builtin_amdgcn_permlane32_swap(__float_as_uint(v), __float_as_uint(v), false, false); return __uint_as_float(rr[0]) + __uint_as_float(rr[1]); }
__device__ __forceinline__ bf16x8 pack8(const f32x16& x, int s) {
    u32x4 p; p.x = pk2(x[8 * s], x[8 * s + 1]); p.y = pk2(x[8 * s + 2], x[8 * s + 3]); p.z = pk2(x[8 * s + 4], x[8 * s + 5]); p.w = pk2(x[8 * s + 6], x[8 * s + 7]);
    return __builtin_bit_cast(bf16x8, p);
}
constexpr float ATT_THR = 8.0f;
constexpr float ATT_NEG = -1.0e30f;

constexpr int PR = 272, PT = 320;
constexpr int AT_Q = 0, AT_KV = 256 * PR, AT_KVSZ = 64 * PR + 64 * PT;
static_assert(AT_KV + 2 * AT_KVSZ <= LDS_MAIN, "attention LDS");
__device__ __forceinline__ void attn_unit(const bf16* PROJ, bf16* Y, const float* subln_g, float lam, int b, int h, int qb, LAS unsigned char* lds) {
    int tid = threadIdx.x; asm volatile("" : "+v"(tid));
    const int lane = tid & 63, r32 = lane & 31, hi = lane >> 5;
    const int w = __builtin_amdgcn_readfirstlane(tid >> 6);
    const size_t rowbase = (size_t)b * SEQ;
    const float slope2 = exp2f(-2.f * (float)(h + 1)) * LOG2E;
    const int srow = tid >> 4, sch = tid & 15;
    const char* gbase = (const char*)(PROJ + rowbase * NIN + h * 128);
    const unsigned soff = (unsigned)(srow * NIN + sch * 8) * 2u;
    {   const char* qb_ = gbase + ((size_t)qb * 256 * NIN + C_DQ) * 2;
#pragma unroll
        for (int i = 0; i < 8; ++i) { const int row = srow + 32 * i; const u32x4 v = *(const u32x4*)(qb_ + (soff + (unsigned)(32 * i * NIN * 2))); *(LAS u32x4*)(lds + AT_Q + row * PR + sch * 16) = v; } }
    u32x4 sk[2], sv[2];
#define A_LOAD(j) do { const char* kb_ = gbase + ((size_t)(64 * (j)) * NIN + C_DK) * 2; const char* vb_ = gbase + ((size_t)(64 * (j)) * NIN + C_DV) * 2; \
        _Pragma("unroll") for (int i_ = 0; i_ < 2; ++i_) { sk[i_] = *(const u32x4*)(kb_ + (soff + (unsigned)(32 * i_ * NIN * 2))); sv[i_] = *(const u32x4*)(vb_ + (soff + (unsigned)(32 * i_ * NIN * 2))); } } while (0)
#define A_STORE(buf) do { _Pragma("unroll") for (int i_ = 0; i_ < 2; ++i_) { \
        *(LAS u32x4*)(lds + AT_KV + (buf) * AT_KVSZ + (srow + 32 * i_) * PR + sch * 16) = sk[i_]; *(LAS u32x4*)(lds + AT_KV + (buf) * AT_KVSZ + 64 * PR + (srow + 32 * i_) * PT + sch * 16) = sv[i_]; } } while (0)
    const int nt = 4 * qb + 4, jd = 4 * qb + (w >> 1);
    const int qpos = qb * 256 + 32 * w + r32;
    unsigned qbase = AT_Q + (32 * w + r32) * PR + hi * 16, kbase = r32 * PR + hi * 16;
    unsigned vbase = 64 * PR + (4 * hi + ((lane & 15) >> 2)) * PT + ((lane >> 4) & 1) * 32 + (lane & 3) * 8;
    f32x16 O1[4], O2[4];
#pragma unroll
    for (int c = 0; c < 4; ++c)
#pragma unroll
        for (int r = 0; r < 16; ++r) { O1[c][r] = 0.f; O2[c][r] = 0.f; }
    float mref[2] = {0.f, 0.f}, lsum[2] = {0.f, 0.f};
    bool started = false;
    A_LOAD(nt - 1); A_STORE(0); if (nt > 1) A_LOAD(nt - 2);
    __syncthreads();
    for (int it = 0; it < nt; ++it) {
        const int j = nt - 1 - it, cur = it & 1;
        asm volatile("" : "+v"(qbase), "+v"(kbase), "+v"(vbase));
        if (it + 1 < nt) A_STORE(cur ^ 1);
        if (it + 2 < nt) A_LOAD(j - 2);
        if (j <= jd) {
            const unsigned kvo = AT_KV + cur * AT_KVSZ;
            for (int kb = 1; kb >= 0; --kb) {
                const bool diag = (j == jd);
                if (diag && kb > (w & 1)) continue;
                const bool domask = diag && kb == (w & 1);
                bf16x8 Pb[2][2];
#pragma unroll
                for (int p = 0; p < 2; ++p) {
                    f32x16 S;
                    const float tb = slope2 * (float)(64 * j + 32 * kb - qpos + 4 * hi) - mref[p];
#pragma unroll
                    for (int r = 0; r < 16; ++r) S[r] = tb + slope2 * (float)((r & 3) + 8 * (r >> 2));
#pragma unroll
                    for (int ks = 0; ks < 4; ++ks) {
                        const bf16x8 qf = *(const LAS bf16x8*)(lds + qbase + (8 * p + 2 * ks) * 16);
                        const bf16x8 kf = *(const LAS bf16x8*)(lds + (kbase + kvo + kb * (32 * PR)) + (8 * p + 2 * ks) * 16);
                        S = MFMA32(kf, qf, S);
                    }
                    if (domask) {
#pragma unroll
                        for (int r = 0; r < 16; ++r) { const int kv = (r & 3) + 8 * (r >> 2) + 4 * hi; if (kv > r32) S[r] = ATT_NEG; } }
                    float rm = fmaxf(S[0], S[1]);
#pragma unroll
                    for (int r = 2; r < 16; ++r) rm = fmaxf(rm, S[r]);
                    rm = swap_max(rm);
                    if (!started) {
                        mref[p] = rm;
#pragma unroll
                        for (int r = 0; r < 16; ++r) S[r] -= rm;
                    } else if (__any(rm > ATT_THR)) {
                        const float dl = fmaxf(rm, 0.f); mref[p] += dl;
#pragma unroll
                        for (int r = 0; r < 16; ++r) S[r] -= dl;
                        const float f = exp2f(-dl); lsum[p] *= f;
                        if (p == 0) {
#pragma unroll
                            for (int c = 0; c < 4; ++c) O1[c] = O1[c] * f;
                        } else {
#pragma unroll
                            for (int c = 0; c < 4; ++c) O2[c] = O2[c] * f;
                        }
                    }
                    float ls = 0.f;
#pragma unroll
                    for (int r = 0; r < 16; ++r) { S[r] = __builtin_amdgcn_exp2f(S[r]); ls += S[r]; }
                    lsum[p] += ls;
                    Pb[p][0] = pack8(S, 0); Pb[p][1] = pack8(S, 1);
                }
                started = true;
#pragma unroll
                for (int c = 0; c < 4; ++c)
#pragma unroll
                    for (int ss = 0; ss < 2; ++ss) {
                        const LAS char* vp = (const LAS char*)lds + (vbase + kvo + kb * (32 * PT));
                        const bf16x8 vf = cat8(lds_tr(vp + ((16 * ss) * PT + c * 64)), lds_tr(vp + ((16 * ss + 8) * PT + c * 64)));
                        O1[c] = MFMA32(vf, Pb[0][ss], O1[c]); O2[c] = MFMA32(vf, Pb[1][ss], O2[c]);
                    }
            }
        }
        __syncthreads();
    }
#undef A_LOAD
#undef A_STORE
    const float inv1 = 1.0f / swap_add(lsum[0]), inv2 = lam / swap_add(lsum[1]);
    float ss = 0.f;
#pragma unroll
    for (int c = 0; c < 4; ++c)
#pragma unroll
        for (int r = 0; r < 16; ++r) { const float o = O1[c][r] * inv1 - O2[c][r] * inv2; O1[c][r] = o; ss += o * o; }
    ss = swap_add(ss);
    const float rstd = (1.0f / sqrtf(ss * (1.0f / 128.f) + RMS_EPS)) * 0.8f;
    bf16* yrow = Y + (rowbase + qpos) * DM + 512 + h * 128;
#pragma unroll
    for (int c = 0; c < 4; ++c)
#pragma unroll
        for (int g4 = 0; g4 < 4; ++g4) { const int dv0 = 32 * c + 8 * g4 + 4 * hi; const f32x4 gg = *(const f32x4*)(subln_g + dv0);
            u32x2 o; o.x = pk2(O1[c][4 * g4] * rstd * gg[0], O1[c][4 * g4 + 1] * rstd * gg[1]); o.y = pk2(O1[c][4 * g4 + 2] * rstd * gg[2], O1[c][4 * g4 + 3] * rstd * gg[3]);
            *(u32x2*)(yrow + dv0) = o; }
}

constexpr int RT_P = 0, RT_K = 128 * PR, RT_V = 2 * 128 * PR, RT_ST = 2 * 128 * PR + 128 * PT;
static_assert(RT_ST + 128 * PR <= LDS_MAIN, "retention LDS");
__device__ __forceinline__ u32x4 scale8(u32x4 v, float f) { u32x4 o; o.x = pk2(bf_lo(v.x) * f, bf_hi(v.x) * f); o.y = pk2(bf_lo(v.y) * f, bf_hi(v.y) * f); o.z = pk2(bf_lo(v.z) * f, bf_hi(v.z) * f); o.w = pk2(bf_lo(v.w) * f, bf_hi(v.w) * f); return o; }
__device__ __forceinline__ void ret_unit(const bf16* PROJ, bf16* Y, int b, int h, LAS unsigned char* lds) {
    int tid = threadIdx.x; asm volatile("" : "+v"(tid));
    const int lane = tid & 63, l15 = lane & 15, g = lane >> 4;
    const int w = __builtin_amdgcn_readfirstlane(tid >> 6);
    const size_t rowbase = (size_t)b * SEQ;
    const float gam = 1.0f - exp2f(-5.f - (float)h), lg = log2f(gam), cdec = exp2f(128.f * lg), g127 = exp2f(127.f * lg);
    const int srow = tid >> 4, sch = tid & 15;
    const char* gbase = (const char*)(PROJ + rowbase * NIN + h * 128);
    const unsigned soff = (unsigned)(srow * NIN + sch * 8) * 2u;
    const unsigned qoff = (unsigned)((16 * w + l15) * NIN + C_RQ + 8 * g) * 2u;
    const unsigned toff = (unsigned)((16 * w + l15) * NIN + C_RG + 4 * g) * 2u;
    const float qscale = exp2f(lg * (float)(16 * w + l15));
    u32x4 sk[4], sv[4];
#define R_LOAD(n) do { const char* kb_ = gbase + ((size_t)(128 * (n)) * NIN + C_RK) * 2; const char* vb_ = gbase + ((size_t)(128 * (n)) * NIN + C_RV) * 2; \
        _Pragma("unroll") for (int i_ = 0; i_ < 4; ++i_) { sk[i_] = *(const u32x4*)(kb_ + (soff + (unsigned)(32 * i_ * NIN * 2))); sv[i_] = *(const u32x4*)(vb_ + (soff + (unsigned)(32 * i_ * NIN * 2))); } } while (0)
#define R_STORE() do { _Pragma("unroll") for (int i_ = 0; i_ < 4; ++i_) { const int row_ = srow + 32 * i_; \
        *(LAS u32x4*)(lds + RT_K + row_ * PR + sch * 16) = scale8(sk[i_], exp2f(-lg * (float)row_)); *(LAS u32x4*)(lds + RT_V + row_ * PT + sch * 16) = sv[i_]; } } while (0)
#define Q_LOAD(n) do { const char* qb_ = gbase + (size_t)(128 * (n)) * NIN * 2; _Pragma("unroll") for (int s_ = 0; s_ < 4; ++s_) qraw[s_] = *(const u32x4*)(qb_ + (qoff + 64u * s_)); } while (0)
    f32x4 Sacc[8];
#pragma unroll
    for (int c = 0; c < 8; ++c) Sacc[c] = (f32x4){0.f, 0.f, 0.f, 0.f};
    for (int i = tid; i < 128 * PR / 16; i += 512) *(LAS u32x4*)(lds + RT_ST + i * 16) = (u32x4){0u, 0u, 0u, 0u};
    u32x4 qraw[4];
    R_LOAD(0); Q_LOAD(0); R_STORE();
    __syncthreads();
    const int tq = (lane & 15) >> 2, tp = lane & 3;
    unsigned b_k = RT_K + l15 * PR + g * 16;
    unsigned b_p = RT_P + (16 * w + l15) * PR + g * 16;
    unsigned b_pw = RT_P + (16 * w + l15) * PR + g * 8;
    unsigned b_kt = RT_K + (8 * g + tq) * PR + tp * 8 + w * 32;
    unsigned b_vt = RT_V + (8 * g + tq) * PT + tp * 8;
    unsigned b_st = RT_ST + l15 * PR + g * 16;
    unsigned b_sw = RT_ST + l15 * PR + (16 * w + 4 * g) * 2;
    for (int n = 0; n < SEQ / 128; ++n) {
        asm volatile("" : "+v"(b_k), "+v"(b_p), "+v"(b_pw), "+v"(b_kt), "+v"(b_vt), "+v"(b_st), "+v"(b_sw));
        bf16x8 Qf[4], Pf[4], KTf[4];
#pragma unroll
        for (int s = 0; s < 4; ++s) Qf[s] = __builtin_bit_cast(bf16x8, scale8(qraw[s], qscale));
#pragma unroll
        for (int jb = 0; jb < 8; ++jb) {
            f32x4 a = (f32x4){0.f, 0.f, 0.f, 0.f};
#pragma unroll
            for (int s = 0; s < 4; ++s) { const bf16x8 kf = *(const LAS bf16x8*)(lds + (b_k + jb * (16 * PR) + s * 64)); a = MFMA16(kf, Qf[s], a); }
            const int ii = 16 * w + l15, jj = 16 * jb + 4 * g;
            u32x2 pw; pw.x = pk2(jj <= ii ? a[0] : 0.f, jj + 1 <= ii ? a[1] : 0.f); pw.y = pk2(jj + 2 <= ii ? a[2] : 0.f, jj + 3 <= ii ? a[3] : 0.f);
            *(LAS u32x2*)(lds + (b_pw + jb * 32)) = pw;
        }
#pragma unroll
        for (int s = 0; s < 4; ++s) { Pf[s] = *(const LAS bf16x8*)(lds + (b_p + s * 64));
            KTf[s] = cat8(lds_tr((const LAS char*)lds + (b_kt + (32 * s) * PR)), lds_tr((const LAS char*)lds + (b_kt + (32 * s + 4) * PR))); }
        f32x4 OT[8];
#pragma unroll
        for (int c = 0; c < 8; ++c) {
            f32x4 o = (f32x4){0.f, 0.f, 0.f, 0.f}, t4 = (f32x4){0.f, 0.f, 0.f, 0.f};
#pragma unroll
            for (int s = 0; s < 4; ++s) {
                const bf16x8 vf = cat8(lds_tr((const LAS char*)lds + (b_vt + (32 * s) * PT + c * 32)), lds_tr((const LAS char*)lds + (b_vt + (32 * s + 4) * PT + c * 32)));
                const bf16x8 stf = *(const LAS bf16x8*)(lds + (b_st + c * (16 * PR) + s * 64));
                o = MFMA16(stf, Qf[s], o); o = MFMA16(vf, Pf[s], o); t4 = MFMA16(KTf[s], vf, t4);
            }
            OT[c] = o; Sacc[c] = Sacc[c] * cdec + t4 * g127;
            __builtin_amdgcn_sched_barrier(0);
        }
        if (n + 1 < SEQ / 128) { Q_LOAD(n + 1); R_LOAD(n + 1); }
        float ss = 0.f;
#pragma unroll
        for (int c = 0; c < 8; ++c) ss += (OT[c][0] * OT[c][0] + OT[c][1] * OT[c][1]) + (OT[c][2] * OT[c][2] + OT[c][3] * OT[c][3]);
        ss += __shfl_xor(ss, 16); ss += __shfl_xor(ss, 32);
        const float rstd = __builtin_amdgcn_rsqf(ss * (1.0f / 128.f) + RMS_EPS);
        const char* rgb = gbase + (size_t)(128 * n) * NIN * 2;
        char* yb = (char*)(Y + (rowbase + (size_t)n * 128) * DM + h * 128); const unsigned yoff = (unsigned)((16 * w + l15) * DM + 4 * g) * 2u;
#pragma unroll
        for (int c = 0; c < 8; ++c) { const u32x2 rg = *(const u32x2*)(rgb + (toff + 32u * c));
            const float r0 = bf_lo(rg.x), r1 = bf_hi(rg.x), r2 = bf_lo(rg.y), r3 = bf_hi(rg.y);
            const float s0 = r0 * __builtin_amdgcn_rcpf(1.f + __expf(-r0)), s1 = r1 * __builtin_amdgcn_rcpf(1.f + __expf(-r1)), s2 = r2 * __builtin_amdgcn_rcpf(1.f + __expf(-r2)), s3 = r3 * __builtin_amdgcn_rcpf(1.f + __expf(-r3));
            u32x2 o; o.x = pk2(OT[c][0] * rstd * s0, OT[c][1] * rstd * s1); o.y = pk2(OT[c][2] * rstd * s2, OT[c][3] * rstd * s3);
            *(u32x2*)(yb + (yoff + 32u * c)) = o; }
        __syncthreads();
#pragma unroll
        for (int c = 0; c < 8; ++c) { u32x2 o; o.x = pk2(Sacc[c][0] * gam, Sacc[c][1] * gam); o.y = pk2(Sacc[c][2] * gam, Sacc[c][3] * gam);
            *(LAS u32x2*)(lds + (b_sw + c * (16 * PR))) = o; }
        if (n + 1 < SEQ / 128) R_STORE();
        __syncthreads();
    }
#undef R_LOAD
#undef R_STORE
#undef Q_LOAD
}

constexpr int P2_NRET = BATCH * 4, P2_NATT = BATCH * 4 * 8, P2_NITEMS = P2_NRET + P2_NATT;
__device__ __forceinline__ void p2_mixers(const Params& P, LAS unsigned char* lds) {
    const int tid = threadIdx.x;
    unsigned* ctl = (unsigned*)(P.ws + WS_CTL);
    volatile LAS int* lctl = (volatile LAS int*)(lds + LDS_MAIN);
    const bf16* PROJ = (const bf16*)(P.ws + WS_PROJ); bf16* Y = (bf16*)(P.ws + WS_H);
    float d1 = 0.f, d2 = 0.f;
    for (int i = 0; i < 64; ++i) { d1 += P.diff_lambda[i] * P.diff_lambda[64 + i]; d2 += P.diff_lambda[128 + i] * P.diff_lambda[192 + i]; }
    const float lam = expf(d1) - expf(d2) + 0.2f;
    for (;;) {
        if (tid == 0) lctl[0] = (int)atomicAdd(ctl + CW_QUEUE, 1u);
        __syncthreads();
        const int item = __builtin_amdgcn_readfirstlane(lctl[0]);
        __syncthreads();
        if (item >= P2_NITEMS) break;
        if (item < P2_NRET) ret_unit(PROJ, Y, item >> 2, item & 3, lds);
        else { const int idx = item - P2_NRET; attn_unit(PROJ, Y, P.diff_subln_g, lam, (idx & 63) >> 2, idx & 3, 7 - (idx >> 6), lds); }
    }
}
#define XB_TMO      128
#define XB_XCNT(j)  (256  + 64 * (j))
#define XB_XSUB(j)  (1280 + 64 * (j))
#define XB_XGEN(j)  (2304 + 64 * (j))
#define XB_TOP      3328
#define XB_TOPGEN   3392
#define XCD_BAR_WORDS 3456
#define XB_SPIN_CAP (1u << 18)

__device__ __forceinline__ unsigned xb_ld(unsigned* p)              { return __hip_atomic_load(p, __ATOMIC_RELAXED, __HIP_MEMORY_SCOPE_AGENT); }
__device__ __forceinline__ unsigned xb_add(unsigned* p, unsigned v) { return __hip_atomic_fetch_add(p, v, __ATOMIC_RELAXED, __HIP_MEMORY_SCOPE_AGENT); }
__device__ __forceinline__ unsigned xb_xcc_id() { return (unsigned)__builtin_amdgcn_s_getreg((3 << 11) | 20) & 0xFu; }
#define XB_SPIN(cond, bar) do { unsigned _sp = 0; while (cond) { __builtin_amdgcn_s_sleep(1); \
    if ((++_sp & 255u) == 0u) { if (xb_ld(&(bar)[XB_TMO])) break; if (_sp > XB_SPIN_CAP) { atomicAdd(&(bar)[XB_TMO], 1u); break; } } } } while (0)

struct XcdBarrier {
    unsigned* bar; unsigned x;
    volatile LAS unsigned* st;
};

__device__ __forceinline__ XcdBarrier xcd_barrier_post(unsigned* bar, volatile LAS unsigned* st) {
    XcdBarrier b; b.bar = bar; b.x = xb_xcc_id(); b.st = st;
    if (threadIdx.x == 0) (void)xb_add(&bar[XB_XCNT(b.x)], 1u);
    return b;
}
__device__ __forceinline__ void xcd_barrier_complete(unsigned* bar, unsigned x, unsigned& nloc, unsigned& nx) {
    const unsigned G = gridDim.x * gridDim.y * gridDim.z;
    unsigned sum, cnt, mine, sp = 0u;
    for (;;) {
        sum = 0u; cnt = 0u; mine = 0u;
#pragma unroll
        for (unsigned j = 0; j < 16; ++j) { const unsigned c = xb_ld(&bar[XB_XCNT(j)]); sum += c; cnt += (c > 0u) ? 1u : 0u; mine = (j == x) ? c : mine; }
        if (sum == G) break;
        __builtin_amdgcn_s_sleep(1);
        if ((++sp & 255u) == 0u) { if (xb_ld(&bar[XB_TMO])) break; if (sp > XB_SPIN_CAP) { atomicAdd(&bar[XB_TMO], 1u); break; } }
    }
    nloc = mine > 0u ? mine : 1u; nx = cnt > 0u ? cnt : 1u;
}

__device__ __forceinline__ void xcd_barrier(const XcdBarrier& b) {
    asm volatile("s_waitcnt vmcnt(0)" ::: "memory");
    __syncthreads();
    if (threadIdx.x == 0) {
        unsigned* bar = b.bar;
        __builtin_amdgcn_s_waitcnt(0);
        unsigned nloc = b.st[0], nx = b.st[1];
        if (nloc == 0u) { xcd_barrier_complete(bar, b.x, nloc, nx); b.st[0] = nloc; b.st[1] = nx; }
        const unsigned old = xb_add(&bar[XB_XSUB(b.x)], 1u);
        const unsigned gen = old / nloc;
        if (old + 1u == (gen + 1u) * nloc) {
            __builtin_amdgcn_fence(__ATOMIC_RELEASE, "agent");
            asm volatile("s_waitcnt vmcnt(0)" ::: "memory");
            const unsigned og = xb_add(&bar[XB_TOP], 1u);
            const unsigned tg = og / nx;
            if (og + 1u == (tg + 1u) * nx) xb_add(&bar[XB_TOPGEN], 1u);
            else XB_SPIN(xb_ld(&bar[XB_TOPGEN]) == tg, bar);
            __builtin_amdgcn_fence(__ATOMIC_ACQUIRE, "agent");
            xb_add(&bar[XB_XGEN(b.x)], 1u);
            asm volatile("s_waitcnt vmcnt(0)" ::: "memory");
        } else {
            XB_SPIN(xb_ld(&bar[XB_XGEN(b.x)]) == gen, bar);
            __builtin_amdgcn_fence(__ATOMIC_ACQUIRE, "agent");
            asm volatile("s_waitcnt vmcnt(0)" ::: "memory");
        }
    }
    __syncthreads();
}
__device__ __forceinline__ int ord_key(float s) { const int b = __float_as_int(s); return b ^ ((b >> 31) & 0x7fffffff); }
__device__ __forceinline__ float ord_val(int k) { return __int_as_float(k ^ ((k >> 31) & 0x7fffffff)); }
__device__ __forceinline__ int med3i(int a, int b, int c) { int r; asm("v_med3_i32 %0, %1, %2, %3" : "=v"(r) : "v"(a), "v"(b), "v"(c)); return r; }
__device__ __forceinline__ int imax(int a, int b) { return a > b ? a : b; }
__device__ __forceinline__ int imin(int a, int b) { return a < b ? a : b; }
#define INS16(L, x) do { const int x_ = (x); _Pragma("unroll") for (int i_ = 15; i_ >= 1; --i_) L[i_] = med3i(L[i_ - 1], L[i_], x_); L[0] = imax(L[0], x_); } while (0)
__device__ __forceinline__ void merge_halves16(int (&L)[16]) {
    int c[16];
#pragma unroll
    for (int i = 0; i < 8; ++i) {
        auto r0 = __builtin_amdgcn_permlane32_swap((unsigned)L[i], (unsigned)L[15 - i], false, false);
        auto r1 = __builtin_amdgcn_permlane32_swap((unsigned)L[15 - i], (unsigned)L[i], false, false);
        const bool hi = (threadIdx.x & 32) != 0;
        const int pa_i = hi ? (int)r1[0] : (int)r0[1], pa_15i = hi ? (int)r0[0] : (int)r1[1];
        c[i] = imax(L[i], pa_15i); c[15 - i] = imax(L[15 - i], pa_i);
    }
#define BSTAGE(d) _Pragma("unroll") for (int i = 0; i < 16; ++i) if ((i & (d)) == 0) { const int a = c[i], b = c[i + (d)]; c[i] = imax(a, b); c[i + (d)] = imin(a, b); }
    BSTAGE(8) BSTAGE(4) BSTAGE(2) BSTAGE(1)
#undef BSTAGE
#pragma unroll
    for (int i = 0; i < 16; ++i) L[i] = c[i];
}
__device__ __forceinline__ float dpp_add(float v, const int ctrl_sel) {
    int m;
    if (ctrl_sel == 0) m = __builtin_amdgcn_update_dpp(0, __float_as_int(v), 0xB1, 0xf, 0xf, false);
    else if (ctrl_sel == 1) m = __builtin_amdgcn_update_dpp(0, __float_as_int(v), 0x4E, 0xf, 0xf, false);
    else if (ctrl_sel == 2) m = __builtin_amdgcn_update_dpp(0, __float_as_int(v), 0x141, 0xf, 0xf, false);
    else m = __builtin_amdgcn_update_dpp(0, __float_as_int(v), 0x128, 0xf, 0xf, false);
    return v + __int_as_float(m);
}
__device__ __forceinline__ float dot2bf(unsigned a, unsigned b, float acc) {
    typedef __bf16 bf2 __attribute__((ext_vector_type(2)));
    return __builtin_amdgcn_fdot2_f32_bf16(__builtin_bit_cast(bf2, a), __builtin_bit_cast(bf2, b), acc, false);
}
__device__ __forceinline__ float dot8(u32x4 a, u32x4 b, float acc) {
    const unsigned a0 = a.x, a1 = a.y, a2 = a.z, a3 = a.w, b0 = b.x, b1 = b.y, b2 = b.z, b3 = b.w;
    acc = dot2bf(a0, b0, acc); acc = dot2bf(a1, b1, acc); acc = dot2bf(a2, b2, acc); acc = dot2bf(a3, b3, acc);
    return acc;
}
#define AXPY8(accp, wk, v) do { (accp)[0] += (wk) * bf_lo((v).x); (accp)[1] += (wk) * bf_hi((v).x); (accp)[2] += (wk) * bf_lo((v).y); (accp)[3] += (wk) * bf_hi((v).y); \
        (accp)[4] += (wk) * bf_lo((v).z); (accp)[5] += (wk) * bf_hi((v).z); (accp)[6] += (wk) * bf_lo((v).w); (accp)[7] += (wk) * bf_hi((v).w); } while (0)


__device__ __forceinline__ void p5_scores(const Params& P, LAS unsigned char* lds) {
    int tid = threadIdx.x; asm volatile("" : "+v"(tid));
    const int lane = tid & 63, r32 = lane & 31, hi = lane >> 5;
    const int w = __builtin_amdgcn_readfirstlane(tid >> 6), tg = w >> 1, ph = w & 1;
    const int tok0 = blockIdx.x * 128;
    const bf16* SKb = (const bf16*)(P.ws + WS_SK); const bf16* Qb = (const bf16*)(P.ws + WS_Q);
    u32x2* ENT = (u32x2*)(P.ws + WS_H);
    LAS int* lists = (LAS int*)(lds + 131072);
    u32x4 st[8];
#define S_LOAD(h) do { _Pragma("unroll") for (int i_ = 0; i_ < 8; ++i_) { const int n_ = tid + 512 * i_; st[i_] = *(const u32x4*)(SKb + ((size_t)(h) * 256 + (n_ >> 4)) * 128 + (n_ & 15) * 8); } } while (0)
#define S_STORE(buf) do { _Pragma("unroll") for (int i_ = 0; i_ < 8; ++i_) { const int n_ = tid + 512 * i_; *(LAS u32x4*)(lds + (buf) * 65536 + (n_ >> 11) * 32768 + off_b((n_ >> 4) & 127, n_ & 15)) = st[i_]; } } while (0)
    S_LOAD(0); S_STORE(0); S_LOAD(1);
    const bf16* qrow0 = Qb + (size_t)(tok0 + 32 * tg + r32) * NQ + ph * 128 + 8 * hi;
    bf16x8 qf[8];
#pragma unroll
    for (int ks = 0; ks < 8; ++ks) qf[ks] = *(const bf16x8*)(qrow0 + 16 * ks);
    __syncthreads();
    for (int h = 0; h < 8; ++h) {
        const int cur = h & 1;
        int L[16];
        {
            f32x16 acc[4];
#pragma unroll
            for (int kb = 0; kb < 4; ++kb)
#pragma unroll
                for (int r = 0; r < 16; ++r) acc[kb][r] = 0.f;
            const LAS unsigned char* SKl = lds + cur * 65536 + ph * 32768;
#pragma unroll
            for (int ks = 0; ks < 8; ++ks)
#pragma unroll
                for (int kb = 0; kb < 4; ++kb) { const bf16x8 a = *(const LAS bf16x8*)(SKl + off_b(32 * kb + r32, 2 * ks + hi)); acc[kb] = MFMA32(a, qf[ks], acc[kb]); }
            asm volatile("" : "+v"(acc[0]), "+v"(acc[1]), "+v"(acc[2]), "+v"(acc[3]));
            {   const bf16* qn = qrow0 + ((h + 1) & 7) * 256;
#pragma unroll
                for (int ks = 0; ks < 8; ++ks) qf[ks] = *(const bf16x8*)(qn + 16 * ks); }
#pragma unroll
            for (int i = 0; i < 16; ++i) L[i] = (int)0x80000000;
#pragma unroll
            for (int kb = 0; kb < 4; ++kb)
#pragma unroll
                for (int r = 0; r < 16; ++r) { const int key = 32 * kb + (r & 3) + 8 * (r >> 2) + 4 * hi; const int x = (ord_key(acc[kb][r]) & ~127) | key; INS16(L, x); }
        }
        merge_halves16(L);
        if (hi == 0) { LAS int* lp = lists + ((tg * 2 + ph) * 32 + r32) * 16;
#pragma unroll
            for (int i = 0; i < 4; ++i) *(LAS u32x4*)(lp + 4 * i) = (u32x4){(unsigned)L[4 * i], (unsigned)L[4 * i + 1], (unsigned)L[4 * i + 2], (unsigned)L[4 * i + 3]}; }
        if (h + 1 < 8) { S_STORE(cur ^ 1); if (h + 2 < 8) S_LOAD(h + 2); }
        __syncthreads();
        if (ph == 0) {
            const LAS int* la = lists + ((tg * 2 + 0) * 32 + r32) * 16; const LAS int* lb = lists + ((tg * 2 + 1) * 32 + r32) * 16;
            float A[16], B[16];
            {   int bl[16];
#pragma unroll
                for (int i = 0; i < 4; ++i) { const u32x4 v = *(const LAS u32x4*)(lb + 4 * i); bl[4 * i] = (int)v.x; bl[4 * i + 1] = (int)v.y; bl[4 * i + 2] = (int)v.z; bl[4 * i + 3] = (int)v.w; }
#pragma unroll
                for (int i = 0; i < 16; ++i) { const float av = ord_val(L[i] & ~127), bv = ord_val(bl[i] & ~127); A[i] = hi ? bv : av; B[i] = hi ? av : bv; } }
            int C[16];
#pragma unroll
            for (int i = 0; i < 16; ++i) C[i] = (int)0x80000000;
#define CAND(i, j) do { const float v_ = A[i] + B[j]; const int code_ = hi ? ((j) * 16 + (i)) : ((i) * 16 + (j)); const int x2_ = (ord_key(v_) & ~255) | code_; INS16(C, x2_); } while (0)
#pragma unroll
            for (int j = 1; j < 16; ++j) CAND(0, j);
#pragma unroll
            for (int j = 2; j < 8; ++j) CAND(1, j);
            CAND(2, 3); CAND(2, 4);
            {
                const float v0 = hi ? (A[2] + B[2]) : (A[0] + B[0]), v1 = hi ? (A[3] + B[3]) : (A[1] + B[1]);
                const int x0 = (ord_key(v0) & ~255) | (hi ? 0x22 : 0x00), x1 = (ord_key(v1) & ~255) | (hi ? 0x33 : 0x11);
                INS16(C, x0); INS16(C, x1); }
#undef CAND
            merge_halves16(C);
            float gsum = 0.f, e[16];
            const float vmax = ord_val(C[0] & ~255);
#pragma unroll
            for (int i = 0; i < 16; ++i) { e[i] = __expf(ord_val(C[i] & ~255) - vmax); gsum += e[i]; }
            const float ginv = 1.0f / gsum;
            u32x2* ep = ENT + (size_t)(tok0 + 32 * tg + r32) * 128 + h * 16 + hi * 8;
            int Cs[8]; float Gs[8];
#pragma unroll
            for (int i = 0; i < 8; ++i) { int c0 = C[i], c1 = C[i + 8]; float e0 = e[i], e1 = e[i + 8]; asm volatile("" : "+v"(c0), "+v"(c1), "+v"(e0), "+v"(e1)); Cs[i] = hi ? c1 : c0; Gs[i] = (hi ? e1 : e0) * ginv; }
#pragma unroll
            for (int i = 0; i < 8; i += 2) {
                u32x4 o;
                { const int code = Cs[i] & 255; const int i1 = la[code >> 4] & 127, i2 = lb[code & 15] & 127; o.x = (unsigned)(i1 * 128 + i2); o.y = __float_as_uint(Gs[i]); }
                { const int code = Cs[i + 1] & 255; const int i1 = la[code >> 4] & 127, i2 = lb[code & 15] & 127; o.z = (unsigned)(i1 * 128 + i2); o.w = __float_as_uint(Gs[i + 1]); }
                *(u32x4*)(ep + i) = o;
            }
        }
        __syncthreads();
    }
#undef S_LOAD
#undef S_STORE
}
__device__ __forceinline__ void fp8x16_to_f32(u32x4 v, float (&f)[16]) {
#pragma unroll
    for (int j = 0; j < 4; ++j) { const int wv_ = (int)v[j]; const f32x2 lo = __builtin_amdgcn_cvt_pk_f32_fp8(wv_, false), hi = __builtin_amdgcn_cvt_pk_f32_fp8(wv_, true);
        f[4 * j] = lo.x; f[4 * j + 1] = lo.y; f[4 * j + 2] = hi.x; f[4 * j + 3] = hi.y; }
}
constexpr int CW_PACE = 65536;
__device__ __forceinline__ void xcc_pace(unsigned* ctl, const XcdBarrier& b, unsigned step) {
    __syncthreads();
    if (threadIdx.x == 0) {
        unsigned* c = ctl + CW_PACE + 64 * b.x; const unsigned nloc = b.st[0];
        if (nloc != 0u) { xb_add(c, 1u); const unsigned want = (step + 1u) * nloc; unsigned sp = 0;
            while (xb_ld(c) < want) { __builtin_amdgcn_s_sleep(1); if (++sp > (1u << 16)) break; } }
    }
    __syncthreads();
}
#define P6_REP(k) (32 * ((k) >> 2) + 16 * (((k) >> 1) & 1) + 8 * ((k) & 1))
__device__ __forceinline__ void p6_gather(const Params& P, LAS unsigned char* lds, const XcdBarrier& xbar) {
    int tid = threadIdx.x; asm volatile("" : "+v"(tid));
    const int lane = tid & 63, l7 = lane & 7;
    const int w = __builtin_amdgcn_readfirstlane(tid >> 6);
    const int tok0 = blockIdx.x * 128;
    const u32x2* ENT = (const u32x2*)(P.ws + WS_H);
    const bf16* XG = (const bf16*)(P.ws + WS_XG); const unsigned char* U8 = P.ws + WS_U; const unsigned char* V8 = P.ws + WS_V;
    const float* SU = (const float*)(P.ws + WS_SU); const float* SV = (const float*)(P.ws + WS_SV);
    const float* RSS = (const float*)(P.ws + WS_RSS);
    const int kk = 4 * (lane >> 5) + 2 * ((lane >> 4) & 1) + ((lane >> 3) & 1);
    const unsigned xsb = (unsigned)w * 8192u + (unsigned)lane * 16u;
    const unsigned ssb = 65536u + (unsigned)w * 8192u;
    const unsigned ska = ssb + (unsigned)kk * 8u;
    const unsigned skv = ssb + (unsigned)l7 * 8u;
    const unsigned rowoff = 16u * (unsigned)lane;
    xcd_barrier(xbar);
    unsigned pace_step = 0;
    for (int r = 0; r < 2; ++r) {
        if (r > 0) xcc_pace((unsigned*)(P.ws + WS_CTL), xbar, pace_step++);
        float rstd[8];
#pragma unroll
        for (int t = 0; t < 8; ++t) {
            const size_t tok = (size_t)tok0 + 64 * r + 8 * w + t;
            const u32x4 e4 = ((const u32x4*)ENT)[tok * 64 + lane];
            float xscale;
            {
                const u32x4 xa = *(const u32x4*)(XG + tok * DM + 16 * lane), xb = *(const u32x4*)(XG + tok * DM + 16 * lane + 8); float xf[16];
#pragma unroll
                for (int j = 0; j < 4; ++j) { xf[2 * j] = bf_lo(xa[j]); xf[2 * j + 1] = bf_hi(xa[j]); xf[8 + 2 * j] = bf_lo(xb[j]); xf[8 + 2 * j + 1] = bf_hi(xb[j]); }
                float mx = 0.f;
#pragma unroll
                for (int i = 0; i < 16; ++i) mx = fmaxf(mx, fabsf(xf[i]));
                mx = wave_max_fast(mx);
                const float qs = mx > 0.f ? 127.f / mx : 1.f; u32x4 xq;
#pragma unroll
                for (int j = 0; j < 4; ++j) { const int b0 = (int)rintf(xf[4 * j] * qs), b1 = (int)rintf(xf[4 * j + 1] * qs), b2 = (int)rintf(xf[4 * j + 2] * qs), b3 = (int)rintf(xf[4 * j + 3] * qs);
                    xq[j] = ((unsigned)b0 & 255u) | (((unsigned)b1 & 255u) << 8) | (((unsigned)b2 & 255u) << 16) | (((unsigned)b3 & 255u) << 24); }
                *(LAS u32x4*)(lds + xsb + t * 1024) = xq; xscale = mx > 0.f ? mx * (1.0f / 127.f) : 1.f; }
            const f32x4* rp = (const f32x4*)(RSS + tok * 16); const f32x4 s0 = rp[0], s1 = rp[1], s2 = rp[2], s3 = rp[3];
            const float ssq = ((s0[0] + s0[1]) + (s0[2] + s0[3])) + ((s1[0] + s1[1]) + (s1[2] + s1[3])) + ((s2[0] + s2[1]) + (s2[2] + s2[3])) + ((s3[0] + s3[1]) + (s3[2] + s3[3]));
            rstd[t] = (1.0f / sqrtf(ssq * (1.0f / DM) + RMS_EPS)) * xscale;
            const unsigned bA = e4.x >> 10, bB = e4.z >> 10; int posA = 0, posB = 0, base = 0;
            for (int s = 0; s < 16; ++s) {
                const unsigned long long mA = __ballot(bA == (unsigned)s), mB = __ballot(bB == (unsigned)s);
                const int cA = __popcll(mA), cB = __popcll(mB);
                const int rA = (int)__builtin_amdgcn_mbcnt_hi((unsigned)(mA >> 32), __builtin_amdgcn_mbcnt_lo((unsigned)mA, 0u));
                const int rB = (int)__builtin_amdgcn_mbcnt_hi((unsigned)(mB >> 32), __builtin_amdgcn_mbcnt_lo((unsigned)mB, 0u));
                if (bA == (unsigned)s) posA = base + rA;
                if (bB == (unsigned)s) posB = base + cA + rB;
                base += cA + cB;
            }
            *(LAS u32x2*)(lds + ssb + t * 1024 + posA * 8) = (u32x2){e4.x, e4.y}; *(LAS u32x2*)(lds + ssb + t * 1024 + posB * 8) = (u32x2){e4.z, e4.w};
        }
        {   u32x4 ua[8]; u32x2 entN; float suN, svN;
#ifndef PA_SPLIT
#define PA_SPLIT 8
#endif
#define PA_PRE_LO(B, T) do { entN = *(const LAS u32x2*)(lds + ska + (T) * 1024 + (B) * 64); suN = SU[entN.x]; svN = SV[entN.x]; \
            _Pragma("unroll") for (int k = 0; k < PA_SPLIT; ++k) { const unsigned ex_ = (unsigned)__builtin_amdgcn_readlane((int)entN.x, P6_REP(k)); ua[k] = *(const u32x4*)(U8 + (ex_ * 1024u + rowoff)); } } while (0)
#define PA_PRE_HI() do { \
            _Pragma("unroll") for (int k = PA_SPLIT; k < 8; ++k) { const unsigned ex_ = (unsigned)__builtin_amdgcn_readlane((int)entN.x, P6_REP(k)); ua[k] = *(const u32x4*)(U8 + (ex_ * 1024u + rowoff)); } } while (0)
#define PA_PRE(B, T) do { PA_PRE_LO(B, T); PA_PRE_HI(); } while (0)
#define PA_BODY(B, T, NB, NT) do { \
            const u32x2 ent = entN; const float suk = suN, svk = svN; \
            const u32x4 xq = *(const LAS u32x4*)(lds + xsb + (T) * 1024); \
            int d[8]; \
            _Pragma("unroll") for (int k = 0; k < 8; ++k) d[k] = __builtin_amdgcn_sdot4((int)ua[k].x, (int)xq.x, __builtin_amdgcn_sdot4((int)ua[k].y, (int)xq.y, __builtin_amdgcn_sdot4((int)ua[k].z, (int)xq.z, __builtin_amdgcn_sdot4((int)ua[k].w, (int)xq.w, 0, false), false), false), false); \
            asm volatile("" : "+v"(d[0]), "+v"(d[1]), "+v"(d[2]), "+v"(d[3]), "+v"(d[4]), "+v"(d[5]), "+v"(d[6]), "+v"(d[7])); \
            PA_PRE_LO(NB, NT);     \
            int s4[4], t2[2]; \
            _Pragma("unroll") for (int k = 0; k < 4; ++k) { auto rr = __builtin_amdgcn_permlane32_swap((unsigned)d[k], (unsigned)d[k + 4], false, false); s4[k] = (int)rr[0] + (int)rr[1]; } \
            _Pragma("unroll") for (int k = 0; k < 2; ++k) { auto rr = __builtin_amdgcn_permlane16_swap((unsigned)s4[k], (unsigned)s4[k + 2], false, false); t2[k] = (int)rr[0] + (int)rr[1]; } \
            __builtin_amdgcn_sched_barrier(0); PA_PRE_HI(); __builtin_amdgcn_sched_barrier(0); \
            const bool b3 = (lane & 8) != 0; \
            const int keep = b3 ? t2[1] : t2[0], give = b3 ? t2[0] : t2[1]; \
            int di = keep + __builtin_amdgcn_update_dpp(0, give, 0x128, 0xf, 0xf, false); \
            di += __builtin_amdgcn_update_dpp(0, di, 0xB1, 0xf, 0xf, false); di += __builtin_amdgcn_update_dpp(0, di, 0x4E, 0xf, 0xf, false); di += __builtin_amdgcn_update_dpp(0, di, 0x141, 0xf, 0xf, false); \
            const float a = rstd[T] * suk * (float)di; \
            const float wv = __uint_as_float(ent.y) * svk * (0.5f * a * (1.0f + erff(a * 0.70710678118654752f))); \
            if ((lane & 7) == 0) *(LAS float*)(lds + ska + (T) * 1024 + (B) * 64 + 4) = wv;     \
            __builtin_amdgcn_sched_barrier(0); \
        } while (0)
            {
            PA_PRE(0, 0);
#pragma unroll 1
            for (int b = 0; b < 16; ++b) {
                PA_BODY(b, 0, b, 1); PA_BODY(b, 1, b, 2); PA_BODY(b, 2, b, 3); PA_BODY(b, 3, b, 4);
                PA_BODY(b, 4, b, 5); PA_BODY(b, 5, b, 6); PA_BODY(b, 6, b, 7);
                PA_BODY(b, 7, (b + 1) & 15, 0);
            }
            }
#undef PA_PRE
#undef PA_PRE_LO
#undef PA_PRE_HI
#undef PA_BODY
        }
        asm volatile("s_waitcnt vmcnt(0) lgkmcnt(0)" ::: "memory");
        f32x2 acc[8][8];
#pragma unroll
        for (int t = 0; t < 8; ++t)
#pragma unroll
            for (int i = 0; i < 8; ++i) acc[t][i] = (f32x2){0.f, 0.f};
#ifndef PB_D
#define PB_D 4
#endif
        {   u32x4 va[8]; u32x2 evN;
#define PB_ENT(B, T) do { evN = *(const LAS u32x2*)(lds + skv + (T) * 1024 + (B) * 64); } while (0)
#define PB_LDV(k) do { const unsigned ex_ = (unsigned)__builtin_amdgcn_readlane((int)evN.x, (k)); va[k] = *(const u32x4*)(V8 + (ex_ * 1024u + rowoff)); } while (0)
#define PB_BODY(B, T, NB, NT) do { f32x2 (&accT)[8] = acc[T]; \
            const u32x2 evC = evN;     \
            PB_ENT(NB, NT); \
            _Pragma("unroll") for (int k = 0; k < 8; ++k) { \
                const float wk_ = __int_as_float(__builtin_amdgcn_readlane((int)evC.y, k)); const f32x2 wk2_ = {wk_, wk_}; \
                _Pragma("unroll") for (int j = 0; j < 4; ++j) { const int wv_ = (int)va[k][j]; const f32x2 lo_ = __builtin_amdgcn_cvt_pk_f32_fp8(wv_, false), hi_ = __builtin_amdgcn_cvt_pk_f32_fp8(wv_, true); \
                    accT[2 * j] = __builtin_elementwise_fma(lo_, wk2_, accT[2 * j]); accT[2 * j + 1] = __builtin_elementwise_fma(hi_, wk2_, accT[2 * j + 1]); } \
                asm volatile("" : "+v"(accT[0]), "+v"(accT[1]), "+v"(accT[2]), "+v"(accT[3]), "+v"(accT[4]), "+v"(accT[5]), "+v"(accT[6]), "+v"(accT[7])); \
                if (k < PB_D) { const unsigned ex_ = (unsigned)__builtin_amdgcn_readlane((int)evC.x, (k + (8 - PB_D)) & 7); va[(k + (8 - PB_D)) & 7] = *(const u32x4*)(V8 + (ex_ * 1024u + rowoff)); } \
                else { const unsigned ex_ = (unsigned)__builtin_amdgcn_readlane((int)evN.x, k - PB_D); va[k - PB_D] = *(const u32x4*)(V8 + (ex_ * 1024u + rowoff)); } } \
        } while (0)
            {
            PB_ENT(0, 0);
#pragma unroll
            for (int k = 0; k < 8 - PB_D; ++k) PB_LDV(k);
#pragma unroll 1
            for (int b = 0; b < 16; ++b) {
                PB_BODY(b, 0, b, 1); PB_BODY(b, 1, b, 2); PB_BODY(b, 2, b, 3); PB_BODY(b, 3, b, 4);
                PB_BODY(b, 4, b, 5); PB_BODY(b, 5, b, 6); PB_BODY(b, 6, b, 7);
                PB_BODY(b, 7, (b + 1) & 15, 0);
            }
            }
#undef PB_ENT
#undef PB_LDV
#undef PB_BODY
        }
#pragma unroll
        for (int t = 0; t < 8; ++t) {
            const size_t tok = (size_t)tok0 + 64 * r + 8 * w + t;
            float* orow = P.out + tok * DM + 16 * lane; const float* fg = P.final_norm_g + 16 * lane;
            const u32x4 ra = *(const u32x4*)(XG + tok * DM + 16 * lane), rb = *(const u32x4*)(XG + tok * DM + 16 * lane + 8);
            f32x4 xr[4]; float ss = 0.f;
            xr[0] = (f32x4){bf_lo(ra.x), bf_hi(ra.x), bf_lo(ra.y), bf_hi(ra.y)}; xr[1] = (f32x4){bf_lo(ra.z), bf_hi(ra.z), bf_lo(ra.w), bf_hi(ra.w)};
            xr[2] = (f32x4){bf_lo(rb.x), bf_hi(rb.x), bf_lo(rb.y), bf_hi(rb.y)}; xr[3] = (f32x4){bf_lo(rb.z), bf_hi(rb.z), bf_lo(rb.w), bf_hi(rb.w)};
#pragma unroll
            for (int j = 0; j < 4; ++j) { xr[j] += (f32x4){acc[t][2 * j].x, acc[t][2 * j].y, acc[t][2 * j + 1].x, acc[t][2 * j + 1].y};
                ss += (xr[j][0] * xr[j][0] + xr[j][1] * xr[j][1]) + (xr[j][2] * xr[j][2] + xr[j][3] * xr[j][3]); }
            const float rs = 1.0f / sqrtf(wave_sum_fast(ss) * (1.0f / DM) + RMS_EPS);
#pragma unroll
            for (int j = 0; j < 4; ++j) *(f32x4*)(orow + 4 * j) = xr[j] * rs * *(const f32x4*)(fg + 4 * j);
        }
    }
}
constexpr int CW_BAR = 4096;
constexpr int NPHASE = 6;
__global__ void __launch_bounds__(512, 2) fwd(Params P) {
    __shared__ __attribute__((aligned(16))) unsigned char lds_raw[LDS_BYTES];
    LAS unsigned char* lds = (LAS unsigned char*)lds_raw;
    const int tid = threadIdx.x, lane = tid & 63, wave = __builtin_amdgcn_readfirstlane(tid >> 6);
    const int lo = P.ph_lo, hi = P.ph_hi, G = gridDim.x;
#define IN(k) (lo <= (k) && (k) < hi)
#define SEAM(k) do { if (IN(k) && IN((k) + 1)) { if ((k) == 2) cg::this_grid().sync(); else xcd_barrier(xbar); } } while (0)
    bf16* WinT = (bf16*)(P.ws + WS_WIN); bf16* WoutT = (bf16*)(P.ws + WS_WOUT); bf16* WqT = (bf16*)(P.ws + WS_WQ);
    bf16* Hb = (bf16*)(P.ws + WS_H); bf16* PROJ = (bf16*)(P.ws + WS_PROJ); bf16* XG = (bf16*)(P.ws + WS_XG); bf16* Qb = (bf16*)(P.ws + WS_Q);
    float* RSS = (float*)(P.ws + WS_RSS);
    if (tid < 16) ((volatile LAS unsigned*)(lds + LDS_MAIN))[tid] = 0u;
    __syncthreads();
    XcdBarrier xbar = xcd_barrier_post((unsigned*)(P.ws + WS_CTL) + CW_BAR, (volatile LAS unsigned*)(lds + LDS_MAIN + 32));

    if (IN(0)) { p0_prologue(P, lds, wave, lane);
#if defined(DUP_PHASE) && DUP_PHASE == 0
        p0_prologue(P, lds, wave, lane);
#endif
        SEAM(0); }
    if (IN(1)) {
        pg8::Gemm g{Hb, WinT, MTOK, NIN, DM}; pg8::StaticOrder S; S.init(MTOK, NIN, G, (int)blockIdx.x);
        pg8::EpiProj E{PROJ};
        pg8::gemm_phase<pg8::EpiProj, pg8::StaticOrder, true, true>(lds, g, S, E);
#if defined(DUP_PHASE) && DUP_PHASE == 1
        __syncthreads(); pg8::gemm_phase<pg8::EpiProj, pg8::StaticOrder, true, true>(lds, g, S, E);
#endif
        SEAM(1);
    }
    if (IN(2)) { p2_mixers(P, lds); SEAM(2); }
    if (IN(3)) {
        pg8::Gemm g{Hb  , WoutT, MTOK, DM, DM}; pg8::StaticOrder S; S.init(MTOK, DM, G, (int)blockIdx.x);
        pg8::EpiOut E{P.x, XG, RSS};
        pg8::gemm_phase<pg8::EpiOut, pg8::StaticOrder, true, true>(lds, g, S, E);
#if defined(DUP_PHASE) && DUP_PHASE == 3
        __syncthreads(); pg8::gemm_phase<pg8::EpiOut, pg8::StaticOrder, true, true>(lds, g, S, E);
#endif
        SEAM(3);
    }
    if (IN(4)) {
        pg8::Gemm g{XG, WqT, MTOK, NQ, DM}; pg8::StaticOrder S; S.init(MTOK, NQ, G, (int)blockIdx.x);
        pg8::EpiQ E{RSS, Qb};
        pg8::gemm_phase<pg8::EpiQ, pg8::StaticOrder, true, true>(lds, g, S, E);
#if defined(DUP_PHASE) && DUP_PHASE == 4
        __syncthreads(); pg8::gemm_phase<pg8::EpiQ, pg8::StaticOrder, true, true>(lds, g, S, E);
#endif
        SEAM(4);
    }
    if (IN(5)) { p5_scores(P, lds);
#if defined(DUP_PHASE) && DUP_PHASE == 5
        p5_scores(P, lds);
#endif
        p6_gather(P, lds, xbar);
#if defined(DUP_PHASE) && DUP_PHASE == 6
        {
            xcd_barrier(xbar);
            const unsigned char* T0 = P.ws + WS_U; const unsigned char* T1 = P.ws + WS_V;
            unsigned rs = ((unsigned)blockIdx.x * 8u + (unsigned)wave) * 2654435761u + 12345u; unsigned accx = 0;
#ifndef CAL_NT
#define CAL_NT 0
#endif
#if CAL_NT
#define CAL_LD(p) __builtin_nontemporal_load(p)
#else
#define CAL_LD(p) (*(p))
#endif
#if CAL_HALF
            for (int sw = 0; sw < 16; ++sw) { const unsigned char* T = ((sw >> 1) & 1) ? T1 : T0; const unsigned coff = (sw & 1) * 512u + lane * 8u;
                for (int it = 0; it < 512 / CAL_DEPTH; ++it) { u32x2 v[CAL_DEPTH];
#pragma unroll
                    for (int i = 0; i < CAL_DEPTH; ++i) { rs = rs * 1664525u + 1013904223u; const unsigned row = ((unsigned)it * (32u * CAL_DEPTH) + ((rs >> 10) & (CAL_BAND - 1u))) & 16383u; v[i] = *(const u32x2*)(T + (size_t)row * 1024 + coff); }
#pragma unroll
                    for (int i = 0; i < CAL_DEPTH; ++i) accx ^= v[i].x ^ v[i].y; } }
#else
            for (int sw = 0; sw < 8; ++sw) { const unsigned char* T = (sw & 1) ? T1 : T0; const unsigned coff = lane * 16u;
                for (int it = 0; it < 512 / CAL_DEPTH; ++it) { u32x4 v[CAL_DEPTH];
#pragma unroll
                    for (int i = 0; i < CAL_DEPTH; ++i) { rs = rs * 1664525u + 1013904223u; const unsigned row = ((unsigned)it * (32u * CAL_DEPTH) + ((rs >> 10) & (CAL_BAND - 1u))) & 16383u; v[i] = CAL_LD((const u32x4*)(T + (size_t)row * 1024 + coff)); }
#pragma unroll
                    for (int i = 0; i < CAL_DEPTH; ++i) accx ^= v[i].x ^ v[i].y ^ v[i].z ^ v[i].w; } }
#endif
            if (accx == 0x1234567u) P.out[0] = 1.f;
        }
#endif
    }
#undef IN
#undef SEAM
}

extern "C" void kernel_launch(void* const* d_in, const int* in_sizes, int n_in, void* d_out, int out_size, void* d_ws, size_t ws_size, hipStream_t stream) {
    static int grid = 0;
    if (grid == 0) {
        if (n_in != 12 || in_sizes[0] != MTOK * DM || out_size != MTOK * DM || ws_size < WS_END) { fprintf(stderr, "kernel_launch: unexpected shapes (n_in %d, in0 %d, out %d, ws %zu)\n", n_in, n_in > 0 ? in_sizes[0] : -1, out_size, ws_size); grid = -1; return; }
        int dev = 0, cus = 0, per_cu = 0;
        (void)hipGetDevice(&dev); (void)hipDeviceGetAttribute(&cus, hipDeviceAttributeMultiprocessorCount, dev);
        (void)hipOccupancyMaxActiveBlocksPerMultiprocessor(&per_cu, (const void*)fwd, 512, 0);
        (void)hipGetLastError();
        if (per_cu < 1 || cus != 256) { fprintf(stderr, "kernel_launch: occupancy %d, cus %d: need 1 block on each of 256 CUs\n", per_cu, cus); grid = -1; return; }
        grid = cus;
    }
    if (grid < 0) return;
    (void)hipMemsetAsync((char*)d_ws + WS_CTL, 0, CTL_BYTES, stream);
    Params p{};
    p.x = (const float*)d_in[0]; p.norm_mix_g = (const float*)d_in[1]; p.w_in = (const float*)d_in[2]; p.diff_lambda = (const float*)d_in[3];
    p.diff_subln_g = (const float*)d_in[4]; p.w_out = (const float*)d_in[5]; p.norm_ffn_g = (const float*)d_in[6]; p.peer_wq = (const float*)d_in[7];
    p.peer_subkeys = (const float*)d_in[8]; p.peer_u = (const float*)d_in[9]; p.peer_v = (const float*)d_in[10]; p.final_norm_g = (const float*)d_in[11];
    p.out = (float*)d_out; p.ws = (unsigned char*)d_ws;
    p.ph_lo = 0; p.ph_hi = NPHASE;
    void* args[] = {&p};
    hipError_t e = hipLaunchCooperativeKernel((const void*)fwd, dim3(grid), dim3(512), args, 0, stream);
    if (e != hipSuccess) fprintf(stderr, "kernel_launch: cooperative launch failed: %s\n", hipGetErrorString(e));
}
```

```cpp
#include <hip/hip_runtime.h>
#include <hip/hip_cooperative_groups.h>
#include <cstdio>
#include <cstdint>
namespace cg = cooperative_groups;

#define LAS __attribute__((address_space(3)))
typedef unsigned short bf16;
typedef short bf16x8 __attribute__((ext_vector_type(8)));
typedef short s16x4 __attribute__((ext_vector_type(4)));
typedef float f32x4 __attribute__((ext_vector_type(4)));
typedef float f32x2 __attribute__((ext_vector_type(2)));
typedef float f32x16 __attribute__((ext_vector_type(16)));
typedef unsigned u32x4 __attribute__((ext_vector_type(4)));
typedef unsigned u32x2 __attribute__((ext_vector_type(2)));
typedef int i32x2 __attribute__((ext_vector_type(2)));

constexpr int BATCH = 16, SEQ = 2048, DM = 1024, MTOK = BATCH * SEQ;
constexpr int NIN = 3584;
constexpr int C_RQ = 0, C_RK = 512, C_RV = 1024, C_RG = 1536, C_DQ = 2048, C_DK = 2560, C_DV = 3072;
constexpr int NQ = 2048;
constexpr int NEXP = 16384;
constexpr float RMS_EPS = 1e-6f;
constexpr float LOG2E = 1.4426950408889634f;
constexpr float QSCALE2 = 0.125f * LOG2E;
constexpr float RK_SCALE = 0.08838834764831845f;

constexpr size_t MiB = 1u << 20;
constexpr size_t WS_CTL = 0, CTL_BYTES = 1 * MiB;
constexpr size_t WS_WIN = 1 * MiB;
constexpr size_t WS_WOUT = 8 * MiB;
constexpr size_t WS_WQ = 10 * MiB;
constexpr size_t WS_SK = 14 * MiB;
constexpr size_t WS_RSS = 15 * MiB;
constexpr size_t WS_U = 17 * MiB;
constexpr size_t WS_V = 33 * MiB;
constexpr size_t WS_SC = 49 * MiB;
constexpr size_t WS_H = 81 * MiB;
constexpr size_t WS_PROJ = 145 * MiB;
constexpr size_t WS_XG = WS_PROJ;
constexpr size_t WS_Q = WS_PROJ + 64 * MiB;
constexpr size_t WS_END = WS_PROJ + 224 * MiB;
constexpr int CW_QUEUE = 64;

constexpr int LDS_MAIN = 147456;
constexpr int LDS_BYTES = LDS_MAIN + 256;

__device__ __forceinline__ unsigned f2bf(float f) { unsigned u = __builtin_bit_cast(unsigned, f); return (u + 0x7fffu + ((u >> 16) & 1u)) >> 16; }
__device__ __forceinline__ unsigned pk2(float lo, float hi) { typedef __bf16 bf16x2_t __attribute__((ext_vector_type(2))); f32x2 v = {lo, hi}; bf16x2_t b = __builtin_convertvector(v, bf16x2_t); return __builtin_bit_cast(unsigned, b); }
__device__ __forceinline__ float bf_lo(unsigned u) { return __builtin_bit_cast(float, u << 16); }
__device__ __forceinline__ float bf_hi(unsigned u) { return __builtin_bit_cast(float, u & 0xffff0000u); }
__device__ __forceinline__ unsigned off_b(unsigned row, unsigned ch) { return 256u * row + 16u * (ch ^ (((row & 3) << 2) | ((row >> 2) & 3))); }
__device__ __forceinline__ s16x4 lds_tr(const LAS char* p) { typedef short v4i16_t __attribute__((ext_vector_type(4))); return __builtin_bit_cast(s16x4, __builtin_amdgcn_ds_read_tr16_b64_v4i16((LAS v4i16_t*)p)); }
__device__ __forceinline__ bf16x8 cat8(s16x4 lo, s16x4 hi) { return __builtin_shufflevector(lo, hi, 0, 1, 2, 3, 4, 5, 6, 7); }
__device__ __forceinline__ float wave_sum(float v) {
#pragma unroll
    for (int o = 1; o < 64; o <<= 1) v += __shfl_xor(v, o);
    return v;
}
#define DPPF(v, ctrl) __int_as_float(__builtin_amdgcn_update_dpp(0, __float_as_int(v), ctrl, 0xf, 0xf, false))
__device__ __forceinline__ float wave_sum_fast(float v) {
    v += DPPF(v, 0xB1); v += DPPF(v, 0x4E); v += DPPF(v, 0x141); v += DPPF(v, 0x140);
    { auto r = __builtin_amdgcn_permlane16_swap(__float_as_uint(v), __float_as_uint(v), false, false); v = __uint_as_float(r[0]) + __uint_as_float(r[1]); }
    { auto r = __builtin_amdgcn_permlane32_swap(__float_as_uint(v), __float_as_uint(v), false, false); v = __uint_as_float(r[0]) + __uint_as_float(r[1]); }
    return v;
}
__device__ __forceinline__ float wave_max_fast(float v) {
    v = fmaxf(v, DPPF(v, 0xB1)); v = fmaxf(v, DPPF(v, 0x4E)); v = fmaxf(v, DPPF(v, 0x141)); v = fmaxf(v, DPPF(v, 0x140));
    { auto r = __builtin_amdgcn_permlane16_swap(__float_as_uint(v), __float_as_uint(v), false, false); v = fmaxf(__uint_as_float(r[0]), __uint_as_float(r[1])); }
    { auto r = __builtin_amdgcn_permlane32_swap(__float_as_uint(v), __float_as_uint(v), false, false); v = fmaxf(__uint_as_float(r[0]), __uint_as_float(r[1])); }
    return v;
}
namespace pg8 {
#define PG8_LAS __attribute__((address_space(3)))
typedef unsigned short bf16_t;
typedef short bf16x8 __attribute__((ext_vector_type(8)));
typedef float f32x4 __attribute__((ext_vector_type(4)));
typedef unsigned u32x4 __attribute__((ext_vector_type(4)));
constexpr int BM = 256, BK = 64, HALF = 128, HTB = HALF * BK * 2  , STAGE_BYTES = 8 * HTB, NXCD = 8, WGM = 8;

__host__ __device__ __forceinline__ int lds_byte(int r, int c) { const int st = (r >> 4) * 2 + (c >> 5), rr = r & 15, cc = c & 31, ob = rr * 64 + cc * 2; return st * 1024 + (ob ^ (((ob >> 9) & 1) << 5)); }
__host__ __device__ __forceinline__ void stage_rc(int b, int& R, int& C) { const int st = b / 1024, sb = b % 1024, swz = sb ^ (((sb >> 9) & 1) << 5); R = (st >> 1) * 16 + swz / 64; C = (st & 1) * 32 + (swz % 64) / 2; }
__host__ __device__ __forceinline__ int perm32(int rho) { const int n = rho >> 4, i = rho & 15; return 8 * (i >> 2) + 4 * n + (i & 3); }

struct Unit { int pm, pn; };
struct Gemm { const bf16_t* A; const bf16_t* Bt; int M, N, K; };

struct StaticOrder {
    int nM, nN, nwg, G, c;
    __host__ __device__ void init(int M, int N, int G_, int c_) { nM = M / BM; nN = N / BM; nwg = nM * nN; G = G_; c = c_; }
    __host__ __device__ bool next(int i, Unit& u) const {
        const long L = (long)i * G + c; if (L >= nwg) return false;
        int wgid = (int)L; { const int q = nwg / NXCD, r = nwg % NXCD, xcd = wgid % NXCD, off = wgid / NXCD; wgid = (xcd < r ? xcd * (q + 1) : r * (q + 1) + (xcd - r) * q) + off; }
        const int nig = WGM * nN, gid = wgid / nig, fm = gid * WGM, gsz = (nM - fm) < WGM ? (nM - fm) : WGM;
        u.pm = fm + ((wgid % nig) % gsz); u.pn = (wgid % nig) / gsz; return true;
    }
    __device__ __forceinline__ void a_ready(const Unit&) const {}
    __device__ __forceinline__ void done(const Unit&) const {}
};

__device__ __forceinline__ unsigned cvt_pk_bf16(float lo, float hi) { unsigned r; asm volatile("v_cvt_pk_bf16_f32 %0, %1, %2" : "=v"(r) : "v"(lo), "v"(hi)); return r; }
typedef float f32x2 __attribute__((ext_vector_type(2)));
__device__ __forceinline__ f32x2 gelu_pk(f32x2 v) {
    const f32x2 av = __builtin_elementwise_abs(v), d = av * 0.2316418882f + 1.0f;
    f32x2 t; t.x = __builtin_amdgcn_rcpf(d.x); t.y = __builtin_amdgcn_rcpf(d.y);
    f32x2 q = t * 0.5307027145f + (-0.7265760135f); q = q * t + 0.7107068705f; q = q * t + (-0.142248368f); q = q * t + 0.127414796f; q = q * t;
    const f32x2 s = (v * v) * (-0.72134752044f);
    f32x2 e; e.x = __builtin_amdgcn_exp2f(s.x); e.y = __builtin_amdgcn_exp2f(s.y);
    const f32x2 m = v * (q * e), r = v - m;
    f32x2 o; o.x = v.x < 0.f ? m.x : r.x; o.y = v.y < 0.f ? m.y : r.y; return o;
}

template <class Epi, class Sched, bool ALIGN_EPI = false, bool SP2 = false>
__device__ __forceinline__ void gemm_phase(PG8_LAS unsigned char* lds, const Gemm g, const Sched& S, const Epi& E) {
    const int tid = threadIdx.x, wid = __builtin_amdgcn_readfirstlane(tid >> 6), lane = tid & 63, wr = wid >> 2, wc = wid & 3, fr = lane & 15, fq = lane >> 4;
    const int K = g.K, nt = K / BK;
    unsigned voffA[2], voffB[2];
#pragma unroll
    for (int i = 0; i < 2; ++i) { int R, C; stage_rc(tid * 16 + i * 8192, R, C); const int Rb = Epi::PERM ? ((R & ~31) + perm32(R & 31)) : R;
        voffA[i] = (unsigned)(R * K + C) * 2u; voffB[i] = (unsigned)(Rb * K + C) * 2u; }
    const size_t kstep = (size_t)(BK * 2);
    const size_t hstep = (size_t)HALF * K * 2;
    const size_t tstep = 2 * hstep;
    const unsigned ldsw = (unsigned)wid * 1024u;
    const int aoff = lds_byte(wr * 64 + fr, fq * 8), boff = lds_byte(wc * 32 + fr, fq * 8);
#define PG8_SA(b, h) (((b) * 2 + (h)) * HTB)
#define PG8_SB(b, h) ((4 + (b) * 2 + (h)) * HTB)
#define PG8_STAGE(bufoff, gbase, voff) do { _Pragma("unroll") for (int _i = 0; _i < 2; ++_i) \
        __builtin_amdgcn_global_load_lds((const unsigned*)((const char*)(gbase) + (voff)[_i]), (PG8_LAS unsigned*)(lds + (bufoff) + ldsw + _i * 8192), 16, 0, 0); } while (0)
#define PG8_LDA(dst, b, h) do { _Pragma("unroll") for (int m = 0; m < 4; ++m) _Pragma("unroll") for (int k = 0; k < 2; ++k) dst[m][k] = *(const PG8_LAS bf16x8*)(lds + PG8_SA(b, h) + aoff + m * 2048 + k * 1024); } while (0)
#define PG8_LDB(dst, b, h) do { _Pragma("unroll") for (int n = 0; n < 2; ++n) _Pragma("unroll") for (int k = 0; k < 2; ++k) dst[n][k] = *(const PG8_LAS bf16x8*)(lds + PG8_SB(b, h) + boff + n * 2048 + k * 1024); } while (0)
#define PG8_MMA(ai, bj, At, Bt) do { __builtin_amdgcn_s_setprio(1); _Pragma("unroll") for (int m = 0; m < 4; ++m) _Pragma("unroll") for (int n = 0; n < 2; ++n) _Pragma("unroll") for (int k = 0; k < 2; ++k) \
        acc[ai][bj][m][n] = __builtin_amdgcn_mfma_f32_16x16x32_bf16(Bt[n][k], At[m][k], acc[ai][bj][m][n], 0, 0, 0); __builtin_amdgcn_s_setprio(0); } while (0)
#define PG8_WAIT_V(n) asm volatile("s_waitcnt vmcnt(" #n ")" ::: "memory")
#define PG8_WAIT_L(n) asm volatile("s_waitcnt lgkmcnt(" #n ")" ::: "memory")
#define PG8_BAR __builtin_amdgcn_s_barrier()
#define PG8_SCHED __builtin_amdgcn_sched_barrier(0)
    Unit cur, nxt; int ui = 0;
    if (!S.next(0, cur)) return;
    f32x4 acc[2][2][4][2];
#pragma unroll
    for (int a = 0; a < 2; ++a)
#pragma unroll
        for (int b = 0; b < 2; ++b)
#pragma unroll
            for (int m = 0; m < 4; ++m)
#pragma unroll
                for (int n = 0; n < 2; ++n) acc[a][b][m][n] = (f32x4){0.f, 0.f, 0.f, 0.f};
    bf16x8 At[4][2], B0[2][2], B1[2][2];
    const char* cA = (const char*)g.A + (size_t)cur.pm * tstep; const char* cB = (const char*)g.Bt + (size_t)cur.pn * tstep;
    S.a_ready(cur);
    if constexpr (SP2) {
        PG8_STAGE(PG8_SB(0, 0), cB, voffB); PG8_STAGE(PG8_SB(0, 1), cB + hstep, voffB); PG8_STAGE(PG8_SA(0, 0), cA, voffA); PG8_STAGE(PG8_SA(0, 1), cA + hstep, voffA);
        if (wr == 1) PG8_BAR;
        PG8_WAIT_V(2); PG8_BAR;
        PG8_STAGE(PG8_SB(1, 0), cB + kstep, voffB); PG8_STAGE(PG8_SA(1, 0), cA + kstep, voffA); PG8_STAGE(PG8_SB(1, 1), cB + hstep + kstep, voffB);
        PG8_WAIT_V(6); PG8_BAR;
    } else {
        PG8_STAGE(PG8_SB(0, 0), cB, voffB); PG8_STAGE(PG8_SA(0, 0), cA, voffA); PG8_STAGE(PG8_SB(0, 1), cB + hstep, voffB); PG8_STAGE(PG8_SA(0, 1), cA + hstep, voffA);
        if (wr == 1) PG8_BAR;
        PG8_WAIT_V(4); PG8_BAR;
        PG8_STAGE(PG8_SB(1, 0), cB + kstep, voffB); PG8_STAGE(PG8_SA(1, 0), cA + kstep, voffA); PG8_STAGE(PG8_SB(1, 1), cB + hstep + kstep, voffB);
        PG8_WAIT_V(6); PG8_BAR;
    }
    for (;;) {
        const bool has_next = S.next(ui + 1, nxt);
        const char* nA = has_next ? (const char*)g.A + (size_t)nxt.pm * tstep : cA; const char* nB = has_next ? (const char*)g.Bt + (size_t)nxt.pn * tstep : cB;
        for (int t = 0; t < nt; t += 2) {
            const bool last = (t == nt - 2);
            const char* a1 = cA + (size_t)(t + 1) * kstep;
            const char* a2 = last ? nA : cA + (size_t)(t + 2) * kstep; const char* b2 = last ? nB : cB + (size_t)(t + 2) * kstep;
            const char* a3 = a2 + kstep; const char* b3 = b2 + kstep;
            if (last && has_next) S.a_ready(nxt);
            if constexpr (SP2) {
            PG8_LDB(B0, 0, 0); PG8_LDB(B1, 0, 1); PG8_SCHED; PG8_LDA(At, 0, 0); PG8_STAGE(PG8_SA(1, 1), a1 + hstep, voffA);
            PG8_WAIT_V(8); PG8_WAIT_L(0); PG8_BAR; PG8_MMA(0, 0, At, B0); PG8_MMA(0, 1, At, B1); PG8_BAR; PG8_SCHED;
            PG8_LDA(At, 0, 1); PG8_STAGE(PG8_SB(0, 0), b2, voffB); PG8_STAGE(PG8_SB(0, 1), b2 + hstep, voffB); PG8_STAGE(PG8_SA(0, 0), a2, voffA);
            PG8_WAIT_V(8); PG8_WAIT_L(0); PG8_BAR; PG8_MMA(1, 0, At, B0); PG8_MMA(1, 1, At, B1); PG8_BAR; PG8_SCHED;
            PG8_LDB(B0, 1, 0); PG8_LDB(B1, 1, 1); PG8_SCHED; PG8_LDA(At, 1, 0); PG8_STAGE(PG8_SA(0, 1), a2 + hstep, voffA);
            PG8_WAIT_V(8); PG8_WAIT_L(0); PG8_BAR; PG8_MMA(0, 0, At, B0); PG8_MMA(0, 1, At, B1); PG8_BAR; PG8_SCHED;
            PG8_LDA(At, 1, 1); PG8_STAGE(PG8_SB(1, 0), b3, voffB); PG8_STAGE(PG8_SB(1, 1), b3 + hstep, voffB); PG8_STAGE(PG8_SA(1, 0), a3, voffA);
            PG8_WAIT_V(8); PG8_WAIT_L(0); PG8_BAR; PG8_MMA(1, 0, At, B0); PG8_MMA(1, 1, At, B1); PG8_BAR; PG8_SCHED;
            } else {
            PG8_LDB(B0, 0, 0); PG8_SCHED; PG8_LDA(At, 0, 0); PG8_STAGE(PG8_SA(1, 1), a1 + hstep, voffA);
            PG8_WAIT_L(8); PG8_BAR; PG8_WAIT_L(0); PG8_MMA(0, 0, At, B0); PG8_BAR; PG8_SCHED;
            PG8_LDB(B1, 0, 1); PG8_STAGE(PG8_SB(0, 0), b2, voffB);
            PG8_BAR; PG8_WAIT_L(0); PG8_MMA(0, 1, At, B1); PG8_BAR;
            PG8_LDA(At, 0, 1); PG8_STAGE(PG8_SA(0, 0), a2, voffA);
            PG8_BAR; PG8_WAIT_L(0); PG8_MMA(1, 0, At, B0); PG8_BAR; PG8_SCHED;
            PG8_STAGE(PG8_SB(0, 1), b2 + hstep, voffB);
            PG8_WAIT_V(6); PG8_BAR; PG8_MMA(1, 1, At, B1); PG8_BAR;
            PG8_LDB(B0, 1, 0); PG8_SCHED; PG8_LDA(At, 1, 0); PG8_STAGE(PG8_SA(0, 1), a2 + hstep, voffA);
            PG8_WAIT_L(8); PG8_BAR; PG8_WAIT_L(0); PG8_MMA(0, 0, At, B0); PG8_BAR; PG8_SCHED;
            PG8_LDB(B1, 1, 1); PG8_STAGE(PG8_SB(1, 0), b3, voffB);
            PG8_BAR; PG8_WAIT_L(0); PG8_MMA(0, 1, At, B1); PG8_BAR;
            PG8_LDA(At, 1, 1); PG8_STAGE(PG8_SA(1, 0), a3, voffA);
            PG8_BAR; PG8_WAIT_L(0); PG8_MMA(1, 0, At, B0); PG8_BAR; PG8_SCHED;
            PG8_STAGE(PG8_SB(1, 1), b3 + hstep, voffB);
            PG8_WAIT_V(6); PG8_BAR; PG8_MMA(1, 1, At, B1); PG8_BAR;
            }
        }
        if constexpr (ALIGN_EPI) { if (wr == 0) PG8_BAR; }
        if constexpr (!Epi::AFTER_DRAIN) { E(acc, cur, wr, wc, fr, fq); S.done(cur); }
        if (!has_next) break;
#pragma unroll
        for (int a = 0; a < 2; ++a)
#pragma unroll
            for (int b = 0; b < 2; ++b)
#pragma unroll
                for (int m = 0; m < 4; ++m)
#pragma unroll
                    for (int n = 0; n < 2; ++n) acc[a][b][m][n] = (f32x4){0.f, 0.f, 0.f, 0.f};
        cur = nxt; cA = nA; cB = nB; ++ui;
        if constexpr (ALIGN_EPI) { if (wr == 1) PG8_BAR; }
    }
    PG8_WAIT_V(0);
    if constexpr (!ALIGN_EPI) { if (wr == 0) PG8_BAR; }
    PG8_BAR;
    if constexpr (Epi::AFTER_DRAIN) { E.fused(acc, cur, wr, wc, fr, fq, lds, wid, lane); S.done(cur); }
#undef PG8_SA
#undef PG8_SB
#undef PG8_STAGE
#undef PG8_LDA
#undef PG8_LDB
#undef PG8_MMA
#undef PG8_WAIT_V
#undef PG8_WAIT_L
#undef PG8_BAR
#undef PG8_SCHED
}
}
namespace pg8 {
struct EpiProj {
    static constexpr bool PERM = true, AFTER_DRAIN = false;
    bf16_t* O;
    __device__ __forceinline__ void operator()(const f32x4 (&acc)[2][2][4][2], const Unit& u, int wr, int wc, int fr, int fq) const {
        const int row0 = u.pm * BM + wr * 64 + fr, col0 = u.pn * BM + wc * 32 + 8 * fq;
        const float sc = (u.pn == 2 || u.pn == 3) ? RK_SCALE : ((u.pn == 8 || u.pn == 9) ? QSCALE2 : 1.f);
#pragma unroll
        for (int ai = 0; ai < 2; ++ai)
#pragma unroll
            for (int m = 0; m < 4; ++m) { bf16_t* rowp = O + (size_t)(row0 + ai * HALF + m * 16) * NIN + col0;
#pragma unroll
                for (int bj = 0; bj < 2; ++bj) { const f32x4 v0 = acc[ai][bj][m][0] * sc, v1 = acc[ai][bj][m][1] * sc;
                    u32x4 w; w.x = cvt_pk_bf16(v0[0], v0[1]); w.y = cvt_pk_bf16(v0[2], v0[3]); w.z = cvt_pk_bf16(v1[0], v1[1]); w.w = cvt_pk_bf16(v1[2], v1[3]);
                    *(u32x4*)(rowp + bj * HALF) = w; } }
    }
};
struct EpiOut {
    static constexpr bool PERM = true, AFTER_DRAIN = false;
    const float* X; bf16_t* XB; float* RSS;
    __device__ __forceinline__ void operator()(const f32x4 (&acc)[2][2][4][2], const Unit& u, int wr, int wc, int fr, int fq) const {
        const int row0 = u.pm * BM + wr * 64 + fr, col0 = u.pn * BM + wc * 32 + 8 * fq;
#pragma unroll
        for (int ai = 0; ai < 2; ++ai)
#pragma unroll
            for (int m = 0; m < 4; ++m) { const int row = row0 + ai * HALF + m * 16; const size_t off = (size_t)row * DM + col0; float ss = 0.f;
#pragma unroll
                for (int bj = 0; bj < 2; ++bj) {
                    const f32x4 a0 = *(const f32x4*)(X + off + bj * HALF) + acc[ai][bj][m][0], a1 = *(const f32x4*)(X + off + bj * HALF + 4) + acc[ai][bj][m][1];
                    ss += (a0[0] * a0[0] + a0[1] * a0[1]) + (a0[2] * a0[2] + a0[3] * a0[3]) + (a1[0] * a1[0] + a1[1] * a1[1]) + (a1[2] * a1[2] + a1[3] * a1[3]);
                    u32x4 w; w.x = cvt_pk_bf16(a0[0], a0[1]); w.y = cvt_pk_bf16(a0[2], a0[3]); w.z = cvt_pk_bf16(a1[0], a1[1]); w.w = cvt_pk_bf16(a1[2], a1[3]);
                    *(u32x4*)(XB + off + bj * HALF) = w; }
                ss += __shfl_xor(ss, 16); ss += __shfl_xor(ss, 32);
                if (fq == 0) RSS[(size_t)row * 16 + u.pn * 4 + wc] = ss; }
    }
};
struct EpiQ {
    static constexpr bool PERM = true, AFTER_DRAIN = false;
    const float* RSS; bf16_t* Q;
    __device__ __forceinline__ void operator()(const f32x4 (&acc)[2][2][4][2], const Unit& u, int wr, int wc, int fr, int fq) const {
        const int row0 = u.pm * BM + wr * 64 + fr, col0 = u.pn * BM + wc * 32 + 8 * fq;
#pragma unroll
        for (int ai = 0; ai < 2; ++ai)
#pragma unroll
            for (int m = 0; m < 4; ++m) { const int row = row0 + ai * HALF + m * 16;
                const f32x4* rp = (const f32x4*)(RSS + (size_t)row * 16); const f32x4 s0 = rp[0], s1 = rp[1], s2 = rp[2], s3 = rp[3];
                const float ss = ((s0[0] + s0[1]) + (s0[2] + s0[3])) + ((s1[0] + s1[1]) + (s1[2] + s1[3])) + ((s2[0] + s2[1]) + (s2[2] + s2[3])) + ((s3[0] + s3[1]) + (s3[2] + s3[3]));
                const float rstd = 1.0f / sqrtf(ss * (1.0f / DM) + RMS_EPS);
                bf16_t* rowp = Q + (size_t)row * NQ + col0;
#pragma unroll
                for (int bj = 0; bj < 2; ++bj) { const f32x4 v0 = acc[ai][bj][m][0] * rstd, v1 = acc[ai][bj][m][1] * rstd;
                    u32x4 w; w.x = cvt_pk_bf16(v0[0], v0[1]); w.y = cvt_pk_bf16(v0[2], v0[3]); w.z = cvt_pk_bf16(v1[0], v1[1]); w.w = cvt_pk_bf16(v1[2], v1[3]);
                    *(u32x4*)(rowp + bj * HALF) = w; } }
    }
};
}
struct Params {
    const float *x, *norm_mix_g, *w_in, *diff_lambda, *diff_subln_g, *w_out, *norm_ffn_g, *peer_wq, *peer_subkeys, *peer_u, *peer_v, *final_norm_g;
    float* out; unsigned char* ws; int ph_lo, ph_hi;
};
__device__ __forceinline__ void p0_transpose_item(const float* W, int K, int N, bf16* WT, LAS float* scr, int item, int lane, const float* gk = nullptr) {
    const int nblk = N / 32, kb = item / nblk, nb = item % nblk, k0 = 64 * kb, n0 = 32 * nb;
#pragma unroll 8
    for (int i = 0; i < 32; ++i) { const int kk = 2 * i + (lane >> 5); scr[kk * 33 + (lane & 31)] = W[(size_t)(k0 + kk) * N + n0 + (lane & 31)] * (gk ? gk[k0 + kk] : 1.0f); }
    asm volatile("s_waitcnt lgkmcnt(0)" ::: "memory");
    const int c = lane & 7;
#pragma unroll
    for (int j = 0; j < 4; ++j) { const int n = (lane >> 3) + 8 * j; const LAS float* s = scr + (8 * c) * 33 + n;
        u32x4 o; o.x = pk2(s[0 * 33], s[1 * 33]); o.y = pk2(s[2 * 33], s[3 * 33]); o.z = pk2(s[4 * 33], s[5 * 33]); o.w = pk2(s[6 * 33], s[7 * 33]);
        *(u32x4*)(WT + (size_t)(n0 + n) * K + k0 + 8 * c) = o; }
    asm volatile("s_waitcnt lgkmcnt(0)" ::: "memory");
}
__device__ __forceinline__ void p0_convert(const float* src, bf16* dst, size_t n8, int gw, int ngw, int lane) {
    for (size_t g = (size_t)gw * 64 + lane; g < n8; g += (size_t)ngw * 64) {
        const f32x4 a = ((const f32x4*)src)[2 * g], b = ((const f32x4*)src)[2 * g + 1];
        u32x4 o; o.x = pk2(a[0], a[1]); o.y = pk2(a[2], a[3]); o.z = pk2(b[0], b[1]); o.w = pk2(b[2], b[3]);
        ((u32x4*)dst)[g] = o; }
}
__device__ __forceinline__ void p0_fp8_rows(const float* src, unsigned char* dst, unsigned short* sc16, int gw, int ngw, int lane) {
    float cal; { float one28 = 128.f; asm volatile("" : "+v"(one28)); const int enc = __builtin_amdgcn_cvt_pk_fp8_f32(one28, one28, 0, false); const f32x2 dec = __builtin_amdgcn_cvt_pk_f32_fp8(enc, false); cal = 128.f / dec.x; }
    for (int row0 = gw; row0 < NEXP; row0 += 2 * ngw) {
        f32x4 v[2][4]; float m[2];
#pragma unroll
        for (int q = 0; q < 2; ++q) { const f32x4* sp = (const f32x4*)(src + (size_t)(row0 + q * ngw) * DM + 16 * lane);
#pragma unroll
            for (int j = 0; j < 4; ++j) v[q][j] = sp[j]; }
#pragma unroll
        for (int q = 0; q < 2; ++q) { float mm = 0.f;
#pragma unroll
            for (int j = 0; j < 4; ++j) mm = fmaxf(mm, fmaxf(fmaxf(fabsf(v[q][j][0]), fabsf(v[q][j][1])), fmaxf(fabsf(v[q][j][2]), fabsf(v[q][j][3]))));
#pragma unroll
            for (int o = 1; o < 64; o <<= 1) mm = fmaxf(mm, __shfl_xor(mm, o));
            m[q] = mm; }
#pragma unroll
        for (int q = 0; q < 2; ++q) { const int row = row0 + q * ngw;
            const unsigned ib = (__float_as_uint(m[q] > 0.f ? m[q] * (1.0f / 224.f) : 1.f) + 0xffffu) & 0xffff0000u;
            const float sc = 1.0f / __uint_as_float(ib);
            u32x4 o;
#pragma unroll
            for (int j = 0; j < 4; ++j) { int pk = __builtin_amdgcn_cvt_pk_fp8_f32(v[q][j][0] * sc, v[q][j][1] * sc, 0, false); pk = __builtin_amdgcn_cvt_pk_fp8_f32(v[q][j][2] * sc, v[q][j][3] * sc, pk, true); o[j] = (unsigned)pk; }
            *(u32x4*)(dst + (size_t)row * DM + 16 * lane) = o;
            if (lane == 0) sc16[2 * row] = (unsigned short)(__float_as_uint(__uint_as_float(ib) * cal) >> 16); }
    }
}
__device__ __forceinline__ void p0_norm_row(const float* xrow, const float* g, bf16* orow, int lane) {
    const f32x4* xr = (const f32x4*)xrow + lane; const f32x4* gr = (const f32x4*)g + lane;
    f32x4 v[4]; float s = 0.f;
#pragma unroll
    for (int j = 0; j < 4; ++j) { v[j] = xr[64 * j]; s += (v[j][0] * v[j][0] + v[j][1] * v[j][1]) + (v[j][2] * v[j][2] + v[j][3] * v[j][3]); }
    const float rstd = 1.0f / sqrtf(wave_sum(s) * (1.f / DM) + RMS_EPS);
    u32x2* o8 = (u32x2*)orow + lane;
#pragma unroll
    for (int j = 0; j < 4; ++j) { const f32x4 gg = gr[64 * j]; u32x2 o; o.x = pk2(v[j][0] * rstd * gg[0], v[j][1] * rstd * gg[1]); o.y = pk2(v[j][2] * rstd * gg[2], v[j][3] * rstd * gg[3]); o8[64 * j] = o; }
}
__device__ __forceinline__ void p0_norm_row2(const float* xrow0, const float* xrow1, const float* g, bf16* orow0, bf16* orow1, int lane) {
    const f32x4* x0 = (const f32x4*)xrow0 + lane; const f32x4* x1 = (const f32x4*)xrow1 + lane; const f32x4* gr = (const f32x4*)g + lane;
    f32x4 a[4], b[4]; float sa = 0.f, sb = 0.f;
#pragma unroll
    for (int j = 0; j < 4; ++j) { a[j] = x0[64 * j]; b[j] = x1[64 * j]; }
#pragma unroll
    for (int j = 0; j < 4; ++j) { sa += (a[j][0] * a[j][0] + a[j][1] * a[j][1]) + (a[j][2] * a[j][2] + a[j][3] * a[j][3]); sb += (b[j][0] * b[j][0] + b[j][1] * b[j][1]) + (b[j][2] * b[j][2] + b[j][3] * b[j][3]); }
    const float ra = 1.0f / sqrtf(wave_sum(sa) * (1.f / DM) + RMS_EPS), rb = 1.0f / sqrtf(wave_sum(sb) * (1.f / DM) + RMS_EPS);
    u32x2* oa = (u32x2*)orow0 + lane; u32x2* ob = (u32x2*)orow1 + lane;
#pragma unroll
    for (int j = 0; j < 4; ++j) { const f32x4 gg = gr[64 * j];
        u32x2 o; o.x = pk2(a[j][0] * ra * gg[0], a[j][1] * ra * gg[1]); o.y = pk2(a[j][2] * ra * gg[2], a[j][3] * ra * gg[3]); oa[64 * j] = o;
        u32x2 q; q.x = pk2(b[j][0] * rb * gg[0], b[j][1] * rb * gg[1]); q.y = pk2(b[j][2] * rb * gg[2], b[j][3] * rb * gg[3]); ob[64 * j] = q; }
}
__device__ __forceinline__ void p0_i8_rows(const float* src, const float* gain, unsigned char* dst, unsigned short* sc16, int gw, int ngw, int lane) {
    f32x4 gq[4];
#pragma unroll
    for (int j = 0; j < 4; ++j) gq[j] = *(const f32x4*)(gain + 16 * lane + 4 * j);
    for (int row0 = gw; row0 < NEXP; row0 += 2 * ngw) {
        f32x4 v[2][4]; float m[2];
#pragma unroll
        for (int q = 0; q < 2; ++q) { const f32x4* sp = (const f32x4*)(src + (size_t)(row0 + q * ngw) * DM + 16 * lane);
#pragma unroll
            for (int j = 0; j < 4; ++j) v[q][j] = sp[j] * gq[j]; }
#pragma unroll
        for (int q = 0; q < 2; ++q) { float mm = 0.f;
#pragma unroll
            for (int j = 0; j < 4; ++j) mm = fmaxf(mm, fmaxf(fmaxf(fabsf(v[q][j][0]), fabsf(v[q][j][1])), fmaxf(fabsf(v[q][j][2]), fabsf(v[q][j][3]))));
#pragma unroll
            for (int o = 1; o < 64; o <<= 1) mm = fmaxf(mm, __shfl_xor(mm, o));
            m[q] = mm; }
#pragma unroll
        for (int q = 0; q < 2; ++q) { const int row = row0 + q * ngw;
            const unsigned ib = (__float_as_uint(m[q] > 0.f ? m[q] * (1.0f / 127.f) : 1.f) + 0xffffu) & 0xffff0000u;
            const float sc = 1.0f / __uint_as_float(ib);
            u32x4 o;
#pragma unroll
            for (int j = 0; j < 4; ++j) { const int b0 = (int)rintf(v[q][j][0] * sc), b1 = (int)rintf(v[q][j][1] * sc), b2 = (int)rintf(v[q][j][2] * sc), b3 = (int)rintf(v[q][j][3] * sc);
                o[j] = ((unsigned)b0 & 255u) | (((unsigned)b1 & 255u) << 8) | (((unsigned)b2 & 255u) << 16) | (((unsigned)b3 & 255u) << 24); }
            *(u32x4*)(dst + (size_t)row * DM + 16 * lane) = o;
            if (lane == 0) sc16[2 * row + 1] = (unsigned short)(ib >> 16); }
    }
}
__device__ __forceinline__ void p0_prologue(const Params& P, LAS unsigned char* lds, int wave, int lane) {
    LAS float* scr = (LAS float*)(lds + wave * 16384);
    const int gw = blockIdx.x * 8 + wave, ngw = gridDim.x * 8;
    constexpr int I_IN = (DM / 64) * (NIN / 32), I_OUT = (DM / 64) * (DM / 32), I_WQ = (DM / 64) * (NQ / 32), NIT = I_IN + I_OUT + I_WQ;
    bf16* WinT = (bf16*)(P.ws + WS_WIN); bf16* WoutT = (bf16*)(P.ws + WS_WOUT); bf16* WqT = (bf16*)(P.ws + WS_WQ);
    for (int it = gw; it < NIT; it += ngw) {
        int r = it;
        if (r < I_IN) { p0_transpose_item(P.w_in, DM, NIN, WinT, scr, r, lane); continue; } r -= I_IN;
        if (r < I_OUT) { p0_transpose_item(P.w_out, DM, DM, WoutT, scr, r, lane); continue; } r -= I_OUT;
        p0_transpose_item(P.peer_wq, DM, NQ, WqT, scr, r, lane, P.norm_ffn_g);
    }
    p0_convert(P.peer_subkeys, (bf16*)(P.ws + WS_SK), (size_t)16 * 128 * 128 / 8, gw, ngw, lane);
    p0_i8_rows(P.peer_u, P.norm_ffn_g, P.ws + WS_U, (unsigned short*)(P.ws + WS_SC), gw, ngw, lane);
    p0_fp8_rows(P.peer_v, P.ws + WS_V, (unsigned short*)(P.ws + WS_SC), gw, ngw, lane);
    bf16* H = (bf16*)(P.ws + WS_H);
    for (int m = gw; m < MTOK; m += 2 * ngw) p0_norm_row2(P.x + (size_t)m * DM, P.x + (size_t)(m + ngw) * DM, P.norm_mix_g, H + (size_t)m * DM, H + (size_t)(m + ngw) * DM, lane);
}
#define MFMA32(a, b, c) __builtin_amdgcn_mfma_f32_32x32x16_bf16((a), (b), (c), 0, 0, 0)
#define MFMA16(a, b, c) __builtin_amdgcn_mfma_f32_16x16x32_bf16((a), (b), (c), 0, 0, 0)
__device__ __forceinline__ float swap_max(float v) { auto rr = __builtin_amdgcn_permlane32_swap(__float_as_uint(v), __float_as_uint(v), false, false); return fmaxf(__uint_as_float(rr[0]), __uint_as_float(rr[1])); }
__device__ __forceinline__ float swap_add(float v) { auto rr = __builtin_amdgcn_permlane32_swap(__float_as_uint(v), __float_as_uint(v), false, false); return __uint_as_float(rr[0]) + __uint_as_float(rr[1]); }
__device__ __forceinline__ bf16x8 pack8(const f32x16& x, int s) {
    u32x4 p; p.x = pk2(x[8 * s], x[8 * s + 1]); p.y = pk2(x[8 * s + 2], x[8 * s + 3]); p.z = pk2(x[8 * s + 4], x[8 * s + 5]); p.w = pk2(x[8 * s + 6], x[8 * s + 7]);
    return __builtin_bit_cast(bf16x8, p);
}
constexpr float ATT_THR = 8.0f;
constexpr float ATT_NEG = -1.0e30f;

constexpr int PR = 272, PT = 320;
constexpr int AT_Q = 0, AT_KV = 256 * PR, AT_KVSZ = 64 * PR + 64 * PT;
static_assert(AT_KV + 2 * AT_KVSZ <= LDS_MAIN, "attention LDS");
__device__ __forceinline__ void attn_unit(const bf16* PROJ, bf16* Y, const float* subln_g, float lam, int b, int h, int qb, LAS unsigned char* lds) {
    int tid = threadIdx.x; asm volatile("" : "+v"(tid));
    const int lane = tid & 63, r32 = lane & 31, hi = lane >> 5;
    const int w = __builtin_amdgcn_readfirstlane(tid >> 6);
    const size_t rowbase = (size_t)b * SEQ;
    const float slope2 = exp2f(-2.f * (float)(h + 1)) * LOG2E;
    const int srow = tid >> 4, sch = tid & 15;
    const char* gbase = (const char*)(PROJ + rowbase * NIN + h * 128);
    const unsigned soff = (unsigned)(srow * NIN + sch * 8) * 2u;
    {   const char* qb_ = gbase + ((size_t)qb * 256 * NIN + C_DQ) * 2;
#pragma unroll
        for (int i = 0; i < 8; ++i) { const int row = srow + 32 * i; const u32x4 v = *(const u32x4*)(qb_ + (soff + (unsigned)(32 * i * NIN * 2))); *(LAS u32x4*)(lds + AT_Q + row * PR + sch * 16) = v; } }
    u32x4 sk[2], sv[2];
#define A_LOAD(j) do { const char* kb_ = gbase + ((size_t)(64 * (j)) * NIN + C_DK) * 2; const char* vb_ = gbase + ((size_t)(64 * (j)) * NIN + C_DV) * 2; \
        _Pragma("unroll") for (int i_ = 0; i_ < 2; ++i_) { sk[i_] = *(const u32x4*)(kb_ + (soff + (unsigned)(32 * i_ * NIN * 2))); sv[i_] = *(const u32x4*)(vb_ + (soff + (unsigned)(32 * i_ * NIN * 2))); } } while (0)
#define A_STORE(buf) do { _Pragma("unroll") for (int i_ = 0; i_ < 2; ++i_) { \
        *(LAS u32x4*)(lds + AT_KV + (buf) * AT_KVSZ + (srow + 32 * i_) * PR + sch * 16) = sk[i_]; *(LAS u32x4*)(lds + AT_KV + (buf) * AT_KVSZ + 64 * PR + (srow + 32 * i_) * PT + sch * 16) = sv[i_]; } } while (0)
    const int nt = 4 * qb + 4, jd = 4 * qb + (w >> 1);
    const int qpos = qb * 256 + 32 * w + r32;
    unsigned qbase = AT_Q + (32 * w + r32) * PR + hi * 16, kbase = r32 * PR + hi * 16;
    unsigned vbase = 64 * PR + (4 * hi + ((lane & 15) >> 2)) * PT + ((lane >> 4) & 1) * 32 + (lane & 3) * 8;
    f32x16 O1[4], O2[4];
#pragma unroll
    for (int c = 0; c < 4; ++c)
#pragma unroll
        for (int r = 0; r < 16; ++r) { O1[c][r] = 0.f; O2[c][r] = 0.f; }
    float mref[2] = {0.f, 0.f}, lsum[2] = {0.f, 0.f};
    bool started = false;
    A_LOAD(nt - 1); A_STORE(0); if (nt > 1) A_LOAD(nt - 2);
    __syncthreads();
    for (int it = 0; it < nt; ++it) {
        const int j = nt - 1 - it, cur = it & 1;
        asm volatile("" : "+v"(qbase), "+v"(kbase), "+v"(vbase));
        if (it + 1 < nt) A_STORE(cur ^ 1);
        if (it + 2 < nt) A_LOAD(j - 2);
        if (j <= jd) {
            const unsigned kvo = AT_KV + cur * AT_KVSZ;
            for (int kb = 1; kb >= 0; --kb) {
                const bool diag = (j == jd);
                if (diag && kb > (w & 1)) continue;
                const bool domask = diag && kb == (w & 1);
                bf16x8 Pb[2][2];
#pragma unroll
                for (int p = 0; p < 2; ++p) {
                    f32x16 S;
                    const float tb = slope2 * (float)(64 * j + 32 * kb - qpos + 4 * hi) - mref[p];
#pragma unroll
                    for (int r = 0; r < 16; ++r) S[r] = tb + slope2 * (float)((r & 3) + 8 * (r >> 2));
#pragma unroll
                    for (int ks = 0; ks < 4; ++ks) {
                        const bf16x8 qf = *(const LAS bf16x8*)(lds + qbase + (8 * p + 2 * ks) * 16);
                        const bf16x8 kf = *(const LAS bf16x8*)(lds + (kbase + kvo + kb * (32 * PR)) + (8 * p + 2 * ks) * 16);
                        S = MFMA32(kf, qf, S);
                    }
                    if (domask) {
#pragma unroll
                        for (int r = 0; r < 16; ++r) { const int kv = (r & 3) + 8 * (r >> 2) + 4 * hi; if (kv > r32) S[r] = ATT_NEG; } }
                    float rm = fmaxf(S[0], S[1]);
#pragma unroll
                    for (int r = 2; r < 16; ++r) rm = fmaxf(rm, S[r]);
                    rm = swap_max(rm);
                    if (!started) {
                        mref[p] = rm;
#pragma unroll
                        for (int r = 0; r < 16; ++r) S[r] -= rm;
                    } else if (__any(rm > ATT_THR)) {
                        const float dl = fmaxf(rm, 0.f); mref[p] += dl;
#pragma unroll
                        for (int r = 0; r < 16; ++r) S[r] -= dl;
                        const float f = exp2f(-dl); lsum[p] *= f;
                        if (p == 0) {
#pragma unroll
                            for (int c = 0; c < 4; ++c) O1[c] = O1[c] * f;
                        } else {
#pragma unroll
                            for (int c = 0; c < 4; ++c) O2[c] = O2[c] * f;
                        }
                    }
                    float ls = 0.f;
#pragma unroll
                    for (int r = 0; r < 16; ++r) { S[r] = __builtin_amdgcn_exp2f(S[r]); ls += S[r]; }
                    lsum[p] += ls;
                    Pb[p][0] = pack8(S, 0); Pb[p][1] = pack8(S, 1);
                }
                started = true;
#pragma unroll
                for (int c = 0; c < 4; ++c)
#pragma unroll
                    for (int ss = 0; ss < 2; ++ss) {
                        const LAS char* vp = (const LAS char*)lds + (vbase + kvo + kb * (32 * PT));
                        const bf16x8 vf = cat8(lds_tr(vp + ((16 * ss) * PT + c * 64)), lds_tr(vp + ((16 * ss + 8) * PT + c * 64)));
                        O1[c] = MFMA32(vf, Pb[0][ss], O1[c]); O2[c] = MFMA32(vf, Pb[1][ss], O2[c]);
                    }
            }
        }
        __syncthreads();
    }
#undef A_LOAD
#undef A_STORE
    const float inv1 = 1.0f / swap_add(lsum[0]), inv2 = lam / swap_add(lsum[1]);
    float ss = 0.f;
#pragma unroll
    for (int c = 0; c < 4; ++c)
#pragma unroll
        for (int r = 0; r < 16; ++r) { const float o = O1[c][r] * inv1 - O2[c][r] * inv2; O1[c][r] = o; ss += o * o; }
    ss = swap_add(ss);
    const float rstd = (1.0f / sqrtf(ss * (1.0f / 128.f) + RMS_EPS)) * 0.8f;
    bf16* yrow = Y + (rowbase + qpos) * DM + 512 + h * 128;
#pragma unroll
    for (int c = 0; c < 4; ++c)
#pragma unroll
        for (int g4 = 0; g4 < 4; ++g4) { const int dv0 = 32 * c + 8 * g4 + 4 * hi; const f32x4 gg = *(const f32x4*)(subln_g + dv0);
            u32x2 o; o.x = pk2(O1[c][4 * g4] * rstd * gg[0], O1[c][4 * g4 + 1] * rstd * gg[1]); o.y = pk2(O1[c][4 * g4 + 2] * rstd * gg[2], O1[c][4 * g4 + 3] * rstd * gg[3]);
            *(u32x2*)(yrow + dv0) = o; }
}

constexpr int RT_P = 0, RT_K = 128 * PR, RT_V = 2 * 128 * PR, RT_ST = 2 * 128 * PR + 128 * PT;
static_assert(RT_ST + 128 * PR <= LDS_MAIN, "retention LDS");
__device__ __forceinline__ u32x4 scale8(u32x4 v, float f) { u32x4 o; o.x = pk2(bf_lo(v.x) * f, bf_hi(v.x) * f); o.y = pk2(bf_lo(v.y) * f, bf_hi(v.y) * f); o.z = pk2(bf_lo(v.z) * f, bf_hi(v.z) * f); o.w = pk2(bf_lo(v.w) * f, bf_hi(v.w) * f); return o; }
__device__ __forceinline__ void ret_unit(const bf16* PROJ, bf16* Y, int b, int h, LAS unsigned char* lds) {
    int tid = threadIdx.x; asm volatile("" : "+v"(tid));
    const int lane = tid & 63, l15 = lane & 15, g = lane >> 4;
    const int w = __builtin_amdgcn_readfirstlane(tid >> 6);
    const size_t rowbase = (size_t)b * SEQ;
    const float gam = 1.0f - exp2f(-5.f - (float)h), lg = log2f(gam), cdec = exp2f(128.f * lg), g127 = exp2f(127.f * lg);
    const int srow = tid >> 4, sch = tid & 15;
    const char* gbase = (const char*)(PROJ + rowbase * NIN + h * 128);
    const unsigned soff = (unsigned)(srow * NIN + sch * 8) * 2u;
    const unsigned qoff = (unsigned)((16 * w + l15) * NIN + C_RQ + 8 * g) * 2u;
    const unsigned toff = (unsigned)((16 * w + l15) * NIN + C_RG + 4 * g) * 2u;
    const float qscale = exp2f(lg * (float)(16 * w + l15));
    u32x4 sk[4], sv[4];
#define R_LOAD(n) do { const char* kb_ = gbase + ((size_t)(128 * (n)) * NIN + C_RK) * 2; const char* vb_ = gbase + ((size_t)(128 * (n)) * NIN + C_RV) * 2; \
        _Pragma("unroll") for (int i_ = 0; i_ < 4; ++i_) { sk[i_] = *(const u32x4*)(kb_ + (soff + (unsigned)(32 * i_ * NIN * 2))); sv[i_] = *(const u32x4*)(vb_ + (soff + (unsigned)(32 * i_ * NIN * 2))); } } while (0)
#define R_STORE() do { _Pragma("unroll") for (int i_ = 0; i_ < 4; ++i_) { const int row_ = srow + 32 * i_; \
        *(LAS u32x4*)(lds + RT_K + row_ * PR + sch * 16) = scale8(sk[i_], exp2f(-lg * (float)row_)); *(LAS u32x4*)(lds + RT_V + row_ * PT + sch * 16) = sv[i_]; } } while (0)
#define Q_LOAD(n) do { const char* qb_ = gbase + (size_t)(128 * (n)) * NIN * 2; _Pragma("unroll") for (int s_ = 0; s_ < 4; ++s_) qraw[s_] = *(const u32x4*)(qb_ + (qoff + 64u * s_)); } while (0)
    f32x4 Sacc[8];
#pragma unroll
    for (int c = 0; c < 8; ++c) Sacc[c] = (f32x4){0.f, 0.f, 0.f, 0.f};
    for (int i = tid; i < 128 * PR / 16; i += 512) *(LAS u32x4*)(lds + RT_ST + i * 16) = (u32x4){0u, 0u, 0u, 0u};
    u32x4 qraw[4];
    R_LOAD(0); Q_LOAD(0); R_STORE();
    __syncthreads();
    const int tq = (lane & 15) >> 2, tp = lane & 3;
    unsigned b_k = RT_K + l15 * PR + g * 16;
    unsigned b_p = RT_P + (16 * w + l15) * PR + g * 16;
    unsigned b_pw = RT_P + (16 * w + l15) * PR + g * 8;
    unsigned b_kt = RT_K + (8 * g + tq) * PR + tp * 8 + w * 32;
    unsigned b_vt = RT_V + (8 * g + tq) * PT + tp * 8;
    unsigned b_st = RT_ST + l15 * PR + g * 16;
    unsigned b_sw = RT_ST + l15 * PR + (16 * w + 4 * g) * 2;
    for (int n = 0; n < SEQ / 128; ++n) {
        asm volatile("" : "+v"(b_k), "+v"(b_p), "+v"(b_pw), "+v"(b_kt), "+v"(b_vt), "+v"(b_st), "+v"(b_sw));
        bf16x8 Qf[4], Pf[4], KTf[4];
#pragma unroll
        for (int s = 0; s < 4; ++s) Qf[s] = __builtin_bit_cast(bf16x8, scale8(qraw[s], qscale));
#pragma unroll
        for (int jb = 0; jb < 8; ++jb) {
            f32x4 a = (f32x4){0.f, 0.f, 0.f, 0.f};
#pragma unroll
            for (int s = 0; s < 4; ++s) { const bf16x8 kf = *(const LAS bf16x8*)(lds + (b_k + jb * (16 * PR) + s * 64)); a = MFMA16(kf, Qf[s], a); }
            const int ii = 16 * w + l15, jj = 16 * jb + 4 * g;
            u32x2 pw; pw.x = pk2(jj <= ii ? a[0] : 0.f, jj + 1 <= ii ? a[1] : 0.f); pw.y = pk2(jj + 2 <= ii ? a[2] : 0.f, jj + 3 <= ii ? a[3] : 0.f);
            *(LAS u32x2*)(lds + (b_pw + jb * 32)) = pw;
        }
#pragma unroll
        for (int s = 0; s < 4; ++s) { Pf[s] = *(const LAS bf16x8*)(lds + (b_p + s * 64));
            KTf[s] = cat8(lds_tr((const LAS char*)lds + (b_kt + (32 * s) * PR)), lds_tr((const LAS char*)lds + (b_kt + (32 * s + 4) * PR))); }
        f32x4 OT[8];
#pragma unroll
        for (int c = 0; c < 8; ++c) {
            f32x4 o = (f32x4){0.f, 0.f, 0.f, 0.f}, t4 = (f32x4){0.f, 0.f, 0.f, 0.f};
#pragma unroll
            for (int s = 0; s < 4; ++s) {
                const bf16x8 vf = cat8(lds_tr((const LAS char*)lds + (b_vt + (32 * s) * PT + c * 32)), lds_tr((const LAS char*)lds + (b_vt + (32 * s + 4) * PT + c * 32)));
                const bf16x8 stf = *(const LAS bf16x8*)(lds + (b_st + c * (16 * PR) + s * 64));
                o = MFMA16(stf, Qf[s], o); o = MFMA16(vf, Pf[s], o); t4 = MFMA16(KTf[s], vf, t4);
            }
            OT[c] = o; Sacc[c] = Sacc[c] * cdec + t4 * g127;
            __builtin_amdgcn_sched_barrier(0);
        }
        if (n + 1 < SEQ / 128) { Q_LOAD(n + 1); R_LOAD(n + 1); }
        float ss = 0.f;
#pragma unroll
        for (int c = 0; c < 8; ++c) ss += (OT[c][0] * OT[c][0] + OT[c][1] * OT[c][1]) + (OT[c][2] * OT[c][2] + OT[c][3] * OT[c][3]);
        ss += __shfl_xor(ss, 16); ss += __shfl_xor(ss, 32);
        const float rstd = __builtin_amdgcn_rsqf(ss * (1.0f / 128.f) + RMS_EPS);
        const char* rgb = gbase + (size_t)(128 * n) * NIN * 2;
        char* yb = (char*)(Y + (rowbase + (size_t)n * 128) * DM + h * 128); const unsigned yoff = (unsigned)((16 * w + l15) * DM + 4 * g) * 2u;
#pragma unroll
        for (int c = 0; c < 8; ++c) { const u32x2 rg = *(const u32x2*)(rgb + (toff + 32u * c));
            const float r0 = bf_lo(rg.x), r1 = bf_hi(rg.x), r2 = bf_lo(rg.y), r3 = bf_hi(rg.y);
            const float s0 = r0 * __builtin_amdgcn_rcpf(1.f + __expf(-r0)), s1 = r1 * __builtin_amdgcn_rcpf(1.f + __expf(-r1)), s2 = r2 * __builtin_amdgcn_rcpf(1.f + __expf(-r2)), s3 = r3 * __builtin_amdgcn_rcpf(1.f + __expf(-r3));
            u32x2 o; o.x = pk2(OT[c][0] * rstd * s0, OT[c][1] * rstd * s1); o.y = pk2(OT[c][2] * rstd * s2, OT[c][3] * rstd * s3);
            *(u32x2*)(yb + (yoff + 32u * c)) = o; }
        __syncthreads();
#pragma unroll
        for (int c = 0; c < 8; ++c) { u32x2 o; o.x = pk2(Sacc[c][0] * gam, Sacc[c][1] * gam); o.y = pk2(Sacc[c][2] * gam, Sacc[c][3] * gam);
            *(LAS u32x2*)(lds + (b_sw + c * (16 * PR))) = o; }
        if (n + 1 < SEQ / 128) R_STORE();
        __syncthreads();
    }
#undef R_LOAD
#undef R_STORE
#undef Q_LOAD
}

constexpr int P2_NRET = BATCH * 4, P2_NATT = BATCH * 4 * 8, P2_NITEMS = P2_NRET + P2_NATT;
__device__ __forceinline__ void p2_mixers(const Params& P, LAS unsigned char* lds) {
    const int tid = threadIdx.x;
    unsigned* ctl = (unsigned*)(P.ws + WS_CTL);
    volatile LAS int* lctl = (volatile LAS int*)(lds + LDS_MAIN);
    const bf16* PROJ = (const bf16*)(P.ws + WS_PROJ); bf16* Y = (bf16*)(P.ws + WS_H);
    float d1 = 0.f, d2 = 0.f;
    for (int i = 0; i < 64; ++i) { d1 += P.diff_lambda[i] * P.diff_lambda[64 + i]; d2 += P.diff_lambda[128 + i] * P.diff_lambda[192 + i]; }
    const float lam = expf(d1) - expf(d2) + 0.2f;
    for (;;) {
        if (tid == 0) lctl[0] = (int)atomicAdd(ctl + CW_QUEUE, 1u);
        __syncthreads();
        const int item = __builtin_amdgcn_readfirstlane(lctl[0]);
        __syncthreads();
        if (item >= P2_NITEMS) break;
        if (item < P2_NRET) ret_unit(PROJ, Y, item >> 2, item & 3, lds);
        else { const int idx = item - P2_NRET; attn_unit(PROJ, Y, P.diff_subln_g, lam, (idx & 63) >> 2, idx & 3, 7 - (idx >> 6), lds); }
    }
}
#define XB_TMO      128
#define XB_XCNT(j)  (256  + 64 * (j))
#define XB_XSUB(j)  (1280 + 64 * (j))
#define XB_XGEN(j)  (2304 + 64 * (j))
#define XB_TOP      3328
#define XB_TOPGEN   3392
#define XCD_BAR_WORDS 3456
#define XB_SPIN_CAP (1u << 18)

__device__ __forceinline__ unsigned xb_ld(unsigned* p)              { return __hip_atomic_load(p, __ATOMIC_RELAXED, __HIP_MEMORY_SCOPE_AGENT); }
__device__ __forceinline__ unsigned xb_add(unsigned* p, unsigned v) { return __hip_atomic_fetch_add(p, v, __ATOMIC_RELAXED, __HIP_MEMORY_SCOPE_AGENT); }
__device__ __forceinline__ unsigned xb_xcc_id() { return (unsigned)__builtin_amdgcn_s_getreg((3 << 11) | 20) & 0xFu; }
#define XB_SPIN(cond, bar) do { unsigned _sp = 0; while (cond) { __builtin_amdgcn_s_sleep(1); \
    if ((++_sp & 255u) == 0u) { if (xb_ld(&(bar)[XB_TMO])) break; if (_sp > XB_SPIN_CAP) { atomicAdd(&(bar)[XB_TMO], 1u); break; } } } } while (0)

struct XcdBarrier {
    unsigned* bar; unsigned x;
    volatile LAS unsigned* st;
};

__device__ __forceinline__ XcdBarrier xcd_barrier_post(unsigned* bar, volatile LAS unsigned* st) {
    XcdBarrier b; b.bar = bar; b.x = xb_xcc_id(); b.st = st;
    if (threadIdx.x == 0) (void)xb_add(&bar[XB_XCNT(b.x)], 1u);
    return b;
}
__device__ __forceinline__ void xcd_barrier_complete(unsigned* bar, unsigned x, unsigned& nloc, unsigned& nx) {
    const unsigned G = gridDim.x * gridDim.y * gridDim.z;
    unsigned sum, cnt, mine, sp = 0u;
    for (;;) {
        sum = 0u; cnt = 0u; mine = 0u;
#pragma unroll
        for (unsigned j = 0; j < 16; ++j) { const unsigned c = xb_ld(&bar[XB_XCNT(j)]); sum += c; cnt += (c > 0u) ? 1u : 0u; mine = (j == x) ? c : mine; }
        if (sum == G) break;
        __builtin_amdgcn_s_sleep(1);
        if ((++sp & 255u) == 0u) { if (xb_ld(&bar[XB_TMO])) break; if (sp > XB_SPIN_CAP) { atomicAdd(&bar[XB_TMO], 1u); break; } }
    }
    nloc = mine > 0u ? mine : 1u; nx = cnt > 0u ? cnt : 1u;
}

__device__ __forceinline__ void xcd_barrier(const XcdBarrier& b) {
    asm volatile("s_waitcnt vmcnt(0)" ::: "memory");
    __syncthreads();
    if (threadIdx.x == 0) {
        unsigned* bar = b.bar;
        __builtin_amdgcn_s_waitcnt(0);
        unsigned nloc = b.st[0], nx = b.st[1];
        if (nloc == 0u) { xcd_barrier_complete(bar, b.x, nloc, nx); b.st[0] = nloc; b.st[1] = nx; }
        const unsigned old = xb_add(&bar[XB_XSUB(b.x)], 1u);
        const unsigned gen = old / nloc;
        if (old + 1u == (gen + 1u) * nloc) {
            __builtin_amdgcn_fence(__ATOMIC_RELEASE, "agent");
            asm volatile("s_waitcnt vmcnt(0)" ::: "memory");
            const unsigned og = xb_add(&bar[XB_TOP], 1u);
            const unsigned tg = og / nx;
            if (og + 1u == (tg + 1u) * nx) xb_add(&bar[XB_TOPGEN], 1u);
            else XB_SPIN(xb_ld(&bar[XB_TOPGEN]) == tg, bar);
            __builtin_amdgcn_fence(__ATOMIC_ACQUIRE, "agent");
            xb_add(&bar[XB_XGEN(b.x)], 1u);
            asm volatile("s_waitcnt vmcnt(0)" ::: "memory");
        } else {
            XB_SPIN(xb_ld(&bar[XB_XGEN(b.x)]) == gen, bar);
            __builtin_amdgcn_fence(__ATOMIC_ACQUIRE, "agent");
            asm volatile("s_waitcnt vmcnt(0)" ::: "memory");
        }
    }
    __syncthreads();
}
__device__ __forceinline__ int ord_key(float s) { const int b = __float_as_int(s); return b ^ ((b >> 31) & 0x7fffffff); }
__device__ __forceinline__ float ord_val(int k) { return __int_as_float(k ^ ((k >> 31) & 0x7fffffff)); }
__device__ __forceinline__ int med3i(int a, int b, int c) { int r; asm("v_med3_i32 %0, %1, %2, %3" : "=v"(r) : "v"(a), "v"(b), "v"(c)); return r; }
__device__ __forceinline__ int imax(int a, int b) { return a > b ? a : b; }
__device__ __forceinline__ int imin(int a, int b) { return a < b ? a : b; }
#define INS16(L, x) do { const int x_ = (x); _Pragma("unroll") for (int i_ = 15; i_ >= 1; --i_) L[i_] = med3i(L[i_ - 1], L[i_], x_); L[0] = imax(L[0], x_); } while (0)
__device__ __forceinline__ void merge_halves16(int (&L)[16]) {
    int c[16];
#pragma unroll
    for (int i = 0; i < 8; ++i) {
        auto r0 = __builtin_amdgcn_permlane32_swap((unsigned)L[i], (unsigned)L[15 - i], false, false);
        auto r1 = __builtin_amdgcn_permlane32_swap((unsigned)L[15 - i], (unsigned)L[i], false, false);
        const bool hi = (threadIdx.x & 32) != 0;
        const int pa_i = hi ? (int)r1[0] : (int)r0[1], pa_15i = hi ? (int)r0[0] : (int)r1[1];
        c[i] = imax(L[i], pa_15i); c[15 - i] = imax(L[15 - i], pa_i);
    }
#define BSTAGE(d) _Pragma("unroll") for (int i = 0; i < 16; ++i) if ((i & (d)) == 0) { const int a = c[i], b = c[i + (d)]; c[i] = imax(a, b); c[i + (d)] = imin(a, b); }
    BSTAGE(8) BSTAGE(4) BSTAGE(2) BSTAGE(1)
#undef BSTAGE
#pragma unroll
    for (int i = 0; i < 16; ++i) L[i] = c[i];
}
__device__ __forceinline__ float dpp_add(float v, const int ctrl_sel) {
    int m;
    if (ctrl_sel == 0) m = __builtin_amdgcn_update_dpp(0, __float_as_int(v), 0xB1, 0xf, 0xf, false);
    else if (ctrl_sel == 1) m = __builtin_amdgcn_update_dpp(0, __float_as_int(v), 0x4E, 0xf, 0xf, false);
    else if (ctrl_sel == 2) m = __builtin_amdgcn_update_dpp(0, __float_as_int(v), 0x141, 0xf, 0xf, false);
    else m = __builtin_amdgcn_update_dpp(0, __float_as_int(v), 0x128, 0xf, 0xf, false);
    return v + __int_as_float(m);
}
__device__ __forceinline__ float dot2bf(unsigned a, unsigned b, float acc) {
    typedef __bf16 bf2 __attribute__((ext_vector_type(2)));
    return __builtin_amdgcn_fdot2_f32_bf16(__builtin_bit_cast(bf2, a), __builtin_bit_cast(bf2, b), acc, false);
}
__device__ __forceinline__ float dot8(u32x4 a, u32x4 b, float acc) {
    const unsigned a0 = a.x, a1 = a.y, a2 = a.z, a3 = a.w, b0 = b.x, b1 = b.y, b2 = b.z, b3 = b.w;
    acc = dot2bf(a0, b0, acc); acc = dot2bf(a1, b1, acc); acc = dot2bf(a2, b2, acc); acc = dot2bf(a3, b3, acc);
    return acc;
}
#define AXPY8(accp, wk, v) do { (accp)[0] += (wk) * bf_lo((v).x); (accp)[1] += (wk) * bf_hi((v).x); (accp)[2] += (wk) * bf_lo((v).y); (accp)[3] += (wk) * bf_hi((v).y); \
        (accp)[4] += (wk) * bf_lo((v).z); (accp)[5] += (wk) * bf_hi((v).z); (accp)[6] += (wk) * bf_lo((v).w); (accp)[7] += (wk) * bf_hi((v).w); } while (0)


__device__ __forceinline__ void p5_scores(const Params& P, LAS unsigned char* lds) {
    int tid = threadIdx.x; asm volatile("" : "+v"(tid));
    const int lane = tid & 63, r32 = lane & 31, hi = lane >> 5;
    const int w = __builtin_amdgcn_readfirstlane(tid >> 6), tg = w >> 1, ph = w & 1;
    const int tok0 = blockIdx.x * 128;
    const bf16* SKb = (const bf16*)(P.ws + WS_SK); const bf16* Qb = (const bf16*)(P.ws + WS_Q);
    u32x2* ENT = (u32x2*)(P.ws + WS_H); const unsigned* SC = (const unsigned*)(P.ws + WS_SC);
    LAS int* lists = (LAS int*)(lds + 131072);
    u32x4 st[8];
#define S_LOAD(h) do { _Pragma("unroll") for (int i_ = 0; i_ < 8; ++i_) { const int n_ = tid + 512 * i_; st[i_] = *(const u32x4*)(SKb + ((size_t)(h) * 256 + (n_ >> 4)) * 128 + (n_ & 15) * 8); } } while (0)
#define S_STORE(buf) do { _Pragma("unroll") for (int i_ = 0; i_ < 8; ++i_) { const int n_ = tid + 512 * i_; *(LAS u32x4*)(lds + (buf) * 65536 + (n_ >> 11) * 32768 + off_b((n_ >> 4) & 127, n_ & 15)) = st[i_]; } } while (0)
    S_LOAD(0); S_STORE(0); S_LOAD(1);
    const bf16* qrow0 = Qb + (size_t)(tok0 + 32 * tg + r32) * NQ + ph * 128 + 8 * hi;
    bf16x8 qf[8];
#pragma unroll
    for (int ks = 0; ks < 8; ++ks) qf[ks] = *(const bf16x8*)(qrow0 + 16 * ks);
    __syncthreads();
    for (int h = 0; h < 8; ++h) {
        const int cur = h & 1;
        int L[16];
        {
            f32x16 acc[4];
#pragma unroll
            for (int kb = 0; kb < 4; ++kb)
#pragma unroll
                for (int r = 0; r < 16; ++r) acc[kb][r] = 0.f;
            const LAS unsigned char* SKl = lds + cur * 65536 + ph * 32768;
#pragma unroll
            for (int ks = 0; ks < 8; ++ks)
#pragma unroll
                for (int kb = 0; kb < 4; ++kb) { const bf16x8 a = *(const LAS bf16x8*)(SKl + off_b(32 * kb + r32, 2 * ks + hi)); acc[kb] = MFMA32(a, qf[ks], acc[kb]); }
            asm volatile("" : "+v"(acc[0]), "+v"(acc[1]), "+v"(acc[2]), "+v"(acc[3]));
            {   const bf16* qn = qrow0 + ((h + 1) & 7) * 256;
#pragma unroll
                for (int ks = 0; ks < 8; ++ks) qf[ks] = *(const bf16x8*)(qn + 16 * ks); }
#pragma unroll
            for (int i = 0; i < 16; ++i) L[i] = (int)0x80000000;
#pragma unroll
            for (int kb = 0; kb < 4; ++kb)
#pragma unroll
                for (int r = 0; r < 16; ++r) { const int key = 32 * kb + (r & 3) + 8 * (r >> 2) + 4 * hi; const int x = (ord_key(acc[kb][r]) & ~127) | key; INS16(L, x); }
        }
        merge_halves16(L);
        if (hi == 0) { LAS int* lp = lists + ((tg * 2 + ph) * 32 + r32) * 16;
#pragma unroll
            for (int i = 0; i < 4; ++i) *(LAS u32x4*)(lp + 4 * i) = (u32x4){(unsigned)L[4 * i], (unsigned)L[4 * i + 1], (unsigned)L[4 * i + 2], (unsigned)L[4 * i + 3]}; }
        if (h + 1 < 8) { S_STORE(cur ^ 1); if (h + 2 < 8) S_LOAD(h + 2); }
        __syncthreads();
        if (ph == 0) {
            const LAS int* la = lists + ((tg * 2 + 0) * 32 + r32) * 16; const LAS int* lb = lists + ((tg * 2 + 1) * 32 + r32) * 16;
            float A[16], B[16];
            {   int bl[16];
#pragma unroll
                for (int i = 0; i < 4; ++i) { const u32x4 v = *(const LAS u32x4*)(lb + 4 * i); bl[4 * i] = (int)v.x; bl[4 * i + 1] = (int)v.y; bl[4 * i + 2] = (int)v.z; bl[4 * i + 3] = (int)v.w; }
#pragma unroll
                for (int i = 0; i < 16; ++i) { const float av = ord_val(L[i] & ~127), bv = ord_val(bl[i] & ~127); A[i] = hi ? bv : av; B[i] = hi ? av : bv; } }
            int C[16];
#pragma unroll
            for (int i = 0; i < 16; ++i) C[i] = (int)0x80000000;
#define CAND(i, j) do { const float v_ = A[i] + B[j]; const int code_ = hi ? ((j) * 16 + (i)) : ((i) * 16 + (j)); const int x2_ = (ord_key(v_) & ~255) | code_; INS16(C, x2_); } while (0)
#pragma unroll
            for (int j = 1; j < 16; ++j) CAND(0, j);
#pragma unroll
            for (int j = 2; j < 8; ++j) CAND(1, j);
            CAND(2, 3); CAND(2, 4);
            {
                const float v0 = hi ? (A[2] + B[2]) : (A[0] + B[0]), v1 = hi ? (A[3] + B[3]) : (A[1] + B[1]);
                const int x0 = (ord_key(v0) & ~255) | (hi ? 0x22 : 0x00), x1 = (ord_key(v1) & ~255) | (hi ? 0x33 : 0x11);
                INS16(C, x0); INS16(C, x1); }
#undef CAND
            merge_halves16(C);
            float gsum = 0.f, e[16];
            const float vmax = ord_val(C[0] & ~255);
#pragma unroll
            for (int i = 0; i < 16; ++i) { e[i] = __expf(ord_val(C[i] & ~255) - vmax); gsum += e[i]; }
            const float ginv = 1.0f / gsum;
            u32x2* ep = ENT + (size_t)(tok0 + 32 * tg + r32) * 128 + h * 16 + hi * 8;
            int Cs[8]; float Gs[8];
#pragma unroll
            for (int i = 0; i < 8; ++i) { int c0 = C[i], c1 = C[i + 8]; float e0 = e[i], e1 = e[i + 8]; asm volatile("" : "+v"(c0), "+v"(c1), "+v"(e0), "+v"(e1)); Cs[i] = hi ? c1 : c0; Gs[i] = (hi ? e1 : e0) * ginv; }
#pragma unroll
            for (int i = 0; i < 8; i += 2) {
                u32x4 o;
                { const int code = Cs[i] & 255; const int i1 = la[code >> 4] & 127, i2 = lb[code & 15] & 127; const unsigned e_ = (unsigned)(i1 * 128 + i2); const unsigned sc_ = SC[e_]; o.x = e_ | ((sc_ >> 16) << 17); o.y = __float_as_uint(Gs[i] * __uint_as_float(sc_ << 16)); }
                { const int code = Cs[i + 1] & 255; const int i1 = la[code >> 4] & 127, i2 = lb[code & 15] & 127; const unsigned e_ = (unsigned)(i1 * 128 + i2); const unsigned sc_ = SC[e_]; o.z = e_ | ((sc_ >> 16) << 17); o.w = __float_as_uint(Gs[i + 1] * __uint_as_float(sc_ << 16)); }
                *(u32x4*)(ep + i) = o;
            }
        }
        __syncthreads();
    }
#undef S_LOAD
#undef S_STORE
}
__device__ __forceinline__ void fp8x16_to_f32(u32x4 v, float (&f)[16]) {
#pragma unroll
    for (int j = 0; j < 4; ++j) { const int wv_ = (int)v[j]; const f32x2 lo = __builtin_amdgcn_cvt_pk_f32_fp8(wv_, false), hi = __builtin_amdgcn_cvt_pk_f32_fp8(wv_, true);
        f[4 * j] = lo.x; f[4 * j + 1] = lo.y; f[4 * j + 2] = hi.x; f[4 * j + 3] = hi.y; }
}
constexpr int CW_PACE = 65536;
__device__ __forceinline__ void xcc_pace(unsigned* ctl, const XcdBarrier& b, unsigned step) {
    __syncthreads();
    if (threadIdx.x == 0) {
        unsigned* c = ctl + CW_PACE + 64 * b.x; const unsigned nloc = b.st[0];
        if (nloc != 0u) { xb_add(c, 1u); const unsigned want = (step + 1u) * nloc; unsigned sp = 0;
            while (xb_ld(c) < want) { __builtin_amdgcn_s_sleep(1); if (++sp > (1u << 16)) break; } }
    }
    __syncthreads();
}
#define P6_REP(k) (32 * ((k) >> 2) + 16 * (((k) >> 1) & 1) + 8 * ((k) & 1))
template <int MODE = 0>
__device__ __forceinline__ void p6_gather(const Params& P, LAS unsigned char* lds, const XcdBarrier& xbar, unsigned pace0 = 0) {
    int tid = threadIdx.x; asm volatile("" : "+v"(tid));
    const int lane = tid & 63, l7 = lane & 7;
    const int w = __builtin_amdgcn_readfirstlane(tid >> 6);
    const int tok0 = blockIdx.x * 128;
    const u32x2* ENT = (const u32x2*)(P.ws + WS_H);
    const bf16* XG = (const bf16*)(P.ws + WS_XG); const unsigned char* U8 = P.ws + WS_U; const unsigned char* V8 = P.ws + WS_V;
    const float* RSS = (const float*)(P.ws + WS_RSS);
    const int kk = 4 * (lane >> 5) + 2 * ((lane >> 4) & 1) + ((lane >> 3) & 1);
    const unsigned xsb = (unsigned)w * 8192u + (unsigned)lane * 16u;
    const unsigned ssb = 65536u + (unsigned)w * 8192u;
    const unsigned ska = ssb + (unsigned)kk * 8u;
    const unsigned skv = ssb + (unsigned)l7 * 8u;
    const unsigned rowoff = 16u * (unsigned)lane;
    xcd_barrier(xbar);
    unsigned pace_step = pace0;
    for (int r = 0; r < 2; ++r) {
        if (r > 0) xcc_pace((unsigned*)(P.ws + WS_CTL), xbar, pace_step++);
        float rstd[8];
#pragma unroll
        for (int t = 0; t < 8; ++t) {
            const size_t tok = (size_t)tok0 + 64 * r + 8 * w + t;
            const u32x4 e4 = ((const u32x4*)ENT)[tok * 64 + lane];
            float xscale;
            {
                const u32x4 xa = *(const u32x4*)(XG + tok * DM + 16 * lane), xb = *(const u32x4*)(XG + tok * DM + 16 * lane + 8); float xf[16];
#pragma unroll
                for (int j = 0; j < 4; ++j) { xf[2 * j] = bf_lo(xa[j]); xf[2 * j + 1] = bf_hi(xa[j]); xf[8 + 2 * j] = bf_lo(xb[j]); xf[8 + 2 * j + 1] = bf_hi(xb[j]); }
                float mx = 0.f;
#pragma unroll
                for (int i = 0; i < 16; ++i) mx = fmaxf(mx, fabsf(xf[i]));
                mx = wave_max_fast(mx);
                const float qs = mx > 0.f ? 127.f / mx : 1.f; u32x4 xq;
#pragma unroll
                for (int j = 0; j < 4; ++j) { const int b0 = (int)rintf(xf[4 * j] * qs), b1 = (int)rintf(xf[4 * j + 1] * qs), b2 = (int)rintf(xf[4 * j + 2] * qs), b3 = (int)rintf(xf[4 * j + 3] * qs);
                    xq[j] = ((unsigned)b0 & 255u) | (((unsigned)b1 & 255u) << 8) | (((unsigned)b2 & 255u) << 16) | (((unsigned)b3 & 255u) << 24); }
                *(LAS u32x4*)(lds + xsb + t * 1024) = xq; xscale = mx > 0.f ? mx * (1.0f / 127.f) : 1.f; }
            const f32x4* rp = (const f32x4*)(RSS + tok * 16); const f32x4 s0 = rp[0], s1 = rp[1], s2 = rp[2], s3 = rp[3];
            const float ssq = ((s0[0] + s0[1]) + (s0[2] + s0[3])) + ((s1[0] + s1[1]) + (s1[2] + s1[3])) + ((s2[0] + s2[1]) + (s2[2] + s2[3])) + ((s3[0] + s3[1]) + (s3[2] + s3[3]));
            rstd[t] = (1.0f / sqrtf(ssq * (1.0f / DM) + RMS_EPS)) * xscale;
            const unsigned bA = (e4.x >> 10) & 15u, bB = (e4.z >> 10) & 15u; int posA = 0, posB = 0, base = 0;
            for (int s = 0; s < 16; ++s) {
                const unsigned long long mA = __ballot(bA == (unsigned)s), mB = __ballot(bB == (unsigned)s);
                const int cA = __popcll(mA), cB = __popcll(mB);
                const int rA = (int)__builtin_amdgcn_mbcnt_hi((unsigned)(mA >> 32), __builtin_amdgcn_mbcnt_lo((unsigned)mA, 0u));
                const int rB = (int)__builtin_amdgcn_mbcnt_hi((unsigned)(mB >> 32), __builtin_amdgcn_mbcnt_lo((unsigned)mB, 0u));
                if (bA == (unsigned)s) posA = base + rA;
                if (bB == (unsigned)s) posB = base + cA + rB;
                base += cA + cB;
            }
            *(LAS u32x2*)(lds + ssb + t * 1024 + posA * 8) = (u32x2){e4.x, e4.y}; *(LAS u32x2*)(lds + ssb + t * 1024 + posB * 8) = (u32x2){e4.z, e4.w};
        }
        if (!(MODE & 1)) {   u32x4 ua[8]; u32x2 entN;
#define PA_PRE(B, T) do { entN = *(const LAS u32x2*)(lds + ska + (T) * 1024 + (B) * 64); \
            _Pragma("unroll") for (int k = 0; k < 8; ++k) { const unsigned ex_ = (unsigned)__builtin_amdgcn_readlane((int)entN.x, P6_REP(k)) & 16383u; ua[k] = *(const u32x4*)(U8 + (ex_ * 1024u + rowoff)); } } while (0)
#define PA_BODY(B, T, NB, NT) do { \
            const u32x2 ent = entN; const float suk = __uint_as_float((ent.x >> 17) << 16);     \
            const u32x4 xq = *(const LAS u32x4*)(lds + xsb + (T) * 1024); \
            int d[8]; \
            _Pragma("unroll") for (int k = 0; k < 8; ++k) d[k] = __builtin_amdgcn_sdot4((int)ua[k].x, (int)xq.x, __builtin_amdgcn_sdot4((int)ua[k].y, (int)xq.y, __builtin_amdgcn_sdot4((int)ua[k].z, (int)xq.z, __builtin_amdgcn_sdot4((int)ua[k].w, (int)xq.w, 0, false), false), false), false); \
            asm volatile("" : "+v"(d[0]), "+v"(d[1]), "+v"(d[2]), "+v"(d[3]), "+v"(d[4]), "+v"(d[5]), "+v"(d[6]), "+v"(d[7])); \
            PA_PRE(NB, NT);     \
            int s4[4], t2[2]; \
            _Pragma("unroll") for (int k = 0; k < 4; ++k) { auto rr = __builtin_amdgcn_permlane32_swap((unsigned)d[k], (unsigned)d[k + 4], false, false); s4[k] = (int)rr[0] + (int)rr[1]; } \
            _Pragma("unroll") for (int k = 0; k < 2; ++k) { auto rr = __builtin_amdgcn_permlane16_swap((unsigned)s4[k], (unsigned)s4[k + 2], false, false); t2[k] = (int)rr[0] + (int)rr[1]; } \
            const bool b3 = (lane & 8) != 0; \
            const int keep = b3 ? t2[1] : t2[0], give = b3 ? t2[0] : t2[1]; \
            int di = keep + __builtin_amdgcn_update_dpp(0, give, 0x128, 0xf, 0xf, false); \
            di += __builtin_amdgcn_update_dpp(0, di, 0xB1, 0xf, 0xf, false); di += __builtin_amdgcn_update_dpp(0, di, 0x4E, 0xf, 0xf, false); di += __builtin_amdgcn_update_dpp(0, di, 0x141, 0xf, 0xf, false); \
            const float a = rstd[T] * suk * (float)di; \
            const float wv = __uint_as_float(ent.y) * (0.5f * a * (1.0f + erff(a * 0.70710678118654752f)));     \
            if ((lane & 7) == 0) *(LAS float*)(lds + ska + (T) * 1024 + (B) * 64 + 4) = wv;     \
            __builtin_amdgcn_sched_barrier(0); \
        } while (0)
            {
            PA_PRE(0, 0);
#pragma unroll 1
            for (int b = 0; b < 16; ++b) {
                PA_BODY(b, 0, b, 1); PA_BODY(b, 1, b, 2); PA_BODY(b, 2, b, 3); PA_BODY(b, 3, b, 4);
                PA_BODY(b, 4, b, 5); PA_BODY(b, 5, b, 6); PA_BODY(b, 6, b, 7);
                PA_BODY(b, 7, (b + 1) & 15, 0);
            }
            }
#undef PA_PRE
#undef PA_BODY
        }
        asm volatile("s_waitcnt vmcnt(0) lgkmcnt(0)" ::: "memory");
        f32x2 acc[8][8];
#pragma unroll
        for (int t = 0; t < 8; ++t)
#pragma unroll
            for (int i = 0; i < 8; ++i) acc[t][i] = (f32x2){0.f, 0.f};
#ifndef PB_D
#define PB_D 4
#endif
        if (!(MODE & 2)) {   u32x4 va[8]; u32x2 evN;
#define PB_ENT(B, T) do { evN = *(const LAS u32x2*)(lds + skv + (T) * 1024 + (B) * 64); } while (0)
#define PB_LDV(k) do { const unsigned ex_ = (unsigned)__builtin_amdgcn_readlane((int)evN.x, (k)) & 16383u; va[k] = *(const u32x4*)(V8 + (ex_ * 1024u + rowoff)); } while (0)
#define PB_BODY(B, T, NB, NT) do { f32x2 (&accT)[8] = acc[T]; \
            const u32x2 evC = evN;     \
            PB_ENT(NB, NT); \
            _Pragma("unroll") for (int k = 0; k < 8; ++k) { \
                const float wk_ = __int_as_float(__builtin_amdgcn_readlane((int)evC.y, k)); const f32x2 wk2_ = {wk_, wk_}; \
                _Pragma("unroll") for (int j = 0; j < 4; ++j) { const int wv_ = (int)va[k][j]; const f32x2 lo_ = __builtin_amdgcn_cvt_pk_f32_fp8(wv_, false), hi_ = __builtin_amdgcn_cvt_pk_f32_fp8(wv_, true); \
                    accT[2 * j] = __builtin_elementwise_fma(lo_, wk2_, accT[2 * j]); accT[2 * j + 1] = __builtin_elementwise_fma(hi_, wk2_, accT[2 * j + 1]); } \
                asm volatile("" : "+v"(accT[0]), "+v"(accT[1]), "+v"(accT[2]), "+v"(accT[3]), "+v"(accT[4]), "+v"(accT[5]), "+v"(accT[6]), "+v"(accT[7])); \
                if (k < PB_D) { const unsigned ex_ = (unsigned)__builtin_amdgcn_readlane((int)evC.x, (k + (8 - PB_D)) & 7) & 16383u; va[(k + (8 - PB_D)) & 7] = *(const u32x4*)(V8 + (ex_ * 1024u + rowoff)); } \
                else { const unsigned ex_ = (unsigned)__builtin_amdgcn_readlane((int)evN.x, k - PB_D) & 16383u; va[k - PB_D] = *(const u32x4*)(V8 + (ex_ * 1024u + rowoff)); } } \
        } while (0)
            {
            PB_ENT(0, 0);
#pragma unroll
            for (int k = 0; k < 8 - PB_D; ++k) PB_LDV(k);
#pragma unroll 1
            for (int b = 0; b < 16; ++b) {
                PB_BODY(b, 0, b, 1); PB_BODY(b, 1, b, 2); PB_BODY(b, 2, b, 3); PB_BODY(b, 3, b, 4);
                PB_BODY(b, 4, b, 5); PB_BODY(b, 5, b, 6); PB_BODY(b, 6, b, 7);
                PB_BODY(b, 7, (b + 1) & 15, 0);
            }
            }
#undef PB_ENT
#undef PB_LDV
#undef PB_BODY
        }
#pragma unroll
        for (int t = 0; t < 8; ++t) {
            const size_t tok = (size_t)tok0 + 64 * r + 8 * w + t;
            float* orow = P.out + tok * DM + 16 * lane; const float* fg = P.final_norm_g + 16 * lane;
            const u32x4 ra = *(const u32x4*)(XG + tok * DM + 16 * lane), rb = *(const u32x4*)(XG + tok * DM + 16 * lane + 8);
            f32x4 xr[4]; float ss = 0.f;
            xr[0] = (f32x4){bf_lo(ra.x), bf_hi(ra.x), bf_lo(ra.y), bf_hi(ra.y)}; xr[1] = (f32x4){bf_lo(ra.z), bf_hi(ra.z), bf_lo(ra.w), bf_hi(ra.w)};
            xr[2] = (f32x4){bf_lo(rb.x), bf_hi(rb.x), bf_lo(rb.y), bf_hi(rb.y)}; xr[3] = (f32x4){bf_lo(rb.z), bf_hi(rb.z), bf_lo(rb.w), bf_hi(rb.w)};
#pragma unroll
            for (int j = 0; j < 4; ++j) { xr[j] += (f32x4){acc[t][2 * j].x, acc[t][2 * j].y, acc[t][2 * j + 1].x, acc[t][2 * j + 1].y};
                ss += (xr[j][0] * xr[j][0] + xr[j][1] * xr[j][1]) + (xr[j][2] * xr[j][2] + xr[j][3] * xr[j][3]); }
            const float rs = 1.0f / sqrtf(wave_sum_fast(ss) * (1.0f / DM) + RMS_EPS);
#pragma unroll
            for (int j = 0; j < 4; ++j) *(f32x4*)(orow + 4 * j) = xr[j] * rs * *(const f32x4*)(fg + 4 * j);
        }
    }
}
#if defined(DUP_PHASE) && DUP_PHASE == 6
#ifndef CAL_NT
#define CAL_NT 0
#endif
#if CAL_NT == 1
#define CAL_LD(p) __builtin_nontemporal_load(p)
#elif CAL_NT >= 2
__device__ __forceinline__ u32x4 cal_ld_asm(const u32x4* p) { u32x4 v;
#if CAL_NT == 2
    asm volatile("global_load_dwordx4 %0, %1, off sc0" : "=v"(v) : "v"(p) : "memory");
#elif CAL_NT == 3
    asm volatile("global_load_dwordx4 %0, %1, off sc1" : "=v"(v) : "v"(p) : "memory");
#else
    asm volatile("global_load_dwordx4 %0, %1, off sc0 sc1" : "=v"(v) : "v"(p) : "memory");
#endif
    return v; }
#define CAL_LD(p) cal_ld_asm(p)
#else
#define CAL_LD(p) (*(p))
#endif
#endif
constexpr int CW_BAR = 4096;
constexpr int NPHASE = 6;
__global__ void __launch_bounds__(512, 2) fwd(Params P) {
    __shared__ __attribute__((aligned(16))) unsigned char lds_raw[LDS_BYTES];
    LAS unsigned char* lds = (LAS unsigned char*)lds_raw;
    const int tid = threadIdx.x, lane = tid & 63, wave = __builtin_amdgcn_readfirstlane(tid >> 6);
    const int lo = P.ph_lo, hi = P.ph_hi, G = gridDim.x;
#define IN(k) (lo <= (k) && (k) < hi)
#define SEAM(k) do { if (IN(k) && IN((k) + 1)) { if ((k) == 2) cg::this_grid().sync(); else xcd_barrier(xbar); } } while (0)
    bf16* WinT = (bf16*)(P.ws + WS_WIN); bf16* WoutT = (bf16*)(P.ws + WS_WOUT); bf16* WqT = (bf16*)(P.ws + WS_WQ);
    bf16* Hb = (bf16*)(P.ws + WS_H); bf16* PROJ = (bf16*)(P.ws + WS_PROJ); bf16* XG = (bf16*)(P.ws + WS_XG); bf16* Qb = (bf16*)(P.ws + WS_Q);
    float* RSS = (float*)(P.ws + WS_RSS);
    if (tid < 16) ((volatile LAS unsigned*)(lds + LDS_MAIN))[tid] = 0u;
    __syncthreads();
    XcdBarrier xbar = xcd_barrier_post((unsigned*)(P.ws + WS_CTL) + CW_BAR, (volatile LAS unsigned*)(lds + LDS_MAIN + 32));

    if (IN(0)) { p0_prologue(P, lds, wave, lane);
#if defined(DUP_PHASE) && DUP_PHASE == 0
        p0_prologue(P, lds, wave, lane);
#endif
        SEAM(0); }
    if (IN(1)) {
        pg8::Gemm g{Hb, WinT, MTOK, NIN, DM}; pg8::StaticOrder S; S.init(MTOK, NIN, G, (int)blockIdx.x);
        pg8::EpiProj E{PROJ};
        pg8::gemm_phase<pg8::EpiProj, pg8::StaticOrder, true, true>(lds, g, S, E);
#if defined(DUP_PHASE) && DUP_PHASE == 1
        __syncthreads(); pg8::gemm_phase<pg8::EpiProj, pg8::StaticOrder, true, true>(lds, g, S, E);
#endif
        SEAM(1);
    }
    if (IN(2)) { p2_mixers(P, lds); SEAM(2); }
    if (IN(3)) {
        pg8::Gemm g{Hb  , WoutT, MTOK, DM, DM}; pg8::StaticOrder S; S.init(MTOK, DM, G, (int)blockIdx.x);
        pg8::EpiOut E{P.x, XG, RSS};
        pg8::gemm_phase<pg8::EpiOut, pg8::StaticOrder, true, true>(lds, g, S, E);
#if defined(DUP_PHASE) && DUP_PHASE == 3
        __syncthreads(); pg8::gemm_phase<pg8::EpiOut, pg8::StaticOrder, true, true>(lds, g, S, E);
#endif
        SEAM(3);
    }
    if (IN(4)) {
        pg8::Gemm g{XG, WqT, MTOK, NQ, DM}; pg8::StaticOrder S; S.init(MTOK, NQ, G, (int)blockIdx.x);
        pg8::EpiQ E{RSS, Qb};
        pg8::gemm_phase<pg8::EpiQ, pg8::StaticOrder, true, true>(lds, g, S, E);
#if defined(DUP_PHASE) && DUP_PHASE == 4
        __syncthreads(); pg8::gemm_phase<pg8::EpiQ, pg8::StaticOrder, true, true>(lds, g, S, E);
#endif
        SEAM(4);
    }
    if (IN(5)) { p5_scores(P, lds);
#if defined(DUP_PHASE) && DUP_PHASE == 5
        p5_scores(P, lds);
#endif
#if defined(DUP_PHASE) && DUP_PHASE == 7
        p6_gather<DUPMODE>(P, lds, xbar); p6_gather<0>(P, lds, xbar, 1);
#else
        p6_gather(P, lds, xbar);
#endif
#if defined(DUP_PHASE) && DUP_PHASE == 6
        {
            xcd_barrier(xbar);
            const unsigned char* T0 = P.ws + WS_U; const unsigned char* T1 = P.ws + WS_V;
            unsigned rs = ((unsigned)blockIdx.x * 8u + (unsigned)wave) * 2654435761u + 12345u; unsigned accx = 0;
#ifndef CAL_NT
#define CAL_NT 0
#endif
#if CAL_HALF
            for (int sw = 0; sw < 16; ++sw) { const unsigned char* T = ((sw >> 1) & 1) ? T1 : T0; const unsigned coff = (sw & 1) * 512u + lane * 8u;
                for (int it = 0; it < 512 / CAL_DEPTH; ++it) { u32x2 v[CAL_DEPTH];
#pragma unroll
                    for (int i = 0; i < CAL_DEPTH; ++i) { rs = rs * 1664525u + 1013904223u; const unsigned row = ((unsigned)it * (32u * CAL_DEPTH) + ((rs >> 10) & (CAL_BAND - 1u))) & 16383u; v[i] = *(const u32x2*)(T + (size_t)row * 1024 + coff); }
#pragma unroll
                    for (int i = 0; i < CAL_DEPTH; ++i) accx ^= v[i].x ^ v[i].y; } }
#else
            for (int sw = 0; sw < 8; ++sw) { const unsigned char* T = (sw & 1) ? T1 : T0; const unsigned coff = lane * 16u;
                for (int it = 0; it < 512 / CAL_DEPTH; ++it) { u32x4 v[CAL_DEPTH];
#pragma unroll
                    for (int i = 0; i < CAL_DEPTH; ++i) { rs = rs * 1664525u + 1013904223u; const unsigned row = ((unsigned)it * (32u * CAL_DEPTH) + ((rs >> 10) & (CAL_BAND - 1u))) & 16383u; v[i] = CAL_LD((const u32x4*)(T + (size_t)row * 1024 + coff)); }
#if CAL_NT >= 2
                    asm volatile("s_waitcnt vmcnt(0)" ::: "memory");
#pragma unroll
                    for (int i = 0; i < CAL_DEPTH; ++i) asm volatile("" : "+v"(v[i]));
#endif
#pragma unroll
                    for (int i = 0; i < CAL_DEPTH; ++i) accx ^= v[i].x ^ v[i].y ^ v[i].z ^ v[i].w; } }
#endif
            if (accx == 0x1234567u) P.out[0] = 1.f;
        }
#endif
    }
#undef IN
#undef SEAM
}

extern "C" void kernel_launch(void* const* d_in, const int* in_sizes, int n_in, void* d_out, int out_size, void* d_ws, size_t ws_size, hipStream_t stream) {
    static int grid = 0;
    if (grid == 0) {
        if (n_in != 12 || in_sizes[0] != MTOK * DM || out_size != MTOK * DM || ws_size < WS_END) { fprintf(stderr, "kernel_launch: unexpected shapes (n_in %d, in0 %d, out %d, ws %zu)\n", n_in, n_in > 0 ? in_sizes[0] : -1, out_size, ws_size); grid = -1; return; }
        int dev = 0, cus = 0, per_cu = 0;
        (void)hipGetDevice(&dev); (void)hipDeviceGetAttribute(&cus, hipDeviceAttributeMultiprocessorCount, dev);
        (void)hipOccupancyMaxActiveBlocksPerMultiprocessor(&per_cu, (const void*)fwd, 512, 0);
        (void)hipGetLastError();
        if (per_cu < 1 || cus != 256) { fprintf(stderr, "kernel_launch: occupancy %d, cus %d: need 1 block on each of 256 CUs\n", per_cu, cus); grid = -1; return; }
        grid = cus;
    }
    if (grid < 0) return;
    (void)hipMemsetAsync((char*)d_ws + WS_CTL, 0, CTL_BYTES, stream);
    Params p{};
    p.x = (const float*)d_in[0]; p.norm_mix_g = (const float*)d_in[1]; p.w_in = (const float*)d_in[2]; p.diff_lambda = (const float*)d_in[3];
    p.diff_subln_g = (const float*)d_in[4]; p.w_out = (const float*)d_in[5]; p.norm_ffn_g = (const float*)d_in[6]; p.peer_wq = (const float*)d_in[7];
    p.peer_subkeys = (const float*)d_in[8]; p.peer_u = (const float*)d_in[9]; p.peer_v = (const float*)d_in[10]; p.final_norm_g = (const float*)d_in[11];
    p.out = (float*)d_out; p.ws = (unsigned char*)d_ws;
    p.ph_lo = 0; p.ph_hi = NPHASE;
    void* args[] = {&p};
    hipError_t e = hipLaunchCooperativeKernel((const void*)fwd, dim3(grid), dim3(512), args, 0, stream);
    if (e != hipSuccess) fprintf(stderr, "kernel_launch: cooperative launch failed: %s\n", hipGetErrorString(e));
}
```

```cpp
#include <hip/hip_runtime.h>
#include <hip/hip_cooperative_groups.h>
#include <cstdio>
#include <cstdint>
namespace cg = cooperative_groups;

#define LAS __attribute__((address_space(3)))
typedef unsigned short bf16;
typedef short bf16x8 __attribute__((ext_vector_type(8)));
typedef short s16x4 __attribute__((ext_vector_type(4)));
typedef float f32x4 __attribute__((ext_vector_type(4)));
typedef float f32x2 __attribute__((ext_vector_type(2)));
typedef float f32x16 __attribute__((ext_vector_type(16)));
typedef unsigned u32x4 __attribute__((ext_vector_type(4)));
typedef unsigned u32x2 __attribute__((ext_vector_type(2)));
typedef int i32x2 __attribute__((ext_vector_type(2)));

constexpr int BATCH = 16, SEQ = 2048, DM = 1024, MTOK = BATCH * SEQ;
constexpr int NIN = 3584;
constexpr int C_RQ = 0, C_RK = 512, C_RV = 1024, C_RG = 1536, C_DQ = 2048, C_DK = 2560, C_DV = 3072;
constexpr int NQ = 2048;
constexpr int NEXP = 16384;
constexpr float RMS_EPS = 1e-6f;
constexpr float LOG2E = 1.4426950408889634f;
constexpr float QSCALE2 = 0.125f * LOG2E;
constexpr float RK_SCALE = 0.08838834764831845f;

constexpr size_t MiB = 1u << 20;
constexpr size_t WS_CTL = 0, CTL_BYTES = 1 * MiB;
constexpr size_t WS_WIN = 1 * MiB;
constexpr size_t WS_WOUT = 8 * MiB;
constexpr size_t WS_WQ = 10 * MiB;
constexpr size_t WS_SK = 14 * MiB;
constexpr size_t WS_RSS = 15 * MiB;
constexpr size_t WS_U = 17 * MiB;
constexpr size_t WS_V = 33 * MiB;
constexpr size_t WS_SC = 49 * MiB;
constexpr size_t WS_H = 81 * MiB;
constexpr size_t WS_PROJ = 145 * MiB;
constexpr size_t WS_XG = WS_PROJ;
constexpr size_t WS_Q = WS_PROJ + 64 * MiB;
constexpr size_t WS_END = WS_PROJ + 224 * MiB;
constexpr int CW_QUEUE = 64;

constexpr int LDS_MAIN = 147456;
constexpr int LDS_BYTES = LDS_MAIN + 256;

__device__ __forceinline__ unsigned f2bf(float f) { unsigned u = __builtin_bit_cast(unsigned, f); return (u + 0x7fffu + ((u >> 16) & 1u)) >> 16; }
__device__ __forceinline__ unsigned pk2(float lo, float hi) { typedef __bf16 bf16x2_t __attribute__((ext_vector_type(2))); f32x2 v = {lo, hi}; bf16x2_t b = __builtin_convertvector(v, bf16x2_t); return __builtin_bit_cast(unsigned, b); }
__device__ __forceinline__ float bf_lo(unsigned u) { return __builtin_bit_cast(float, u << 16); }
__device__ __forceinline__ float bf_hi(unsigned u) { return __builtin_bit_cast(float, u & 0xffff0000u); }
__device__ __forceinline__ unsigned off_b(unsigned row, unsigned ch) { return 256u * row + 16u * (ch ^ (((row & 3) << 2) | ((row >> 2) & 3))); }
__device__ __forceinline__ s16x4 lds_tr(const LAS char* p) { typedef short v4i16_t __attribute__((ext_vector_type(4))); return __builtin_bit_cast(s16x4, __builtin_amdgcn_ds_read_tr16_b64_v4i16((LAS v4i16_t*)p)); }
__device__ __forceinline__ bf16x8 cat8(s16x4 lo, s16x4 hi) { return __builtin_shufflevector(lo, hi, 0, 1, 2, 3, 4, 5, 6, 7); }
__device__ __forceinline__ float wave_sum(float v) {
#pragma unroll
    for (int o = 1; o < 64; o <<= 1) v += __shfl_xor(v, o);
    return v;
}
#define DPPF(v, ctrl) __int_as_float(__builtin_amdgcn_update_dpp(0, __float_as_int(v), ctrl, 0xf, 0xf, false))
__device__ __forceinline__ float wave_sum_fast(float v) {
    v += DPPF(v, 0xB1); v += DPPF(v, 0x4E); v += DPPF(v, 0x141); v += DPPF(v, 0x140);
    { auto r = __builtin_amdgcn_permlane16_swap(__float_as_uint(v), __float_as_uint(v), false, false); v = __uint_as_float(r[0]) + __uint_as_float(r[1]); }
    { auto r = __builtin_amdgcn_permlane32_swap(__float_as_uint(v), __float_as_uint(v), false, false); v = __uint_as_float(r[0]) + __uint_as_float(r[1]); }
    return v;
}
__device__ __forceinline__ float wave_max_fast(float v) {
    v = fmaxf(v, DPPF(v, 0xB1)); v = fmaxf(v, DPPF(v, 0x4E)); v = fmaxf(v, DPPF(v, 0x141)); v = fmaxf(v, DPPF(v, 0x140));
    { auto r = __builtin_amdgcn_permlane16_swap(__float_as_uint(v), __float_as_uint(v), false, false); v = fmaxf(__uint_as_float(r[0]), __uint_as_float(r[1])); }
    { auto r = __builtin_amdgcn_permlane32_swap(__float_as_uint(v), __float_as_uint(v), false, false); v = fmaxf(__uint_as_float(r[0]), __uint_as_float(r[1])); }
    return v;
}
namespace pg8 {
#define PG8_LAS __attribute__((address_space(3)))
typedef unsigned short bf16_t;
typedef short bf16x8 __attribute__((ext_vector_type(8)));
typedef float f32x4 __attribute__((ext_vector_type(4)));
typedef unsigned u32x4 __attribute__((ext_vector_type(4)));
constexpr int BM = 256, BK = 64, HALF = 128, HTB = HALF * BK * 2  , STAGE_BYTES = 8 * HTB, NXCD = 8, WGM = 8;

__host__ __device__ __forceinline__ int lds_byte(int r, int c) { const int st = (r >> 4) * 2 + (c >> 5), rr = r & 15, cc = c & 31, ob = rr * 64 + cc * 2; return st * 1024 + (ob ^ (((ob >> 9) & 1) << 5)); }
__host__ __device__ __forceinline__ void stage_rc(int b, int& R, int& C) { const int st = b / 1024, sb = b % 1024, swz = sb ^ (((sb >> 9) & 1) << 5); R = (st >> 1) * 16 + swz / 64; C = (st & 1) * 32 + (swz % 64) / 2; }
__host__ __device__ __forceinline__ int perm32(int rho) { const int n = rho >> 4, i = rho & 15; return 8 * (i >> 2) + 4 * n + (i & 3); }

struct Unit { int pm, pn; };
struct Gemm { const bf16_t* A; const bf16_t* Bt; int M, N, K; };

struct StaticOrder {
    int nM, nN, nwg, G, c;
    __host__ __device__ void init(int M, int N, int G_, int c_) { nM = M / BM; nN = N / BM; nwg = nM * nN; G = G_; c = c_; }
    __host__ __device__ bool next(int i, Unit& u) const {
        const long L = (long)i * G + c; if (L >= nwg) return false;
        int wgid = (int)L; { const int q = nwg / NXCD, r = nwg % NXCD, xcd = wgid % NXCD, off = wgid / NXCD; wgid = (xcd < r ? xcd * (q + 1) : r * (q + 1) + (xcd - r) * q) + off; }
        const int nig = WGM * nN, gid = wgid / nig, fm = gid * WGM, gsz = (nM - fm) < WGM ? (nM - fm) : WGM;
        u.pm = fm + ((wgid % nig) % gsz); u.pn = (wgid % nig) / gsz; return true;
    }
    __device__ __forceinline__ void a_ready(const Unit&) const {}
    __device__ __forceinline__ void done(const Unit&) const {}
};

__device__ __forceinline__ unsigned cvt_pk_bf16(float lo, float hi) { unsigned r; asm volatile("v_cvt_pk_bf16_f32 %0, %1, %2" : "=v"(r) : "v"(lo), "v"(hi)); return r; }
typedef float f32x2 __attribute__((ext_vector_type(2)));
__device__ __forceinline__ f32x2 gelu_pk(f32x2 v) {
    const f32x2 av = __builtin_elementwise_abs(v), d = av * 0.2316418882f + 1.0f;
    f32x2 t; t.x = __builtin_amdgcn_rcpf(d.x); t.y = __builtin_amdgcn_rcpf(d.y);
    f32x2 q = t * 0.5307027145f + (-0.7265760135f); q = q * t + 0.7107068705f; q = q * t + (-0.142248368f); q = q * t + 0.127414796f; q = q * t;
    const f32x2 s = (v * v) * (-0.72134752044f);
    f32x2 e; e.x = __builtin_amdgcn_exp2f(s.x); e.y = __builtin_amdgcn_exp2f(s.y);
    const f32x2 m = v * (q * e), r = v - m;
    f32x2 o; o.x = v.x < 0.f ? m.x : r.x; o.y = v.y < 0.f ? m.y : r.y; return o;
}

template <class Epi, class Sched, bool ALIGN_EPI = false, bool SP2 = false>
__device__ __forceinline__ void gemm_phase(PG8_LAS unsigned char* lds, const Gemm g, const Sched& S, const Epi& E) {
    const int tid = threadIdx.x, wid = __builtin_amdgcn_readfirstlane(tid >> 6), lane = tid & 63, wr = wid >> 2, wc = wid & 3, fr = lane & 15, fq = lane >> 4;
    const int K = g.K, nt = K / BK;
    unsigned voffA[2], voffB[2];
#pragma unroll
    for (int i = 0; i < 2; ++i) { int R, C; stage_rc(tid * 16 + i * 8192, R, C); const int Rb = Epi::PERM ? ((R & ~31) + perm32(R & 31)) : R;
        voffA[i] = (unsigned)(R * K + C) * 2u; voffB[i] = (unsigned)(Rb * K + C) * 2u; }
    const size_t kstep = (size_t)(BK * 2);
    const size_t hstep = (size_t)HALF * K * 2;
    const size_t tstep = 2 * hstep;
    const unsigned ldsw = (unsigned)wid * 1024u;
    const int aoff = lds_byte(wr * 64 + fr, fq * 8), boff = lds_byte(wc * 32 + fr, fq * 8);
#define PG8_SA(b, h) (((b) * 2 + (h)) * HTB)
#define PG8_SB(b, h) ((4 + (b) * 2 + (h)) * HTB)
#define PG8_STAGE(bufoff, gbase, voff) do { _Pragma("unroll") for (int _i = 0; _i < 2; ++_i) \
        __builtin_amdgcn_global_load_lds((const unsigned*)((const char*)(gbase) + (voff)[_i]), (PG8_LAS unsigned*)(lds + (bufoff) + ldsw + _i * 8192), 16, 0, 0); } while (0)
#define PG8_LDA(dst, b, h) do { _Pragma("unroll") for (int m = 0; m < 4; ++m) _Pragma("unroll") for (int k = 0; k < 2; ++k) dst[m][k] = *(const PG8_LAS bf16x8*)(lds + PG8_SA(b, h) + aoff + m * 2048 + k * 1024); } while (0)
#define PG8_LDB(dst, b, h) do { _Pragma("unroll") for (int n = 0; n < 2; ++n) _Pragma("unroll") for (int k = 0; k < 2; ++k) dst[n][k] = *(const PG8_LAS bf16x8*)(lds + PG8_SB(b, h) + boff + n * 2048 + k * 1024); } while (0)
#define PG8_MMA(ai, bj, At, Bt) do { __builtin_amdgcn_s_setprio(1); _Pragma("unroll") for (int m = 0; m < 4; ++m) _Pragma("unroll") for (int n = 0; n < 2; ++n) _Pragma("unroll") for (int k = 0; k < 2; ++k) \
        acc[ai][bj][m][n] = __builtin_amdgcn_mfma_f32_16x16x32_bf16(Bt[n][k], At[m][k], acc[ai][bj][m][n], 0, 0, 0); __builtin_amdgcn_s_setprio(0); } while (0)
#define PG8_WAIT_V(n) asm volatile("s_waitcnt vmcnt(" #n ")" ::: "memory")
#define PG8_WAIT_L(n) asm volatile("s_waitcnt lgkmcnt(" #n ")" ::: "memory")
#define PG8_BAR __builtin_amdgcn_s_barrier()
#define PG8_SCHED __builtin_amdgcn_sched_barrier(0)
    Unit cur, nxt; int ui = 0;
    if (!S.next(0, cur)) return;
    f32x4 acc[2][2][4][2];
#pragma unroll
    for (int a = 0; a < 2; ++a)
#pragma unroll
        for (int b = 0; b < 2; ++b)
#pragma unroll
            for (int m = 0; m < 4; ++m)
#pragma unroll
                for (int n = 0; n < 2; ++n) acc[a][b][m][n] = (f32x4){0.f, 0.f, 0.f, 0.f};
    bf16x8 At[4][2], B0[2][2], B1[2][2];
    const char* cA = (const char*)g.A + (size_t)cur.pm * tstep; const char* cB = (const char*)g.Bt + (size_t)cur.pn * tstep;
    S.a_ready(cur);
    if constexpr (SP2) {
        PG8_STAGE(PG8_SB(0, 0), cB, voffB); PG8_STAGE(PG8_SB(0, 1), cB + hstep, voffB); PG8_STAGE(PG8_SA(0, 0), cA, voffA); PG8_STAGE(PG8_SA(0, 1), cA + hstep, voffA);
        if (wr == 1) PG8_BAR;
        PG8_WAIT_V(2); PG8_BAR;
        PG8_STAGE(PG8_SB(1, 0), cB + kstep, voffB); PG8_STAGE(PG8_SA(1, 0), cA + kstep, voffA); PG8_STAGE(PG8_SB(1, 1), cB + hstep + kstep, voffB);
        PG8_WAIT_V(6); PG8_BAR;
    } else {
        PG8_STAGE(PG8_SB(0, 0), cB, voffB); PG8_STAGE(PG8_SA(0, 0), cA, voffA); PG8_STAGE(PG8_SB(0, 1), cB + hstep, voffB); PG8_STAGE(PG8_SA(0, 1), cA + hstep, voffA);
        if (wr == 1) PG8_BAR;
        PG8_WAIT_V(4); PG8_BAR;
        PG8_STAGE(PG8_SB(1, 0), cB + kstep, voffB); PG8_STAGE(PG8_SA(1, 0), cA + kstep, voffA); PG8_STAGE(PG8_SB(1, 1), cB + hstep + kstep, voffB);
        PG8_WAIT_V(6); PG8_BAR;
    }
    for (;;) {
        const bool has_next = S.next(ui + 1, nxt);
        const char* nA = has_next ? (const char*)g.A + (size_t)nxt.pm * tstep : cA; const char* nB = has_next ? (const char*)g.Bt + (size_t)nxt.pn * tstep : cB;
        for (int t = 0; t < nt; t += 2) {
            const bool last = (t == nt - 2);
            const char* a1 = cA + (size_t)(t + 1) * kstep;
            const char* a2 = last ? nA : cA + (size_t)(t + 2) * kstep; const char* b2 = last ? nB : cB + (size_t)(t + 2) * kstep;
            const char* a3 = a2 + kstep; const char* b3 = b2 + kstep;
            if (last && has_next) S.a_ready(nxt);
            if constexpr (SP2) {
            PG8_LDB(B0, 0, 0); PG8_LDB(B1, 0, 1); PG8_SCHED; PG8_LDA(At, 0, 0); PG8_STAGE(PG8_SA(1, 1), a1 + hstep, voffA);
            PG8_WAIT_V(8); PG8_WAIT_L(0); PG8_BAR; PG8_MMA(0, 0, At, B0); PG8_MMA(0, 1, At, B1); PG8_BAR; PG8_SCHED;
            PG8_LDA(At, 0, 1); PG8_STAGE(PG8_SB(0, 0), b2, voffB); PG8_STAGE(PG8_SB(0, 1), b2 + hstep, voffB); PG8_STAGE(PG8_SA(0, 0), a2, voffA);
            PG8_WAIT_V(8); PG8_WAIT_L(0); PG8_BAR; PG8_MMA(1, 0, At, B0); PG8_MMA(1, 1, At, B1); PG8_BAR; PG8_SCHED;
            PG8_LDB(B0, 1, 0); PG8_LDB(B1, 1, 1); PG8_SCHED; PG8_LDA(At, 1, 0); PG8_STAGE(PG8_SA(0, 1), a2 + hstep, voffA);
            PG8_WAIT_V(8); PG8_WAIT_L(0); PG8_BAR; PG8_MMA(0, 0, At, B0); PG8_MMA(0, 1, At, B1); PG8_BAR; PG8_SCHED;
            PG8_LDA(At, 1, 1); PG8_STAGE(PG8_SB(1, 0), b3, voffB); PG8_STAGE(PG8_SB(1, 1), b3 + hstep, voffB); PG8_STAGE(PG8_SA(1, 0), a3, voffA);
            PG8_WAIT_V(8); PG8_WAIT_L(0); PG8_BAR; PG8_MMA(1, 0, At, B0); PG8_MMA(1, 1, At, B1); PG8_BAR; PG8_SCHED;
            } else {
            PG8_LDB(B0, 0, 0); PG8_SCHED; PG8_LDA(At, 0, 0); PG8_STAGE(PG8_SA(1, 1), a1 + hstep, voffA);
            PG8_WAIT_L(8); PG8_BAR; PG8_WAIT_L(0); PG8_MMA(0, 0, At, B0); PG8_BAR; PG8_SCHED;
            PG8_LDB(B1, 0, 1); PG8_STAGE(PG8_SB(0, 0), b2, voffB);
            PG8_BAR; PG8_WAIT_L(0); PG8_MMA(0, 1, At, B1); PG8_BAR;
            PG8_LDA(At, 0, 1); PG8_STAGE(PG8_SA(0, 0), a2, voffA);
            PG8_BAR; PG8_WAIT_L(0); PG8_MMA(1, 0, At, B0); PG8_BAR; PG8_SCHED;
            PG8_STAGE(PG8_SB(0, 1), b2 + hstep, voffB);
            PG8_WAIT_V(6); PG8_BAR; PG8_MMA(1, 1, At, B1); PG8_BAR;
            PG8_LDB(B0, 1, 0); PG8_SCHED; PG8_LDA(At, 1, 0); PG8_STAGE(PG8_SA(0, 1), a2 + hstep, voffA);
            PG8_WAIT_L(8); PG8_BAR; PG8_WAIT_L(0); PG8_MMA(0, 0, At, B0); PG8_BAR; PG8_SCHED;
            PG8_LDB(B1, 1, 1); PG8_STAGE(PG8_SB(1, 0), b3, voffB);
            PG8_BAR; PG8_WAIT_L(0); PG8_MMA(0, 1, At, B1); PG8_BAR;
            PG8_LDA(At, 1, 1); PG8_STAGE(PG8_SA(1, 0), a3, voffA);
            PG8_BAR; PG8_WAIT_L(0); PG8_MMA(1, 0, At, B0); PG8_BAR; PG8_SCHED;
            PG8_STAGE(PG8_SB(1, 1), b3 + hstep, voffB);
            PG8_WAIT_V(6); PG8_BAR; PG8_MMA(1, 1, At, B1); PG8_BAR;
            }
        }
        if constexpr (ALIGN_EPI) { if (wr == 0) PG8_BAR; }
        if constexpr (!Epi::AFTER_DRAIN) { E(acc, cur, wr, wc, fr, fq); S.done(cur); }
        if (!has_next) break;
#pragma unroll
        for (int a = 0; a < 2; ++a)
#pragma unroll
            for (int b = 0; b < 2; ++b)
#pragma unroll
                for (int m = 0; m < 4; ++m)
#pragma unroll
                    for (int n = 0; n < 2; ++n) acc[a][b][m][n] = (f32x4){0.f, 0.f, 0.f, 0.f};
        cur = nxt; cA = nA; cB = nB; ++ui;
        if constexpr (ALIGN_EPI) { if (wr == 1) PG8_BAR; }
    }
    PG8_WAIT_V(0);
    if constexpr (!ALIGN_EPI) { if (wr == 0) PG8_BAR; }
    PG8_BAR;
    if constexpr (Epi::AFTER_DRAIN) { E.fused(acc, cur, wr, wc, fr, fq, lds, wid, lane); S.done(cur); }
#undef PG8_SA
#undef PG8_SB
#undef PG8_STAGE
#undef PG8_LDA
#undef PG8_LDB
#undef PG8_MMA
#undef PG8_WAIT_V
#undef PG8_WAIT_L
#undef PG8_BAR
#undef PG8_SCHED
}
}
namespace pg8 {
struct EpiProj {
    static constexpr bool PERM = true, AFTER_DRAIN = false;
    bf16_t* O;
    __device__ __forceinline__ void operator()(const f32x4 (&acc)[2][2][4][2], const Unit& u, int wr, int wc, int fr, int fq) const {
        const int row0 = u.pm * BM + wr * 64 + fr, col0 = u.pn * BM + wc * 32 + 8 * fq;
        const float sc = (u.pn == 2 || u.pn == 3) ? RK_SCALE : ((u.pn == 8 || u.pn == 9) ? QSCALE2 : 1.f);
#pragma unroll
        for (int ai = 0; ai < 2; ++ai)
#pragma unroll
            for (int m = 0; m < 4; ++m) { bf16_t* rowp = O + (size_t)(row0 + ai * HALF + m * 16) * NIN + col0;
#pragma unroll
                for (int bj = 0; bj < 2; ++bj) { const f32x4 v0 = acc[ai][bj][m][0] * sc, v1 = acc[ai][bj][m][1] * sc;
                    u32x4 w; w.x = cvt_pk_bf16(v0[0], v0[1]); w.y = cvt_pk_bf16(v0[2], v0[3]); w.z = cvt_pk_bf16(v1[0], v1[1]); w.w = cvt_pk_bf16(v1[2], v1[3]);
                    *(u32x4*)(rowp + bj * HALF) = w; } }
    }
};
struct EpiOut {
    static constexpr bool PERM = true, AFTER_DRAIN = false;
    const float* X; bf16_t* XB; float* RSS;
    __device__ __forceinline__ void operator()(const f32x4 (&acc)[2][2][4][2], const Unit& u, int wr, int wc, int fr, int fq) const {
        const int row0 = u.pm * BM + wr * 64 + fr, col0 = u.pn * BM + wc * 32 + 8 * fq;
#pragma unroll
        for (int ai = 0; ai < 2; ++ai)
#pragma unroll
            for (int m = 0; m < 4; ++m) { const int row = row0 + ai * HALF + m * 16; const size_t off = (size_t)row * DM + col0; float ss = 0.f;
#pragma unroll
                for (int bj = 0; bj < 2; ++bj) {
                    const f32x4 a0 = *(const f32x4*)(X + off + bj * HALF) + acc[ai][bj][m][0], a1 = *(const f32x4*)(X + off + bj * HALF + 4) + acc[ai][bj][m][1];
                    ss += (a0[0] * a0[0] + a0[1] * a0[1]) + (a0[2] * a0[2] + a0[3] * a0[3]) + (a1[0] * a1[0] + a1[1] * a1[1]) + (a1[2] * a1[2] + a1[3] * a1[3]);
                    u32x4 w; w.x = cvt_pk_bf16(a0[0], a0[1]); w.y = cvt_pk_bf16(a0[2], a0[3]); w.z = cvt_pk_bf16(a1[0], a1[1]); w.w = cvt_pk_bf16(a1[2], a1[3]);
                    *(u32x4*)(XB + off + bj * HALF) = w; }
                ss += __shfl_xor(ss, 16); ss += __shfl_xor(ss, 32);
                if (fq == 0) RSS[(size_t)row * 16 + u.pn * 4 + wc] = ss; }
    }
};
struct EpiQ {
    static constexpr bool PERM = true, AFTER_DRAIN = false;
    const float* RSS; bf16_t* Q;
    __device__ __forceinline__ void operator()(const f32x4 (&acc)[2][2][4][2], const Unit& u, int wr, int wc, int fr, int fq) const {
        const int row0 = u.pm * BM + wr * 64 + fr, col0 = u.pn * BM + wc * 32 + 8 * fq;
#pragma unroll
        for (int ai = 0; ai < 2; ++ai)
#pragma unroll
            for (int m = 0; m < 4; ++m) { const int row = row0 + ai * HALF + m * 16;
                const f32x4* rp = (const f32x4*)(RSS + (size_t)row * 16); const f32x4 s0 = rp[0], s1 = rp[1], s2 = rp[2], s3 = rp[3];
                const float ss = ((s0[0] + s0[1]) + (s0[2] + s0[3])) + ((s1[0] + s1[1]) + (s1[2] + s1[3])) + ((s2[0] + s2[1]) + (s2[2] + s2[3])) + ((s3[0] + s3[1]) + (s3[2] + s3[3]));
                const float rstd = 1.0f / sqrtf(ss * (1.0f / DM) + RMS_EPS);
                bf16_t* rowp = Q + (size_t)row * NQ + col0;
#pragma unroll
                for (int bj = 0; bj < 2; ++bj) { const f32x4 v0 = acc[ai][bj][m][0] * rstd, v1 = acc[ai][bj][m][1] * rstd;
                    u32x4 w; w.x = cvt_pk_bf16(v0[0], v0[1]); w.y = cvt_pk_bf16(v0[2], v0[3]); w.z = cvt_pk_bf16(v1[0], v1[1]); w.w = cvt_pk_bf16(v1[2], v1[3]);
                    *(u32x4*)(rowp + bj * HALF) = w; } }
    }
};
}
struct Params {
    const float *x, *norm_mix_g, *w_in, *diff_lambda, *diff_subln_g, *w_out, *norm_ffn_g, *peer_wq, *peer_subkeys, *peer_u, *peer_v, *final_norm_g;
    float* out; unsigned char* ws; int ph_lo, ph_hi;
};
__device__ __forceinline__ void p0_transpose_item(const float* W, int K, int N, bf16* WT, LAS float* scr, int item, int lane, const float* gk = nullptr) {
    const int nblk = N / 32, kb = item / nblk, nb = item % nblk, k0 = 64 * kb, n0 = 32 * nb;
#pragma unroll 8
    for (int i = 0; i < 32; ++i) { const int kk = 2 * i + (lane >> 5); scr[kk * 33 + (lane & 31)] = W[(size_t)(k0 + kk) * N + n0 + (lane & 31)] * (gk ? gk[k0 + kk] : 1.0f); }
    asm volatile("s_waitcnt lgkmcnt(0)" ::: "memory");
    const int c = lane & 7;
#pragma unroll
    for (int j = 0; j < 4; ++j) { const int n = (lane >> 3) + 8 * j; const LAS float* s = scr + (8 * c) * 33 + n;
        u32x4 o; o.x = pk2(s[0 * 33], s[1 * 33]); o.y = pk2(s[2 * 33], s[3 * 33]); o.z = pk2(s[4 * 33], s[5 * 33]); o.w = pk2(s[6 * 33], s[7 * 33]);
        *(u32x4*)(WT + (size_t)(n0 + n) * K + k0 + 8 * c) = o; }
    asm volatile("s_waitcnt lgkmcnt(0)" ::: "memory");
}
__device__ __forceinline__ void p0_convert(const float* src, bf16* dst, size_t n8, int gw, int ngw, int lane) {
    for (size_t g = (size_t)gw * 64 + lane; g < n8; g += (size_t)ngw * 64) {
        const f32x4 a = ((const f32x4*)src)[2 * g], b = ((const f32x4*)src)[2 * g + 1];
        u32x4 o; o.x = pk2(a[0], a[1]); o.y = pk2(a[2], a[3]); o.z = pk2(b[0], b[1]); o.w = pk2(b[2], b[3]);
        ((u32x4*)dst)[g] = o; }
}
__device__ __forceinline__ void p0_fp4_rows(const float* src, unsigned char* dst, unsigned short* sc16, int gw, int ngw, int lane) {
    float cal; { float four = 4.f; asm volatile("" : "+v"(four)); const unsigned enc = __builtin_amdgcn_cvt_scalef32_pk_fp4_f32(0u, four, four, 1.0f, 0); const f32x2 dec = __builtin_amdgcn_cvt_scalef32_pk_f32_fp4(enc, 1.0f, 0); cal = 4.f / dec.x; }
    for (int row0 = gw; row0 < NEXP; row0 += 2 * ngw) {
        f32x4 v[2][4]; float m[2];
#pragma unroll
        for (int q = 0; q < 2; ++q) { const f32x4* sp = (const f32x4*)(src + (size_t)(row0 + q * ngw) * DM + 16 * lane);
#pragma unroll
            for (int j = 0; j < 4; ++j) v[q][j] = sp[j]; }
#pragma unroll
        for (int q = 0; q < 2; ++q) { float mm = 0.f;
#pragma unroll
            for (int j = 0; j < 4; ++j) mm = fmaxf(mm, fmaxf(fmaxf(fabsf(v[q][j][0]), fabsf(v[q][j][1])), fmaxf(fabsf(v[q][j][2]), fabsf(v[q][j][3]))));
#pragma unroll
            for (int o = 1; o < 64; o <<= 1) mm = fmaxf(mm, __shfl_xor(mm, o));
            m[q] = mm; }
#pragma unroll
        for (int q = 0; q < 2; ++q) { const int row = row0 + q * ngw;
            const unsigned ib = (__float_as_uint(m[q] > 0.f ? m[q] * (1.0f / 6.f) : 1.f) + 0xffffu) & 0xffff0000u;
            const float sc = 1.0f / __uint_as_float(ib);
            u32x2 o;
#pragma unroll
            for (int j = 0; j < 2; ++j) { unsigned pk = 0u;
                pk = __builtin_amdgcn_cvt_scalef32_pk_fp4_f32(pk, v[q][2 * j][0] * sc, v[q][2 * j][1] * sc, 1.0f, 0); pk = __builtin_amdgcn_cvt_scalef32_pk_fp4_f32(pk, v[q][2 * j][2] * sc, v[q][2 * j][3] * sc, 1.0f, 1);
                pk = __builtin_amdgcn_cvt_scalef32_pk_fp4_f32(pk, v[q][2 * j + 1][0] * sc, v[q][2 * j + 1][1] * sc, 1.0f, 2); pk = __builtin_amdgcn_cvt_scalef32_pk_fp4_f32(pk, v[q][2 * j + 1][2] * sc, v[q][2 * j + 1][3] * sc, 1.0f, 3);
                o[j] = pk; }
            *(u32x2*)(dst + (size_t)row * (DM / 2) + 8 * lane) = o;
            if (lane == 0) sc16[2 * row] = (unsigned short)(__float_as_uint(__uint_as_float(ib) * cal) >> 16); }
    }
}
__device__ __forceinline__ void p0_norm_row(const float* xrow, const float* g, bf16* orow, int lane) {
    const f32x4* xr = (const f32x4*)xrow + lane; const f32x4* gr = (const f32x4*)g + lane;
    f32x4 v[4]; float s = 0.f;
#pragma unroll
    for (int j = 0; j < 4; ++j) { v[j] = xr[64 * j]; s += (v[j][0] * v[j][0] + v[j][1] * v[j][1]) + (v[j][2] * v[j][2] + v[j][3] * v[j][3]); }
    const float rstd = 1.0f / sqrtf(wave_sum(s) * (1.f / DM) + RMS_EPS);
    u32x2* o8 = (u32x2*)orow + lane;
#pragma unroll
    for (int j = 0; j < 4; ++j) { const f32x4 gg = gr[64 * j]; u32x2 o; o.x = pk2(v[j][0] * rstd * gg[0], v[j][1] * rstd * gg[1]); o.y = pk2(v[j][2] * rstd * gg[2], v[j][3] * rstd * gg[3]); o8[64 * j] = o; }
}
__device__ __forceinline__ void p0_norm_row2(const float* xrow0, const float* xrow1, const float* g, bf16* orow0, bf16* orow1, int lane) {
    const f32x4* x0 = (const f32x4*)xrow0 + lane; const f32x4* x1 = (const f32x4*)xrow1 + lane; const f32x4* gr = (const f32x4*)g + lane;
    f32x4 a[4], b[4]; float sa = 0.f, sb = 0.f;
#pragma unroll
    for (int j = 0; j < 4; ++j) { a[j] = x0[64 * j]; b[j] = x1[64 * j]; }
#pragma unroll
    for (int j = 0; j < 4; ++j) { sa += (a[j][0] * a[j][0] + a[j][1] * a[j][1]) + (a[j][2] * a[j][2] + a[j][3] * a[j][3]); sb += (b[j][0] * b[j][0] + b[j][1] * b[j][1]) + (b[j][2] * b[j][2] + b[j][3] * b[j][3]); }
    const float ra = 1.0f / sqrtf(wave_sum(sa) * (1.f / DM) + RMS_EPS), rb = 1.0f / sqrtf(wave_sum(sb) * (1.f / DM) + RMS_EPS);
    u32x2* oa = (u32x2*)orow0 + lane; u32x2* ob = (u32x2*)orow1 + lane;
#pragma unroll
    for (int j = 0; j < 4; ++j) { const f32x4 gg = gr[64 * j];
        u32x2 o; o.x = pk2(a[j][0] * ra * gg[0], a[j][1] * ra * gg[1]); o.y = pk2(a[j][2] * ra * gg[2], a[j][3] * ra * gg[3]); oa[64 * j] = o;
        u32x2 q; q.x = pk2(b[j][0] * rb * gg[0], b[j][1] * rb * gg[1]); q.y = pk2(b[j][2] * rb * gg[2], b[j][3] * rb * gg[3]); ob[64 * j] = q; }
}
__device__ __forceinline__ void p0_i8_rows(const float* src, const float* gain, unsigned char* dst, unsigned short* sc16, int gw, int ngw, int lane) {
    f32x4 gq[4];
#pragma unroll
    for (int j = 0; j < 4; ++j) gq[j] = *(const f32x4*)(gain + 16 * lane + 4 * j);
    for (int row0 = gw; row0 < NEXP; row0 += 2 * ngw) {
        f32x4 v[2][4]; float m[2];
#pragma unroll
        for (int q = 0; q < 2; ++q) { const f32x4* sp = (const f32x4*)(src + (size_t)(row0 + q * ngw) * DM + 16 * lane);
#pragma unroll
            for (int j = 0; j < 4; ++j) v[q][j] = sp[j] * gq[j]; }
#pragma unroll
        for (int q = 0; q < 2; ++q) { float mm = 0.f;
#pragma unroll
            for (int j = 0; j < 4; ++j) mm = fmaxf(mm, fmaxf(fmaxf(fabsf(v[q][j][0]), fabsf(v[q][j][1])), fmaxf(fabsf(v[q][j][2]), fabsf(v[q][j][3]))));
#pragma unroll
            for (int o = 1; o < 64; o <<= 1) mm = fmaxf(mm, __shfl_xor(mm, o));
            m[q] = mm; }
#pragma unroll
        for (int q = 0; q < 2; ++q) { const int row = row0 + q * ngw;
            const unsigned ib = (__float_as_uint(m[q] > 0.f ? m[q] * (1.0f / 127.f) : 1.f) + 0xffffu) & 0xffff0000u;
            const float sc = 1.0f / __uint_as_float(ib);
            u32x4 o;
#pragma unroll
            for (int j = 0; j < 4; ++j) { const int b0 = (int)rintf(v[q][j][0] * sc), b1 = (int)rintf(v[q][j][1] * sc), b2 = (int)rintf(v[q][j][2] * sc), b3 = (int)rintf(v[q][j][3] * sc);
                o[j] = ((unsigned)b0 & 255u) | (((unsigned)b1 & 255u) << 8) | (((unsigned)b2 & 255u) << 16) | (((unsigned)b3 & 255u) << 24); }
            *(u32x4*)(dst + (size_t)row * DM + 16 * lane) = o;
            if (lane == 0) sc16[2 * row + 1] = (unsigned short)(ib >> 16); }
    }
}
__device__ __forceinline__ void p0_prologue(const Params& P, LAS unsigned char* lds, int wave, int lane) {
    LAS float* scr = (LAS float*)(lds + wave * 16384);
    const int gw = blockIdx.x * 8 + wave, ngw = gridDim.x * 8;
    constexpr int I_IN = (DM / 64) * (NIN / 32), I_OUT = (DM / 64) * (DM / 32), I_WQ = (DM / 64) * (NQ / 32), NIT = I_IN + I_OUT + I_WQ;
    bf16* WinT = (bf16*)(P.ws + WS_WIN); bf16* WoutT = (bf16*)(P.ws + WS_WOUT); bf16* WqT = (bf16*)(P.ws + WS_WQ);
    for (int it = gw; it < NIT; it += ngw) {
        int r = it;
        if (r < I_IN) { p0_transpose_item(P.w_in, DM, NIN, WinT, scr, r, lane); continue; } r -= I_IN;
        if (r < I_OUT) { p0_transpose_item(P.w_out, DM, DM, WoutT, scr, r, lane); continue; } r -= I_OUT;
        p0_transpose_item(P.peer_wq, DM, NQ, WqT, scr, r, lane, P.norm_ffn_g);
    }
    p0_convert(P.peer_subkeys, (bf16*)(P.ws + WS_SK), (size_t)16 * 128 * 128 / 8, gw, ngw, lane);
    p0_i8_rows(P.peer_u, P.norm_ffn_g, P.ws + WS_U, (unsigned short*)(P.ws + WS_SC), gw, ngw, lane);
    p0_fp4_rows(P.peer_v, P.ws + WS_V, (unsigned short*)(P.ws + WS_SC), gw, ngw, lane);
    bf16* H = (bf16*)(P.ws + WS_H);
    for (int m = gw; m < MTOK; m += 2 * ngw) p0_norm_row2(P.x + (size_t)m * DM, P.x + (size_t)(m + ngw) * DM, P.norm_mix_g, H + (size_t)m * DM, H + (size_t)(m + ngw) * DM, lane);
}
#define MFMA32(a, b, c) __builtin_amdgcn_mfma_f32_32x32x16_bf16((a), (b), (c), 0, 0, 0)
#define MFMA16(a, b, c) __builtin_amdgcn_mfma_f32_16x16x32_bf16((a), (b), (c), 0, 0, 0)
__device__ __forceinline__ float swap_max(float v) { auto rr = __builtin_amdgcn_permlane32_swap(__float_as_uint(v), __float_as_uint(v), false, false); return fmaxf(__uint_as_float(rr[0]), __uint_as_float(rr[1])); }
__device__ __forceinline__ float swap_add(float v) { auto rr = __builtin_amdgcn_permlane32_swap(__float_as_uint(v), __float_as_uint(v), false, false); return __uint_as_float(rr[0]) + __uint_as_float(rr[1]); }
__device__ __forceinline__ bf16x8 pack8(const f32x16& x, int s) {
    u32x4 p; p.x = pk2(x[8 * s], x[8 * s + 1]); p.y = pk2(x[8 * s + 2], x[8 * s + 3]); p.z = pk2(x[8 * s + 4], x[8 * s + 5]); p.w = pk2(x[8 * s + 6], x[8 * s + 7]);
    return __builtin_bit_cast(bf16x8, p);
}
constexpr float ATT_THR = 8.0f;
constexpr float ATT_NEG = -1.0e30f;

constexpr int PR = 272, PT = 320;
constexpr int AT_Q = 0, AT_KV = 256 * PR, AT_KVSZ = 64 * PR + 64 * PT;
static_assert(AT_KV + 2 * AT_KVSZ <= LDS_MAIN, "attention LDS");
__device__ __forceinline__ void attn_unit(const bf16* PROJ, bf16* Y, const float* subln_g, float lam, int b, int h, int qb, LAS unsigned char* lds) {
    int tid = threadIdx.x; asm volatile("" : "+v"(tid));
    const int lane = tid & 63, r32 = lane & 31, hi = lane >> 5;
    const int w = __builtin_amdgcn_readfirstlane(tid >> 6);
    const size_t rowbase = (size_t)b * SEQ;
    const float slope2 = exp2f(-2.f * (float)(h + 1)) * LOG2E;
    const int srow = tid >> 4, sch = tid & 15;
    const char* gbase = (const char*)(PROJ + rowbase * NIN + h * 128);
    const unsigned soff = (unsigned)(srow * NIN + sch * 8) * 2u;
    {   const char* qb_ = gbase + ((size_t)qb * 256 * NIN + C_DQ) * 2;
#pragma unroll
        for (int i = 0; i < 8; ++i) { const int row = srow + 32 * i; const u32x4 v = *(const u32x4*)(qb_ + (soff + (unsigned)(32 * i * NIN * 2))); *(LAS u32x4*)(lds + AT_Q + row * PR + sch * 16) = v; } }
    u32x4 sk[2], sv[2];
#define A_LOAD(j) do { const char* kb_ = gbase + ((size_t)(64 * (j)) * NIN + C_DK) * 2; const char* vb_ = gbase + ((size_t)(64 * (j)) * NIN + C_DV) * 2; \
        _Pragma("unroll") for (int i_ = 0; i_ < 2; ++i_) { sk[i_] = *(const u32x4*)(kb_ + (soff + (unsigned)(32 * i_ * NIN * 2))); sv[i_] = *(const u32x4*)(vb_ + (soff + (unsigned)(32 * i_ * NIN * 2))); } } while (0)
#define A_STORE(buf) do { _Pragma("unroll") for (int i_ = 0; i_ < 2; ++i_) { \
        *(LAS u32x4*)(lds + AT_KV + (buf) * AT_KVSZ + (srow + 32 * i_) * PR + sch * 16) = sk[i_]; *(LAS u32x4*)(lds + AT_KV + (buf) * AT_KVSZ + 64 * PR + (srow + 32 * i_) * PT + sch * 16) = sv[i_]; } } while (0)
    const int nt = 4 * qb + 4, jd = 4 * qb + (w >> 1);
    const int qpos = qb * 256 + 32 * w + r32;
    unsigned qbase = AT_Q + (32 * w + r32) * PR + hi * 16, kbase = r32 * PR + hi * 16;
    unsigned vbase = 64 * PR + (4 * hi + ((lane & 15) >> 2)) * PT + ((lane >> 4) & 1) * 32 + (lane & 3) * 8;
    f32x16 O1[4], O2[4];
#pragma unroll
    for (int c = 0; c < 4; ++c)
#pragma unroll
        for (int r = 0; r < 16; ++r) { O1[c][r] = 0.f; O2[c][r] = 0.f; }
    float mref[2] = {0.f, 0.f}, lsum[2] = {0.f, 0.f};
    bool started = false;
    A_LOAD(nt - 1); A_STORE(0); if (nt > 1) A_LOAD(nt - 2);
    __syncthreads();
    for (int it = 0; it < nt; ++it) {
        const int j = nt - 1 - it, cur = it & 1;
        asm volatile("" : "+v"(qbase), "+v"(kbase), "+v"(vbase));
        if (it + 1 < nt) A_STORE(cur ^ 1);
        if (it + 2 < nt) A_LOAD(j - 2);
        if (j <= jd) {
            const unsigned kvo = AT_KV + cur * AT_KVSZ;
            for (int kb = 1; kb >= 0; --kb) {
                const bool diag = (j == jd);
                if (diag && kb > (w & 1)) continue;
                const bool domask = diag && kb == (w & 1);
                bf16x8 Pb[2][2];
#pragma unroll
                for (int p = 0; p < 2; ++p) {
                    f32x16 S;
                    const float tb = slope2 * (float)(64 * j + 32 * kb - qpos + 4 * hi) - mref[p];
#pragma unroll
                    for (int r = 0; r < 16; ++r) S[r] = tb + slope2 * (float)((r & 3) + 8 * (r >> 2));
#pragma unroll
                    for (int ks = 0; ks < 4; ++ks) {
                        const bf16x8 qf = *(const LAS bf16x8*)(lds + qbase + (8 * p + 2 * ks) * 16);
                        const bf16x8 kf = *(const LAS bf16x8*)(lds + (kbase + kvo + kb * (32 * PR)) + (8 * p + 2 * ks) * 16);
                        S = MFMA32(kf, qf, S);
                    }
                    if (domask) {
#pragma unroll
                        for (int r = 0; r < 16; ++r) { const int kv = (r & 3) + 8 * (r >> 2) + 4 * hi; if (kv > r32) S[r] = ATT_NEG; } }
                    float rm = fmaxf(S[0], S[1]);
#pragma unroll
                    for (int r = 2; r < 16; ++r) rm = fmaxf(rm, S[r]);
                    rm = swap_max(rm);
                    if (!started) {
                        mref[p] = rm;
#pragma unroll
                        for (int r = 0; r < 16; ++r) S[r] -= rm;
                    } else if (__any(rm > ATT_THR)) {
                        const float dl = fmaxf(rm, 0.f); mref[p] += dl;
#pragma unroll
                        for (int r = 0; r < 16; ++r) S[r] -= dl;
                        const float f = exp2f(-dl); lsum[p] *= f;
                        if (p == 0) {
#pragma unroll
                            for (int c = 0; c < 4; ++c) O1[c] = O1[c] * f;
                        } else {
#pragma unroll
                            for (int c = 0; c < 4; ++c) O2[c] = O2[c] * f;
                        }
                    }
                    float ls = 0.f;
#pragma unroll
                    for (int r = 0; r < 16; ++r) { S[r] = __builtin_amdgcn_exp2f(S[r]); ls += S[r]; }
                    lsum[p] += ls;
                    Pb[p][0] = pack8(S, 0); Pb[p][1] = pack8(S, 1);
                }
                started = true;
#pragma unroll
                for (int c = 0; c < 4; ++c)
#pragma unroll
                    for (int ss = 0; ss < 2; ++ss) {
                        const LAS char* vp = (const LAS char*)lds + (vbase + kvo + kb * (32 * PT));
                        const bf16x8 vf = cat8(lds_tr(vp + ((16 * ss) * PT + c * 64)), lds_tr(vp + ((16 * ss + 8) * PT + c * 64)));
                        O1[c] = MFMA32(vf, Pb[0][ss], O1[c]); O2[c] = MFMA32(vf, Pb[1][ss], O2[c]);
                    }
            }
        }
        __syncthreads();
    }
#undef A_LOAD
#undef A_STORE
    const float inv1 = 1.0f / swap_add(lsum[0]), inv2 = lam / swap_add(lsum[1]);
    float ss = 0.f;
#pragma unroll
    for (int c = 0; c < 4; ++c)
#pragma unroll
        for (int r = 0; r < 16; ++r) { const float o = O1[c][r] * inv1 - O2[c][r] * inv2; O1[c][r] = o; ss += o * o; }
    ss = swap_add(ss);
    const float rstd = (1.0f / sqrtf(ss * (1.0f / 128.f) + RMS_EPS)) * 0.8f;
    bf16* yrow = Y + (rowbase + qpos) * DM + 512 + h * 128;
#pragma unroll
    for (int c = 0; c < 4; ++c)
#pragma unroll
        for (int g4 = 0; g4 < 4; ++g4) { const int dv0 = 32 * c + 8 * g4 + 4 * hi; const f32x4 gg = *(const f32x4*)(subln_g + dv0);
            u32x2 o; o.x = pk2(O1[c][4 * g4] * rstd * gg[0], O1[c][4 * g4 + 1] * rstd * gg[1]); o.y = pk2(O1[c][4 * g4 + 2] * rstd * gg[2], O1[c][4 * g4 + 3] * rstd * gg[3]);
            *(u32x2*)(yrow + dv0) = o; }
}

constexpr int RT_P = 0, RT_K = 128 * PR, RT_V = 2 * 128 * PR, RT_ST = 2 * 128 * PR + 128 * PT;
static_assert(RT_ST + 128 * PR <= LDS_MAIN, "retention LDS");
__device__ __forceinline__ u32x4 scale8(u32x4 v, float f) { u32x4 o; o.x = pk2(bf_lo(v.x) * f, bf_hi(v.x) * f); o.y = pk2(bf_lo(v.y) * f, bf_hi(v.y) * f); o.z = pk2(bf_lo(v.z) * f, bf_hi(v.z) * f); o.w = pk2(bf_lo(v.w) * f, bf_hi(v.w) * f); return o; }
__device__ __forceinline__ void ret_unit(const bf16* PROJ, bf16* Y, int b, int h, LAS unsigned char* lds) {
    int tid = threadIdx.x; asm volatile("" : "+v"(tid));
    const int lane = tid & 63, l15 = lane & 15, g = lane >> 4;
    const int w = __builtin_amdgcn_readfirstlane(tid >> 6);
    const size_t rowbase = (size_t)b * SEQ;
    const float gam = 1.0f - exp2f(-5.f - (float)h), lg = log2f(gam), cdec = exp2f(128.f * lg), g127 = exp2f(127.f * lg);
    const int srow = tid >> 4, sch = tid & 15;
    const char* gbase = (const char*)(PROJ + rowbase * NIN + h * 128);
    const unsigned soff = (unsigned)(srow * NIN + sch * 8) * 2u;
    const unsigned qoff = (unsigned)((16 * w + l15) * NIN + C_RQ + 8 * g) * 2u;
    const unsigned toff = (unsigned)((16 * w + l15) * NIN + C_RG + 4 * g) * 2u;
    const float qscale = exp2f(lg * (float)(16 * w + l15));
    u32x4 sk[4], sv[4];
#define R_LOAD(n) do { const char* kb_ = gbase + ((size_t)(128 * (n)) * NIN + C_RK) * 2; const char* vb_ = gbase + ((size_t)(128 * (n)) * NIN + C_RV) * 2; \
        _Pragma("unroll") for (int i_ = 0; i_ < 4; ++i_) { sk[i_] = *(const u32x4*)(kb_ + (soff + (unsigned)(32 * i_ * NIN * 2))); sv[i_] = *(const u32x4*)(vb_ + (soff + (unsigned)(32 * i_ * NIN * 2))); } } while (0)
#define R_STORE() do { _Pragma("unroll") for (int i_ = 0; i_ < 4; ++i_) { const int row_ = srow + 32 * i_; \
        *(LAS u32x4*)(lds + RT_K + row_ * PR + sch * 16) = scale8(sk[i_], exp2f(-lg * (float)row_)); *(LAS u32x4*)(lds + RT_V + row_ * PT + sch * 16) = sv[i_]; } } while (0)
#define Q_LOAD(n) do { const char* qb_ = gbase + (size_t)(128 * (n)) * NIN * 2; _Pragma("unroll") for (int s_ = 0; s_ < 4; ++s_) qraw[s_] = *(const u32x4*)(qb_ + (qoff + 64u * s_)); } while (0)
    f32x4 Sacc[8];
#pragma unroll
    for (int c = 0; c < 8; ++c) Sacc[c] = (f32x4){0.f, 0.f, 0.f, 0.f};
    for (int i = tid; i < 128 * PR / 16; i += 512) *(LAS u32x4*)(lds + RT_ST + i * 16) = (u32x4){0u, 0u, 0u, 0u};
    u32x4 qraw[4];
    R_LOAD(0); Q_LOAD(0); R_STORE();
    __syncthreads();
    const int tq = (lane & 15) >> 2, tp = lane & 3;
    unsigned b_k = RT_K + l15 * PR + g * 16;
    unsigned b_p = RT_P + (16 * w + l15) * PR + g * 16;
    unsigned b_pw = RT_P + (16 * w + l15) * PR + g * 8;
    unsigned b_kt = RT_K + (8 * g + tq) * PR + tp * 8 + w * 32;
    unsigned b_vt = RT_V + (8 * g + tq) * PT + tp * 8;
    unsigned b_st = RT_ST + l15 * PR + g * 16;
    unsigned b_sw = RT_ST + l15 * PR + (16 * w + 4 * g) * 2;
    for (int n = 0; n < SEQ / 128; ++n) {
        asm volatile("" : "+v"(b_k), "+v"(b_p), "+v"(b_pw), "+v"(b_kt), "+v"(b_vt), "+v"(b_st), "+v"(b_sw));
        bf16x8 Qf[4], Pf[4], KTf[4];
#pragma unroll
        for (int s = 0; s < 4; ++s) Qf[s] = __builtin_bit_cast(bf16x8, scale8(qraw[s], qscale));
#pragma unroll
        for (int jb = 0; jb < 8; ++jb) {
            f32x4 a = (f32x4){0.f, 0.f, 0.f, 0.f};
#pragma unroll
            for (int s = 0; s < 4; ++s) { const bf16x8 kf = *(const LAS bf16x8*)(lds + (b_k + jb * (16 * PR) + s * 64)); a = MFMA16(kf, Qf[s], a); }
            const int ii = 16 * w + l15, jj = 16 * jb + 4 * g;
            u32x2 pw; pw.x = pk2(jj <= ii ? a[0] : 0.f, jj + 1 <= ii ? a[1] : 0.f); pw.y = pk2(jj + 2 <= ii ? a[2] : 0.f, jj + 3 <= ii ? a[3] : 0.f);
            *(LAS u32x2*)(lds + (b_pw + jb * 32)) = pw;
        }
#pragma unroll
        for (int s = 0; s < 4; ++s) { Pf[s] = *(const LAS bf16x8*)(lds + (b_p + s * 64));
            KTf[s] = cat8(lds_tr((const LAS char*)lds + (b_kt + (32 * s) * PR)), lds_tr((const LAS char*)lds + (b_kt + (32 * s + 4) * PR))); }
        f32x4 OT[8];
#pragma unroll
        for (int c = 0; c < 8; ++c) {
            f32x4 o = (f32x4){0.f, 0.f, 0.f, 0.f}, t4 = (f32x4){0.f, 0.f, 0.f, 0.f};
#pragma unroll
            for (int s = 0; s < 4; ++s) {
                const bf16x8 vf = cat8(lds_tr((const LAS char*)lds + (b_vt + (32 * s) * PT + c * 32)), lds_tr((const LAS char*)lds + (b_vt + (32 * s + 4) * PT + c * 32)));
                const bf16x8 stf = *(const LAS bf16x8*)(lds + (b_st + c * (16 * PR) + s * 64));
                o = MFMA16(stf, Qf[s], o); o = MFMA16(vf, Pf[s], o); t4 = MFMA16(KTf[s], vf, t4);
            }
            OT[c] = o; Sacc[c] = Sacc[c] * cdec + t4 * g127;
            __builtin_amdgcn_sched_barrier(0);
        }
        if (n + 1 < SEQ / 128) { Q_LOAD(n + 1); R_LOAD(n + 1); }
        float ss = 0.f;
#pragma unroll
        for (int c = 0; c < 8; ++c) ss += (OT[c][0] * OT[c][0] + OT[c][1] * OT[c][1]) + (OT[c][2] * OT[c][2] + OT[c][3] * OT[c][3]);
        ss += __shfl_xor(ss, 16); ss += __shfl_xor(ss, 32);
        const float rstd = __builtin_amdgcn_rsqf(ss * (1.0f / 128.f) + RMS_EPS);
        const char* rgb = gbase + (size_t)(128 * n) * NIN * 2;
        char* yb = (char*)(Y + (rowbase + (size_t)n * 128) * DM + h * 128); const unsigned yoff = (unsigned)((16 * w + l15) * DM + 4 * g) * 2u;
#pragma unroll
        for (int c = 0; c < 8; ++c) { const u32x2 rg = *(const u32x2*)(rgb + (toff + 32u * c));
            const float r0 = bf_lo(rg.x), r1 = bf_hi(rg.x), r2 = bf_lo(rg.y), r3 = bf_hi(rg.y);
            const float s0 = r0 * __builtin_amdgcn_rcpf(1.f + __expf(-r0)), s1 = r1 * __builtin_amdgcn_rcpf(1.f + __expf(-r1)), s2 = r2 * __builtin_amdgcn_rcpf(1.f + __expf(-r2)), s3 = r3 * __builtin_amdgcn_rcpf(1.f + __expf(-r3));
            u32x2 o; o.x = pk2(OT[c][0] * rstd * s0, OT[c][1] * rstd * s1); o.y = pk2(OT[c][2] * rstd * s2, OT[c][3] * rstd * s3);
            *(u32x2*)(yb + (yoff + 32u * c)) = o; }
        __syncthreads();
#pragma unroll
        for (int c = 0; c < 8; ++c) { u32x2 o; o.x = pk2(Sacc[c][0] * gam, Sacc[c][1] * gam); o.y = pk2(Sacc[c][2] * gam, Sacc[c][3] * gam);
            *(LAS u32x2*)(lds + (b_sw + c * (16 * PR))) = o; }
        if (n + 1 < SEQ / 128) R_STORE();
        __syncthreads();
    }
#undef R_LOAD
#undef R_STORE
#undef Q_LOAD
}

constexpr int P2_NRET = BATCH * 4, P2_NATT = BATCH * 4 * 8, P2_NITEMS = P2_NRET + P2_NATT;
__device__ __forceinline__ void p2_mixers(const Params& P, LAS unsigned char* lds) {
    const int tid = threadIdx.x;
    unsigned* ctl = (unsigned*)(P.ws + WS_CTL);
    volatile LAS int* lctl = (volatile LAS int*)(lds + LDS_MAIN);
    const bf16* PROJ = (const bf16*)(P.ws + WS_PROJ); bf16* Y = (bf16*)(P.ws + WS_H);
    float d1 = 0.f, d2 = 0.f;
    for (int i = 0; i < 64; ++i) { d1 += P.diff_lambda[i] * P.diff_lambda[64 + i]; d2 += P.diff_lambda[128 + i] * P.diff_lambda[192 + i]; }
    const float lam = expf(d1) - expf(d2) + 0.2f;
    for (;;) {
        if (tid == 0) lctl[0] = (int)atomicAdd(ctl + CW_QUEUE, 1u);
        __syncthreads();
        const int item = __builtin_amdgcn_readfirstlane(lctl[0]);
        __syncthreads();
        if (item >= P2_NITEMS) break;
        if (item < P2_NRET) ret_unit(PROJ, Y, item >> 2, item & 3, lds);
        else { const int idx = item - P2_NRET; attn_unit(PROJ, Y, P.diff_subln_g, lam, (idx & 63) >> 2, idx & 3, 7 - (idx >> 6), lds); }
    }
}
#define XB_TMO      128
#define XB_XCNT(j)  (256  + 64 * (j))
#define XB_XSUB(j)  (1280 + 64 * (j))
#define XB_XGEN(j)  (2304 + 64 * (j))
#define XB_TOP      3328
#define XB_TOPGEN   3392
#define XCD_BAR_WORDS 3456
#define XB_SPIN_CAP (1u << 18)

__device__ __forceinline__ unsigned xb_ld(unsigned* p)              { return __hip_atomic_load(p, __ATOMIC_RELAXED, __HIP_MEMORY_SCOPE_AGENT); }
__device__ __forceinline__ unsigned xb_add(unsigned* p, unsigned v) { return __hip_atomic_fetch_add(p, v, __ATOMIC_RELAXED, __HIP_MEMORY_SCOPE_AGENT); }
__device__ __forceinline__ unsigned xb_xcc_id() { return (unsigned)__builtin_amdgcn_s_getreg((3 << 11) | 20) & 0xFu; }
#define XB_SPIN(cond, bar) do { unsigned _sp = 0; while (cond) { __builtin_amdgcn_s_sleep(1); \
    if ((++_sp & 255u) == 0u) { if (xb_ld(&(bar)[XB_TMO])) break; if (_sp > XB_SPIN_CAP) { atomicAdd(&(bar)[XB_TMO], 1u); break; } } } } while (0)

struct XcdBarrier {
    unsigned* bar; unsigned x;
    volatile LAS unsigned* st;
};

__device__ __forceinline__ XcdBarrier xcd_barrier_post(unsigned* bar, volatile LAS unsigned* st) {
    XcdBarrier b; b.bar = bar; b.x = xb_xcc_id(); b.st = st;
    if (threadIdx.x == 0) (void)xb_add(&bar[XB_XCNT(b.x)], 1u);
    return b;
}
__device__ __forceinline__ void xcd_barrier_complete(unsigned* bar, unsigned x, unsigned& nloc, unsigned& nx) {
    const unsigned G = gridDim.x * gridDim.y * gridDim.z;
    unsigned sum, cnt, mine, sp = 0u;
    for (;;) {
        sum = 0u; cnt = 0u; mine = 0u;
#pragma unroll
        for (unsigned j = 0; j < 16; ++j) { const unsigned c = xb_ld(&bar[XB_XCNT(j)]); sum += c; cnt += (c > 0u) ? 1u : 0u; mine = (j == x) ? c : mine; }
        if (sum == G) break;
        __builtin_amdgcn_s_sleep(1);
        if ((++sp & 255u) == 0u) { if (xb_ld(&bar[XB_TMO])) break; if (sp > XB_SPIN_CAP) { atomicAdd(&bar[XB_TMO], 1u); break; } }
    }
    nloc = mine > 0u ? mine : 1u; nx = cnt > 0u ? cnt : 1u;
}

__device__ __forceinline__ void xcd_barrier(const XcdBarrier& b) {
    asm volatile("s_waitcnt vmcnt(0)" ::: "memory");
    __syncthreads();
    if (threadIdx.x == 0) {
        unsigned* bar = b.bar;
        __builtin_amdgcn_s_waitcnt(0);
        unsigned nloc = b.st[0], nx = b.st[1];
        if (nloc == 0u) { xcd_barrier_complete(bar, b.x, nloc, nx); b.st[0] = nloc; b.st[1] = nx; }
        const unsigned old = xb_add(&bar[XB_XSUB(b.x)], 1u);
        const unsigned gen = old / nloc;
        if (old + 1u == (gen + 1u) * nloc) {
            __builtin_amdgcn_fence(__ATOMIC_RELEASE, "agent");
            asm volatile("s_waitcnt vmcnt(0)" ::: "memory");
            const unsigned og = xb_add(&bar[XB_TOP], 1u);
            const unsigned tg = og / nx;
            if (og + 1u == (tg + 1u) * nx) xb_add(&bar[XB_TOPGEN], 1u);
            else XB_SPIN(xb_ld(&bar[XB_TOPGEN]) == tg, bar);
            __builtin_amdgcn_fence(__ATOMIC_ACQUIRE, "agent");
            xb_add(&bar[XB_XGEN(b.x)], 1u);
            asm volatile("s_waitcnt vmcnt(0)" ::: "memory");
        } else {
            XB_SPIN(xb_ld(&bar[XB_XGEN(b.x)]) == gen, bar);
            __builtin_amdgcn_fence(__ATOMIC_ACQUIRE, "agent");
            asm volatile("s_waitcnt vmcnt(0)" ::: "memory");
        }
    }
    __syncthreads();
}
__device__ __forceinline__ int ord_key(float s) { const int b = __float_as_int(s); return b ^ ((b >> 31) & 0x7fffffff); }
__device__ __forceinline__ float ord_val(int k) { return __int_as_float(k ^ ((k >> 31) & 0x7fffffff)); }
__device__ __forceinline__ int med3i(int a, int b, int c) { int r; asm("v_med3_i32 %0, %1, %2, %3" : "=v"(r) : "v"(a), "v"(b), "v"(c)); return r; }
__device__ __forceinline__ int imax(int a, int b) { return a > b ? a : b; }
__device__ __forceinline__ int imin(int a, int b) { return a < b ? a : b; }
#define INS16(L, x) do { const int x_ = (x); _Pragma("unroll") for (int i_ = 15; i_ >= 1; --i_) L[i_] = med3i(L[i_ - 1], L[i_], x_); L[0] = imax(L[0], x_); } while (0)
__device__ __forceinline__ void merge_halves16(int (&L)[16]) {
    int c[16];
#pragma unroll
    for (int i = 0; i < 8; ++i) {
        auto r0 = __builtin_amdgcn_permlane32_swap((unsigned)L[i], (unsigned)L[15 - i], false, false);
        auto r1 = __builtin_amdgcn_permlane32_swap((unsigned)L[15 - i], (unsigned)L[i], false, false);
        const bool hi = (threadIdx.x & 32) != 0;
        const int pa_i = hi ? (int)r1[0] : (int)r0[1], pa_15i = hi ? (int)r0[0] : (int)r1[1];
        c[i] = imax(L[i], pa_15i); c[15 - i] = imax(L[15 - i], pa_i);
    }
#define BSTAGE(d) _Pragma("unroll") for (int i = 0; i < 16; ++i) if ((i & (d)) == 0) { const int a = c[i], b = c[i + (d)]; c[i] = imax(a, b); c[i + (d)] = imin(a, b); }
    BSTAGE(8) BSTAGE(4) BSTAGE(2) BSTAGE(1)
#undef BSTAGE
#pragma unroll
    for (int i = 0; i < 16; ++i) L[i] = c[i];
}
__device__ __forceinline__ float dpp_add(float v, const int ctrl_sel) {
    int m;
    if (ctrl_sel == 0) m = __builtin_amdgcn_update_dpp(0, __float_as_int(v), 0xB1, 0xf, 0xf, false);
    else if (ctrl_sel == 1) m = __builtin_amdgcn_update_dpp(0, __float_as_int(v), 0x4E, 0xf, 0xf, false);
    else if (ctrl_sel == 2) m = __builtin_amdgcn_update_dpp(0, __float_as_int(v), 0x141, 0xf, 0xf, false);
    else m = __builtin_amdgcn_update_dpp(0, __float_as_int(v), 0x128, 0xf, 0xf, false);
    return v + __int_as_float(m);
}
__device__ __forceinline__ float dot2bf(unsigned a, unsigned b, float acc) {
    typedef __bf16 bf2 __attribute__((ext_vector_type(2)));
    return __builtin_amdgcn_fdot2_f32_bf16(__builtin_bit_cast(bf2, a), __builtin_bit_cast(bf2, b), acc, false);
}
__device__ __forceinline__ float dot8(u32x4 a, u32x4 b, float acc) {
    const unsigned a0 = a.x, a1 = a.y, a2 = a.z, a3 = a.w, b0 = b.x, b1 = b.y, b2 = b.z, b3 = b.w;
    acc = dot2bf(a0, b0, acc); acc = dot2bf(a1, b1, acc); acc = dot2bf(a2, b2, acc); acc = dot2bf(a3, b3, acc);
    return acc;
}
#define AXPY8(accp, wk, v) do { (accp)[0] += (wk) * bf_lo((v).x); (accp)[1] += (wk) * bf_hi((v).x); (accp)[2] += (wk) * bf_lo((v).y); (accp)[3] += (wk) * bf_hi((v).y); \
        (accp)[4] += (wk) * bf_lo((v).z); (accp)[5] += (wk) * bf_hi((v).z); (accp)[6] += (wk) * bf_lo((v).w); (accp)[7] += (wk) * bf_hi((v).w); } while (0)


__device__ __forceinline__ void p5_scores(const Params& P, LAS unsigned char* lds) {
    int tid = threadIdx.x; asm volatile("" : "+v"(tid));
    const int lane = tid & 63, r32 = lane & 31, hi = lane >> 5;
    const int w = __builtin_amdgcn_readfirstlane(tid >> 6), tg = w >> 1, ph = w & 1;
    const int tok0 = blockIdx.x * 128;
    const bf16* SKb = (const bf16*)(P.ws + WS_SK); const bf16* Qb = (const bf16*)(P.ws + WS_Q);
    u32x2* ENT = (u32x2*)(P.ws + WS_H); const unsigned* SC = (const unsigned*)(P.ws + WS_SC);
    LAS int* lists = (LAS int*)(lds + 131072);
    u32x4 st[8];
#define S_LOAD(h) do { _Pragma("unroll") for (int i_ = 0; i_ < 8; ++i_) { const int n_ = tid + 512 * i_; st[i_] = *(const u32x4*)(SKb + ((size_t)(h) * 256 + (n_ >> 4)) * 128 + (n_ & 15) * 8); } } while (0)
#define S_STORE(buf) do { _Pragma("unroll") for (int i_ = 0; i_ < 8; ++i_) { const int n_ = tid + 512 * i_; *(LAS u32x4*)(lds + (buf) * 65536 + (n_ >> 11) * 32768 + off_b((n_ >> 4) & 127, n_ & 15)) = st[i_]; } } while (0)
    S_LOAD(0); S_STORE(0); S_LOAD(1);
    const bf16* qrow0 = Qb + (size_t)(tok0 + 32 * tg + r32) * NQ + ph * 128 + 8 * hi;
    bf16x8 qf[8];
#pragma unroll
    for (int ks = 0; ks < 8; ++ks) qf[ks] = *(const bf16x8*)(qrow0 + 16 * ks);
    __syncthreads();
    for (int h = 0; h < 8; ++h) {
        const int cur = h & 1;
        int L[16];
        {
            f32x16 acc[4];
#pragma unroll
            for (int kb = 0; kb < 4; ++kb)
#pragma unroll
                for (int r = 0; r < 16; ++r) acc[kb][r] = 0.f;
            const LAS unsigned char* SKl = lds + cur * 65536 + ph * 32768;
#pragma unroll
            for (int ks = 0; ks < 8; ++ks)
#pragma unroll
                for (int kb = 0; kb < 4; ++kb) { const bf16x8 a = *(const LAS bf16x8*)(SKl + off_b(32 * kb + r32, 2 * ks + hi)); acc[kb] = MFMA32(a, qf[ks], acc[kb]); }
            asm volatile("" : "+v"(acc[0]), "+v"(acc[1]), "+v"(acc[2]), "+v"(acc[3]));
            {   const bf16* qn = qrow0 + ((h + 1) & 7) * 256;
#pragma unroll
                for (int ks = 0; ks < 8; ++ks) qf[ks] = *(const bf16x8*)(qn + 16 * ks); }
#pragma unroll
            for (int i = 0; i < 16; ++i) L[i] = (int)0x80000000;
#pragma unroll
            for (int kb = 0; kb < 4; ++kb)
#pragma unroll
                for (int r = 0; r < 16; ++r) { const int key = 32 * kb + (r & 3) + 8 * (r >> 2) + 4 * hi; const int x = (ord_key(acc[kb][r]) & ~127) | key; INS16(L, x); }
        }
        merge_halves16(L);
        if (hi == 0) { LAS int* lp = lists + ((tg * 2 + ph) * 32 + r32) * 16;
#pragma unroll
            for (int i = 0; i < 4; ++i) *(LAS u32x4*)(lp + 4 * i) = (u32x4){(unsigned)L[4 * i], (unsigned)L[4 * i + 1], (unsigned)L[4 * i + 2], (unsigned)L[4 * i + 3]}; }
        if (h + 1 < 8) { S_STORE(cur ^ 1); if (h + 2 < 8) S_LOAD(h + 2); }
        __syncthreads();
        if (ph == 0) {
            const LAS int* la = lists + ((tg * 2 + 0) * 32 + r32) * 16; const LAS int* lb = lists + ((tg * 2 + 1) * 32 + r32) * 16;
            float A[16], B[16];
            {   int bl[16];
#pragma unroll
                for (int i = 0; i < 4; ++i) { const u32x4 v = *(const LAS u32x4*)(lb + 4 * i); bl[4 * i] = (int)v.x; bl[4 * i + 1] = (int)v.y; bl[4 * i + 2] = (int)v.z; bl[4 * i + 3] = (int)v.w; }
#pragma unroll
                for (int i = 0; i < 16; ++i) { const float av = ord_val(L[i] & ~127), bv = ord_val(bl[i] & ~127); A[i] = hi ? bv : av; B[i] = hi ? av : bv; } }
            int C[16];
#pragma unroll
            for (int i = 0; i < 16; ++i) C[i] = (int)0x80000000;
#define CAND(i, j) do { const float v_ = A[i] + B[j]; const int code_ = hi ? ((j) * 16 + (i)) : ((i) * 16 + (j)); const int x2_ = (ord_key(v_) & ~255) | code_; INS16(C, x2_); } while (0)
#pragma unroll
            for (int j = 1; j < 16; ++j) CAND(0, j);
#pragma unroll
            for (int j = 2; j < 8; ++j) CAND(1, j);
            CAND(2, 3); CAND(2, 4);
            {
                const float v0 = hi ? (A[2] + B[2]) : (A[0] + B[0]), v1 = hi ? (A[3] + B[3]) : (A[1] + B[1]);
                const int x0 = (ord_key(v0) & ~255) | (hi ? 0x22 : 0x00), x1 = (ord_key(v1) & ~255) | (hi ? 0x33 : 0x11);
                INS16(C, x0); INS16(C, x1); }
#undef CAND
            merge_halves16(C);
            float gsum = 0.f, e[16];
            const float vmax = ord_val(C[0] & ~255);
#pragma unroll
            for (int i = 0; i < 16; ++i) { e[i] = __expf(ord_val(C[i] & ~255) - vmax); gsum += e[i]; }
            const float ginv = 1.0f / gsum;
            u32x2* ep = ENT + (size_t)(tok0 + 32 * tg + r32) * 128 + h * 16 + hi * 8;
            int Cs[8]; float Gs[8];
#pragma unroll
            for (int i = 0; i < 8; ++i) { int c0 = C[i], c1 = C[i + 8]; float e0 = e[i], e1 = e[i + 8]; asm volatile("" : "+v"(c0), "+v"(c1), "+v"(e0), "+v"(e1)); Cs[i] = hi ? c1 : c0; Gs[i] = (hi ? e1 : e0) * ginv; }
#pragma unroll
            for (int i = 0; i < 8; i += 2) {
                u32x4 o;
                { const int code = Cs[i] & 255; const int i1 = la[code >> 4] & 127, i2 = lb[code & 15] & 127; const unsigned e_ = (unsigned)(i1 * 128 + i2); const unsigned sc_ = SC[e_]; o.x = e_ | ((sc_ >> 16) << 17); o.y = __float_as_uint(Gs[i] * __uint_as_float(sc_ << 16)); }
                { const int code = Cs[i + 1] & 255; const int i1 = la[code >> 4] & 127, i2 = lb[code & 15] & 127; const unsigned e_ = (unsigned)(i1 * 128 + i2); const unsigned sc_ = SC[e_]; o.z = e_ | ((sc_ >> 16) << 17); o.w = __float_as_uint(Gs[i + 1] * __uint_as_float(sc_ << 16)); }
                *(u32x4*)(ep + i) = o;
            }
        }
        __syncthreads();
    }
#undef S_LOAD
#undef S_STORE
}
__device__ __forceinline__ void fp8x16_to_f32(u32x4 v, float (&f)[16]) {
#pragma unroll
    for (int j = 0; j < 4; ++j) { const int wv_ = (int)v[j]; const f32x2 lo = __builtin_amdgcn_cvt_pk_f32_fp8(wv_, false), hi = __builtin_amdgcn_cvt_pk_f32_fp8(wv_, true);
        f[4 * j] = lo.x; f[4 * j + 1] = lo.y; f[4 * j + 2] = hi.x; f[4 * j + 3] = hi.y; }
}
constexpr int CW_PACE = 65536;
__device__ __forceinline__ void xcc_pace(unsigned* ctl, const XcdBarrier& b, unsigned step) {
    __syncthreads();
    if (threadIdx.x == 0) {
        unsigned* c = ctl + CW_PACE + 64 * b.x; const unsigned nloc = b.st[0];
        if (nloc != 0u) { xb_add(c, 1u); const unsigned want = (step + 1u) * nloc; unsigned sp = 0;
            while (xb_ld(c) < want) { __builtin_amdgcn_s_sleep(1); if (++sp > (1u << 16)) break; } }
    }
    __syncthreads();
}
#define P6_REP(k) (32 * ((k) >> 2) + 16 * (((k) >> 1) & 1) + 8 * ((k) & 1))
template <int MODE = 0>
__device__ __forceinline__ void p6_gather(const Params& P, LAS unsigned char* lds, const XcdBarrier& xbar, unsigned pace0 = 0) {
    int tid = threadIdx.x; asm volatile("" : "+v"(tid));
    const int lane = tid & 63, l7 = lane & 7;
    const int w = __builtin_amdgcn_readfirstlane(tid >> 6);
    const int tok0 = blockIdx.x * 128;
    const u32x2* ENT = (const u32x2*)(P.ws + WS_H);
    const bf16* XG = (const bf16*)(P.ws + WS_XG); const unsigned char* U8 = P.ws + WS_U; const unsigned char* V8 = P.ws + WS_V;
    const float* RSS = (const float*)(P.ws + WS_RSS);
    const int kk = 4 * (lane >> 5) + 2 * ((lane >> 4) & 1) + ((lane >> 3) & 1);
    const unsigned xsb = (unsigned)w * 8192u + (unsigned)lane * 16u;
    const unsigned ssb = 65536u + (unsigned)w * 8192u;
    const unsigned ska = ssb + (unsigned)kk * 8u;
    const unsigned skv = ssb + (unsigned)l7 * 8u;
    const unsigned rowoff = 16u * (unsigned)lane, rowoff4 = 8u * (unsigned)lane;
    xcd_barrier(xbar);
    unsigned pace_step = pace0;
    for (int r = 0; r < 2; ++r) {
        if (r > 0) xcc_pace((unsigned*)(P.ws + WS_CTL), xbar, pace_step++);
        float rstd[8];
#pragma unroll
        for (int t = 0; t < 8; ++t) {
            const size_t tok = (size_t)tok0 + 64 * r + 8 * w + t;
            const u32x4 e4 = ((const u32x4*)ENT)[tok * 64 + lane];
            float xscale;
            {
                const u32x4 xa = *(const u32x4*)(XG + tok * DM + 16 * lane), xb = *(const u32x4*)(XG + tok * DM + 16 * lane + 8); float xf[16];
#pragma unroll
                for (int j = 0; j < 4; ++j) { xf[2 * j] = bf_lo(xa[j]); xf[2 * j + 1] = bf_hi(xa[j]); xf[8 + 2 * j] = bf_lo(xb[j]); xf[8 + 2 * j + 1] = bf_hi(xb[j]); }
                float mx = 0.f;
#pragma unroll
                for (int i = 0; i < 16; ++i) mx = fmaxf(mx, fabsf(xf[i]));
                mx = wave_max_fast(mx);
                const float qs = mx > 0.f ? 127.f / mx : 1.f; u32x4 xq;
#pragma unroll
                for (int j = 0; j < 4; ++j) { const int b0 = (int)rintf(xf[4 * j] * qs), b1 = (int)rintf(xf[4 * j + 1] * qs), b2 = (int)rintf(xf[4 * j + 2] * qs), b3 = (int)rintf(xf[4 * j + 3] * qs);
                    xq[j] = ((unsigned)b0 & 255u) | (((unsigned)b1 & 255u) << 8) | (((unsigned)b2 & 255u) << 16) | (((unsigned)b3 & 255u) << 24); }
                *(LAS u32x4*)(lds + xsb + t * 1024) = xq; xscale = mx > 0.f ? mx * (1.0f / 127.f) : 1.f; }
            const f32x4* rp = (const f32x4*)(RSS + tok * 16); const f32x4 s0 = rp[0], s1 = rp[1], s2 = rp[2], s3 = rp[3];
            const float ssq = ((s0[0] + s0[1]) + (s0[2] + s0[3])) + ((s1[0] + s1[1]) + (s1[2] + s1[3])) + ((s2[0] + s2[1]) + (s2[2] + s2[3])) + ((s3[0] + s3[1]) + (s3[2] + s3[3]));
            rstd[t] = (1.0f / sqrtf(ssq * (1.0f / DM) + RMS_EPS)) * xscale;
            const unsigned bA = (e4.x >> 10) & 15u, bB = (e4.z >> 10) & 15u; int posA = 0, posB = 0, base = 0;
            for (int s = 0; s < 16; ++s) {
                const unsigned long long mA = __ballot(bA == (unsigned)s), mB = __ballot(bB == (unsigned)s);
                const int cA = __popcll(mA), cB = __popcll(mB);
                const int rA = (int)__builtin_amdgcn_mbcnt_hi((unsigned)(mA >> 32), __builtin_amdgcn_mbcnt_lo((unsigned)mA, 0u));
                const int rB = (int)__builtin_amdgcn_mbcnt_hi((unsigned)(mB >> 32), __builtin_amdgcn_mbcnt_lo((unsigned)mB, 0u));
                if (bA == (unsigned)s) posA = base + rA;
                if (bB == (unsigned)s) posB = base + cA + rB;
                base += cA + cB;
            }
            *(LAS u32x2*)(lds + ssb + t * 1024 + posA * 8) = (u32x2){e4.x, e4.y}; *(LAS u32x2*)(lds + ssb + t * 1024 + posB * 8) = (u32x2){e4.z, e4.w};
        }
        if (!(MODE & 1)) {   u32x4 ua[8]; u32x2 entN;
#define PA_PRE(B, T) do { entN = *(const LAS u32x2*)(lds + ska + (T) * 1024 + (B) * 64); \
            _Pragma("unroll") for (int k = 0; k < 8; ++k) { const unsigned ex_ = (unsigned)__builtin_amdgcn_readlane((int)entN.x, P6_REP(k)) & 16383u; ua[k] = *(const u32x4*)(U8 + (ex_ * 1024u + rowoff)); } } while (0)
#define PA_BODY(B, T, NB, NT) do { \
            const u32x2 ent = entN; const float suk = __uint_as_float((ent.x >> 17) << 16);     \
            const u32x4 xq = *(const LAS u32x4*)(lds + xsb + (T) * 1024); \
            int d[8]; \
            _Pragma("unroll") for (int k = 0; k < 8; ++k) d[k] = __builtin_amdgcn_sdot4((int)ua[k].x, (int)xq.x, __builtin_amdgcn_sdot4((int)ua[k].y, (int)xq.y, __builtin_amdgcn_sdot4((int)ua[k].z, (int)xq.z, __builtin_amdgcn_sdot4((int)ua[k].w, (int)xq.w, 0, false), false), false), false); \
            asm volatile("" : "+v"(d[0]), "+v"(d[1]), "+v"(d[2]), "+v"(d[3]), "+v"(d[4]), "+v"(d[5]), "+v"(d[6]), "+v"(d[7])); \
            PA_PRE(NB, NT);     \
            int s4[4], t2[2]; \
            _Pragma("unroll") for (int k = 0; k < 4; ++k) { auto rr = __builtin_amdgcn_permlane32_swap((unsigned)d[k], (unsigned)d[k + 4], false, false); s4[k] = (int)rr[0] + (int)rr[1]; } \
            _Pragma("unroll") for (int k = 0; k < 2; ++k) { auto rr = __builtin_amdgcn_permlane16_swap((unsigned)s4[k], (unsigned)s4[k + 2], false, false); t2[k] = (int)rr[0] + (int)rr[1]; } \
            const bool b3 = (lane & 8) != 0; \
            const int keep = b3 ? t2[1] : t2[0], give = b3 ? t2[0] : t2[1]; \
            int di = keep + __builtin_amdgcn_update_dpp(0, give, 0x128, 0xf, 0xf, false); \
            di += __builtin_amdgcn_update_dpp(0, di, 0xB1, 0xf, 0xf, false); di += __builtin_amdgcn_update_dpp(0, di, 0x4E, 0xf, 0xf, false); di += __builtin_amdgcn_update_dpp(0, di, 0x141, 0xf, 0xf, false); \
            const float a = rstd[T] * suk * (float)di; \
            const float wv = __uint_as_float(ent.y) * (0.5f * a * (1.0f + erff(a * 0.70710678118654752f)));     \
            if ((lane & 7) == 0) *(LAS float*)(lds + ska + (T) * 1024 + (B) * 64 + 4) = wv;     \
            __builtin_amdgcn_sched_barrier(0); \
        } while (0)
            {
            PA_PRE(0, 0);
#pragma unroll 1
            for (int b = 0; b < 16; ++b) {
                PA_BODY(b, 0, b, 1); PA_BODY(b, 1, b, 2); PA_BODY(b, 2, b, 3); PA_BODY(b, 3, b, 4);
                PA_BODY(b, 4, b, 5); PA_BODY(b, 5, b, 6); PA_BODY(b, 6, b, 7);
                PA_BODY(b, 7, (b + 1) & 15, 0);
            }
            }
#undef PA_PRE
#undef PA_BODY
        }
        asm volatile("s_waitcnt vmcnt(0) lgkmcnt(0)" ::: "memory");
        f32x2 acc[8][8];
#pragma unroll
        for (int t = 0; t < 8; ++t)
#pragma unroll
            for (int i = 0; i < 8; ++i) acc[t][i] = (f32x2){0.f, 0.f};
#ifndef PB_D
#define PB_D 4
#endif
        if (!(MODE & 2)) {   u32x2 va[8]; u32x2 evN;
#define PB_ENT(B, T) do { evN = *(const LAS u32x2*)(lds + skv + (T) * 1024 + (B) * 64); } while (0)
#define PB_LDV(k) do { const unsigned ex_ = (unsigned)__builtin_amdgcn_readlane((int)evN.x, (k)) & 16383u; va[k] = *(const u32x2*)(V8 + (ex_ * 512u + rowoff4)); } while (0)
#define PB_BODY(B, T, NB, NT) do { f32x2 (&accT)[8] = acc[T]; \
            const u32x2 evC = evN;     \
            PB_ENT(NB, NT); \
            _Pragma("unroll") for (int k = 0; k < 8; ++k) { \
                const float wk_ = __int_as_float(__builtin_amdgcn_readlane((int)evC.y, k)); const f32x2 wk2_ = {wk_, wk_}; \
                _Pragma("unroll") for (int j = 0; j < 2; ++j) { const unsigned wv_ = va[k][j]; \
                    accT[4 * j] = __builtin_elementwise_fma(__builtin_amdgcn_cvt_scalef32_pk_f32_fp4(wv_, 1.0f, 0), wk2_, accT[4 * j]); accT[4 * j + 1] = __builtin_elementwise_fma(__builtin_amdgcn_cvt_scalef32_pk_f32_fp4(wv_, 1.0f, 1), wk2_, accT[4 * j + 1]); \
                    accT[4 * j + 2] = __builtin_elementwise_fma(__builtin_amdgcn_cvt_scalef32_pk_f32_fp4(wv_, 1.0f, 2), wk2_, accT[4 * j + 2]); accT[4 * j + 3] = __builtin_elementwise_fma(__builtin_amdgcn_cvt_scalef32_pk_f32_fp4(wv_, 1.0f, 3), wk2_, accT[4 * j + 3]); } \
                asm volatile("" : "+v"(accT[0]), "+v"(accT[1]), "+v"(accT[2]), "+v"(accT[3]), "+v"(accT[4]), "+v"(accT[5]), "+v"(accT[6]), "+v"(accT[7])); \
                if (k < PB_D) { const unsigned ex_ = (unsigned)__builtin_amdgcn_readlane((int)evC.x, (k + (8 - PB_D)) & 7) & 16383u; va[(k + (8 - PB_D)) & 7] = *(const u32x2*)(V8 + (ex_ * 512u + rowoff4)); } \
                else { const unsigned ex_ = (unsigned)__builtin_amdgcn_readlane((int)evN.x, k - PB_D) & 16383u; va[k - PB_D] = *(const u32x2*)(V8 + (ex_ * 512u + rowoff4)); } } \
        } while (0)
            {
            PB_ENT(0, 0);
#pragma unroll
            for (int k = 0; k < 8 - PB_D; ++k) PB_LDV(k);
#pragma unroll 1
            for (int b = 0; b < 16; ++b) {
                PB_BODY(b, 0, b, 1); PB_BODY(b, 1, b, 2); PB_BODY(b, 2, b, 3); PB_BODY(b, 3, b, 4);
                PB_BODY(b, 4, b, 5); PB_BODY(b, 5, b, 6); PB_BODY(b, 6, b, 7);
                PB_BODY(b, 7, (b + 1) & 15, 0);
            }
            }
#undef PB_ENT
#undef PB_LDV
#undef PB_BODY
        }
#pragma unroll
        for (int t = 0; t < 8; ++t) {
            const size_t tok = (size_t)tok0 + 64 * r + 8 * w + t;
            float* orow = P.out + tok * DM + 16 * lane; const float* fg = P.final_norm_g + 16 * lane;
            const u32x4 ra = *(const u32x4*)(XG + tok * DM + 16 * lane), rb = *(const u32x4*)(XG + tok * DM + 16 * lane + 8);
            f32x4 xr[4]; float ss = 0.f;
            xr[0] = (f32x4){bf_lo(ra.x), bf_hi(ra.x), bf_lo(ra.y), bf_hi(ra.y)}; xr[1] = (f32x4){bf_lo(ra.z), bf_hi(ra.z), bf_lo(ra.w), bf_hi(ra.w)};
            xr[2] = (f32x4){bf_lo(rb.x), bf_hi(rb.x), bf_lo(rb.y), bf_hi(rb.y)}; xr[3] = (f32x4){bf_lo(rb.z), bf_hi(rb.z), bf_lo(rb.w), bf_hi(rb.w)};
#pragma unroll
            for (int j = 0; j < 4; ++j) { xr[j] += (f32x4){acc[t][2 * j].x, acc[t][2 * j].y, acc[t][2 * j + 1].x, acc[t][2 * j + 1].y};
                ss += (xr[j][0] * xr[j][0] + xr[j][1] * xr[j][1]) + (xr[j][2] * xr[j][2] + xr[j][3] * xr[j][3]); }
            const float rs = 1.0f / sqrtf(wave_sum_fast(ss) * (1.0f / DM) + RMS_EPS);
#pragma unroll
            for (int j = 0; j < 4; ++j) *(f32x4*)(orow + 4 * j) = xr[j] * rs * *(const f32x4*)(fg + 4 * j);
        }
    }
}
#if defined(DUP_PHASE) && DUP_PHASE == 6
#ifndef CAL_NT
#define CAL_NT 0
#endif
#if CAL_NT == 1
#define CAL_LD(p) __builtin_nontemporal_load(p)
#elif CAL_NT >= 2
__device__ __forceinline__ u32x4 cal_ld_asm(const u32x4* p) { u32x4 v;
#if CAL_NT == 2
    asm volatile("global_load_dwordx4 %0, %1, off sc0" : "=v"(v) : "v"(p) : "memory");
#elif CAL_NT == 3
    asm volatile("global_load_dwordx4 %0, %1, off sc1" : "=v"(v) : "v"(p) : "memory");
#else
    asm volatile("global_load_dwordx4 %0, %1, off sc0 sc1" : "=v"(v) : "v"(p) : "memory");
#endif
    return v; }
#define CAL_LD(p) cal_ld_asm(p)
#else
#define CAL_LD(p) (*(p))
#endif
#endif
constexpr int CW_BAR = 4096;
constexpr int NPHASE = 6;
__global__ void __launch_bounds__(512, 2) fwd(Params P) {
    __shared__ __attribute__((aligned(16))) unsigned char lds_raw[LDS_BYTES];
    LAS unsigned char* lds = (LAS unsigned char*)lds_raw;
    const int tid = threadIdx.x, lane = tid & 63, wave = __builtin_amdgcn_readfirstlane(tid >> 6);
    const int lo = P.ph_lo, hi = P.ph_hi, G = gridDim.x;
#define IN(k) (lo <= (k) && (k) < hi)
#define SEAM(k) do { if (IN(k) && IN((k) + 1)) { if ((k) == 2) cg::this_grid().sync(); else xcd_barrier(xbar); } } while (0)
    bf16* WinT = (bf16*)(P.ws + WS_WIN); bf16* WoutT = (bf16*)(P.ws + WS_WOUT); bf16* WqT = (bf16*)(P.ws + WS_WQ);
    bf16* Hb = (bf16*)(P.ws + WS_H); bf16* PROJ = (bf16*)(P.ws + WS_PROJ); bf16* XG = (bf16*)(P.ws + WS_XG); bf16* Qb = (bf16*)(P.ws + WS_Q);
    float* RSS = (float*)(P.ws + WS_RSS);
    if (tid < 16) ((volatile LAS unsigned*)(lds + LDS_MAIN))[tid] = 0u;
    __syncthreads();
    XcdBarrier xbar = xcd_barrier_post((unsigned*)(P.ws + WS_CTL) + CW_BAR, (volatile LAS unsigned*)(lds + LDS_MAIN + 32));

    if (IN(0)) { p0_prologue(P, lds, wave, lane);
#if defined(DUP_PHASE) && DUP_PHASE == 0
        p0_prologue(P, lds, wave, lane);
#endif
        SEAM(0); }
    if (IN(1)) {
        pg8::Gemm g{Hb, WinT, MTOK, NIN, DM}; pg8::StaticOrder S; S.init(MTOK, NIN, G, (int)blockIdx.x);
        pg8::EpiProj E{PROJ};
        pg8::gemm_phase<pg8::EpiProj, pg8::StaticOrder, true, true>(lds, g, S, E);
#if defined(DUP_PHASE) && DUP_PHASE == 1
        __syncthreads(); pg8::gemm_phase<pg8::EpiProj, pg8::StaticOrder, true, true>(lds, g, S, E);
#endif
        SEAM(1);
    }
    if (IN(2)) { p2_mixers(P, lds); SEAM(2); }
    if (IN(3)) {
        pg8::Gemm g{Hb  , WoutT, MTOK, DM, DM}; pg8::StaticOrder S; S.init(MTOK, DM, G, (int)blockIdx.x);
        pg8::EpiOut E{P.x, XG, RSS};
        pg8::gemm_phase<pg8::EpiOut, pg8::StaticOrder, true, true>(lds, g, S, E);
#if defined(DUP_PHASE) && DUP_PHASE == 3
        __syncthreads(); pg8::gemm_phase<pg8::EpiOut, pg8::StaticOrder, true, true>(lds, g, S, E);
#endif
        SEAM(3);
    }
    if (IN(4)) {
        pg8::Gemm g{XG, WqT, MTOK, NQ, DM}; pg8::StaticOrder S; S.init(MTOK, NQ, G, (int)blockIdx.x);
        pg8::EpiQ E{RSS, Qb};
        pg8::gemm_phase<pg8::EpiQ, pg8::StaticOrder, true, true>(lds, g, S, E);
#if defined(DUP_PHASE) && DUP_PHASE == 4
        __syncthreads(); pg8::gemm_phase<pg8::EpiQ, pg8::StaticOrder, true, true>(lds, g, S, E);
#endif
        SEAM(4);
    }
    if (IN(5)) { p5_scores(P, lds);
#if defined(DUP_PHASE) && DUP_PHASE == 5
        p5_scores(P, lds);
#endif
#if defined(DUP_PHASE) && DUP_PHASE == 7
        p6_gather<DUPMODE>(P, lds, xbar); p6_gather<0>(P, lds, xbar, 1);
#else
        p6_gather(P, lds, xbar);
#endif
#if defined(DUP_PHASE) && DUP_PHASE == 6
        {
            xcd_barrier(xbar);
            const unsigned char* T0 = P.ws + WS_U; const unsigned char* T1 = P.ws + WS_V;
            unsigned rs = ((unsigned)blockIdx.x * 8u + (unsigned)wave) * 2654435761u + 12345u; unsigned accx = 0;
#ifndef CAL_NT
#define CAL_NT 0
#endif
#if CAL_HALF
            for (int sw = 0; sw < 16; ++sw) { const unsigned char* T = ((sw >> 1) & 1) ? T1 : T0; const unsigned coff = (sw & 1) * 512u + lane * 8u;
                for (int it = 0; it < 512 / CAL_DEPTH; ++it) { u32x2 v[CAL_DEPTH];
#pragma unroll
                    for (int i = 0; i < CAL_DEPTH; ++i) { rs = rs * 1664525u + 1013904223u; const unsigned row = ((unsigned)it * (32u * CAL_DEPTH) + ((rs >> 10) & (CAL_BAND - 1u))) & 16383u; v[i] = *(const u32x2*)(T + (size_t)row * 1024 + coff); }
#pragma unroll
                    for (int i = 0; i < CAL_DEPTH; ++i) accx ^= v[i].x ^ v[i].y; } }
#else
            for (int sw = 0; sw < 8; ++sw) { const unsigned char* T = (sw & 1) ? T1 : T0; const unsigned coff = lane * 16u;
                for (int it = 0; it < 512 / CAL_DEPTH; ++it) { u32x4 v[CAL_DEPTH];
#pragma unroll
                    for (int i = 0; i < CAL_DEPTH; ++i) { rs = rs * 1664525u + 1013904223u; const unsigned row = ((unsigned)it * (32u * CAL_DEPTH) + ((rs >> 10) & (CAL_BAND - 1u))) & 16383u; v[i] = CAL_LD((const u32x4*)(T + (size_t)row * 1024 + coff)); }
#if CAL_NT >= 2
                    asm volatile("s_waitcnt vmcnt(0)" ::: "memory");
#pragma unroll
                    for (int i = 0; i < CAL_DEPTH; ++i) asm volatile("" : "+v"(v[i]));
#endif
#pragma unroll
                    for (int i = 0; i < CAL_DEPTH; ++i) accx ^= v[i].x ^ v[i].y ^ v[i].z ^ v[i].w; } }
#endif
            if (accx == 0x1234567u) P.out[0] = 1.f;
        }
#endif
    }
#undef IN
#undef SEAM
}

extern "C" void kernel_launch(void* const* d_in, const int* in_sizes, int n_in, void* d_out, int out_size, void* d_ws, size_t ws_size, hipStream_t stream) {
    static int grid = 0;
    if (grid == 0) {
        if (n_in != 12 || in_sizes[0] != MTOK * DM || out_size != MTOK * DM || ws_size < WS_END) { fprintf(stderr, "kernel_launch: unexpected shapes (n_in %d, in0 %d, out %d, ws %zu)\n", n_in, n_in > 0 ? in_sizes[0] : -1, out_size, ws_size); grid = -1; return; }
        int dev = 0, cus = 0, per_cu = 0;
        (void)hipGetDevice(&dev); (void)hipDeviceGetAttribute(&cus, hipDeviceAttributeMultiprocessorCount, dev);
        (void)hipOccupancyMaxActiveBlocksPerMultiprocessor(&per_cu, (const void*)fwd, 512, 0);
        (void)hipGetLastError();
        if (per_cu < 1 || cus != 256) { fprintf(stderr, "kernel_launch: occupancy %d, cus %d: need 1 block on each of 256 CUs\n", per_cu, cus); grid = -1; return; }
        grid = cus;
    }
    if (grid < 0) return;
    (void)hipMemsetAsync((char*)d_ws + WS_CTL, 0, CTL_BYTES, stream);
    Params p{};
    p.x = (const float*)d_in[0]; p.norm_mix_g = (const float*)d_in[1]; p.w_in = (const float*)d_in[2]; p.diff_lambda = (const float*)d_in[3];
    p.diff_subln_g = (const float*)d_in[4]; p.w_out = (const float*)d_in[5]; p.norm_ffn_g = (const float*)d_in[6]; p.peer_wq = (const float*)d_in[7];
    p.peer_subkeys = (const float*)d_in[8]; p.peer_u = (const float*)d_in[9]; p.peer_v = (const float*)d_in[10]; p.final_norm_g = (const float*)d_in[11];
    p.out = (float*)d_out; p.ws = (unsigned char*)d_ws;
    p.ph_lo = 0; p.ph_hi = NPHASE;
    void* args[] = {&p};
    hipError_t e = hipLaunchCooperativeKernel((const void*)fwd, dim3(grid), dim3(512), args, 0, stream);
    if (e != hipSuccess) fprintf(stderr, "kernel_launch: cooperative launch failed: %s\n", hipGetErrorString(e));
}
```

```cpp
#include <hip/hip_runtime.h>
#include <hip/hip_cooperative_groups.h>
#include <cstdio>
#include <cstdint>
namespace cg = cooperative_groups;

#define TABLES_IN_P1 1

#define LAS __attribute__((address_space(3)))
typedef unsigned short bf16;
typedef short bf16x8 __attribute__((ext_vector_type(8)));
typedef short s16x4 __attribute__((ext_vector_type(4)));
typedef float f32x4 __attribute__((ext_vector_type(4)));
typedef float f32x2 __attribute__((ext_vector_type(2)));
typedef float f32x16 __attribute__((ext_vector_type(16)));
typedef unsigned u32x4 __attribute__((ext_vector_type(4)));
typedef unsigned u32x2 __attribute__((ext_vector_type(2)));
typedef int i32x2 __attribute__((ext_vector_type(2)));

constexpr int BATCH = 16, SEQ = 2048, DM = 1024, MTOK = BATCH * SEQ;
constexpr int NIN = 3584;
constexpr int C_RQ = 0, C_RK = 512, C_RV = 1024, C_RG = 1536, C_DQ = 2048, C_DK = 2560, C_DV = 3072;
constexpr int NQ = 2048;
constexpr int NEXP = 16384;
constexpr float RMS_EPS = 1e-6f;
constexpr float LOG2E = 1.4426950408889634f;
constexpr float QSCALE2 = 0.125f * LOG2E;
constexpr float RK_SCALE = 0.08838834764831845f;

constexpr size_t MiB = 1u << 20;
constexpr size_t WS_CTL = 0, CTL_BYTES = 1 * MiB;
constexpr size_t WS_WIN = 1 * MiB;
constexpr size_t WS_WOUT = 8 * MiB;
constexpr size_t WS_WQ = 10 * MiB;
constexpr size_t WS_SK = 14 * MiB;
constexpr size_t WS_RSS = 15 * MiB;
constexpr size_t WS_U = 17 * MiB;
constexpr size_t WS_SC = 49 * MiB;
constexpr size_t WS_H = 81 * MiB;
constexpr size_t WS_PROJ = 145 * MiB;
constexpr size_t WS_XG = WS_PROJ;
constexpr size_t WS_Q = WS_PROJ + 64 * MiB;
constexpr size_t WS_RMS = 50 * MiB;
constexpr size_t WS_END = WS_PROJ + 224 * MiB;
constexpr int CW_QUEUE = 64;

constexpr int LDS_MAIN = 147456;
constexpr int LDS_BYTES = LDS_MAIN + 256;

__device__ __forceinline__ unsigned f2bf(float f) { unsigned u = __builtin_bit_cast(unsigned, f); return (u + 0x7fffu + ((u >> 16) & 1u)) >> 16; }
__device__ __forceinline__ unsigned pk2(float lo, float hi) { typedef __bf16 bf16x2_t __attribute__((ext_vector_type(2))); f32x2 v = {lo, hi}; bf16x2_t b = __builtin_convertvector(v, bf16x2_t); return __builtin_bit_cast(unsigned, b); }
__device__ __forceinline__ float bf_lo(unsigned u) { return __builtin_bit_cast(float, u << 16); }
__device__ __forceinline__ float bf_hi(unsigned u) { return __builtin_bit_cast(float, u & 0xffff0000u); }
__device__ __forceinline__ unsigned off_b(unsigned row, unsigned ch) { return 256u * row + 16u * (ch ^ (((row & 3) << 2) | ((row >> 2) & 3))); }
__device__ __forceinline__ s16x4 lds_tr(const LAS char* p) { typedef short v4i16_t __attribute__((ext_vector_type(4))); return __builtin_bit_cast(s16x4, __builtin_amdgcn_ds_read_tr16_b64_v4i16((LAS v4i16_t*)p)); }
__device__ __forceinline__ bf16x8 cat8(s16x4 lo, s16x4 hi) { return __builtin_shufflevector(lo, hi, 0, 1, 2, 3, 4, 5, 6, 7); }
__device__ __forceinline__ float wave_sum(float v) {
#pragma unroll
    for (int o = 1; o < 64; o <<= 1) v += __shfl_xor(v, o);
    return v;
}
#define DPPF(v, ctrl) __int_as_float(__builtin_amdgcn_update_dpp(0, __float_as_int(v), ctrl, 0xf, 0xf, false))
__device__ __forceinline__ float wave_sum_fast(float v) {
    v += DPPF(v, 0xB1); v += DPPF(v, 0x4E); v += DPPF(v, 0x141); v += DPPF(v, 0x140);
    { auto r = __builtin_amdgcn_permlane16_swap(__float_as_uint(v), __float_as_uint(v), false, false); v = __uint_as_float(r[0]) + __uint_as_float(r[1]); }
    { auto r = __builtin_amdgcn_permlane32_swap(__float_as_uint(v), __float_as_uint(v), false, false); v = __uint_as_float(r[0]) + __uint_as_float(r[1]); }
    return v;
}
__device__ __forceinline__ float wave_max_fast(float v) {
    v = fmaxf(v, DPPF(v, 0xB1)); v = fmaxf(v, DPPF(v, 0x4E)); v = fmaxf(v, DPPF(v, 0x141)); v = fmaxf(v, DPPF(v, 0x140));
    { auto r = __builtin_amdgcn_permlane16_swap(__float_as_uint(v), __float_as_uint(v), false, false); v = fmaxf(__uint_as_float(r[0]), __uint_as_float(r[1])); }
    { auto r = __builtin_amdgcn_permlane32_swap(__float_as_uint(v), __float_as_uint(v), false, false); v = fmaxf(__uint_as_float(r[0]), __uint_as_float(r[1])); }
    return v;
}
namespace pg8 {
#define PG8_LAS __attribute__((address_space(3)))
typedef unsigned short bf16_t;
typedef short bf16x8 __attribute__((ext_vector_type(8)));
typedef float f32x4 __attribute__((ext_vector_type(4)));
typedef unsigned u32x4 __attribute__((ext_vector_type(4)));
constexpr int BM = 256, BK = 64, HALF = 128, HTB = HALF * BK * 2  , STAGE_BYTES = 8 * HTB, NXCD = 8, WGM = 8;

__host__ __device__ __forceinline__ int lds_byte(int r, int c) { const int st = (r >> 4) * 2 + (c >> 5), rr = r & 15, cc = c & 31, ob = rr * 64 + cc * 2; return st * 1024 + (ob ^ (((ob >> 9) & 1) << 5)); }
__host__ __device__ __forceinline__ void stage_rc(int b, int& R, int& C) { const int st = b / 1024, sb = b % 1024, swz = sb ^ (((sb >> 9) & 1) << 5); R = (st >> 1) * 16 + swz / 64; C = (st & 1) * 32 + (swz % 64) / 2; }
__host__ __device__ __forceinline__ int perm32(int rho) { const int n = rho >> 4, i = rho & 15; return 8 * (i >> 2) + 4 * n + (i & 3); }

struct Unit { int pm, pn; };
struct Gemm { const bf16_t* A; const bf16_t* Bt; int M, N, K; };

struct StaticOrder {
    int nM, nN, nwg, G, c;
    __host__ __device__ void init(int M, int N, int G_, int c_) { nM = M / BM; nN = N / BM; nwg = nM * nN; G = G_; c = c_; }
    __host__ __device__ bool next(int i, Unit& u) const {
        const long L = (long)i * G + c; if (L >= nwg) return false;
        int wgid = (int)L; { const int q = nwg / NXCD, r = nwg % NXCD, xcd = wgid % NXCD, off = wgid / NXCD; wgid = (xcd < r ? xcd * (q + 1) : r * (q + 1) + (xcd - r) * q) + off; }
        const int nig = WGM * nN, gid = wgid / nig, fm = gid * WGM, gsz = (nM - fm) < WGM ? (nM - fm) : WGM;
        u.pm = fm + ((wgid % nig) % gsz); u.pn = (wgid % nig) / gsz; return true;
    }
    __device__ __forceinline__ void a_ready(const Unit&) const {}
    __device__ __forceinline__ void done(const Unit&) const {}
};

__device__ __forceinline__ unsigned cvt_pk_bf16(float lo, float hi) { unsigned r; asm volatile("v_cvt_pk_bf16_f32 %0, %1, %2" : "=v"(r) : "v"(lo), "v"(hi)); return r; }
typedef float f32x2 __attribute__((ext_vector_type(2)));
__device__ __forceinline__ f32x2 gelu_pk(f32x2 v) {
    const f32x2 av = __builtin_elementwise_abs(v), d = av * 0.2316418882f + 1.0f;
    f32x2 t; t.x = __builtin_amdgcn_rcpf(d.x); t.y = __builtin_amdgcn_rcpf(d.y);
    f32x2 q = t * 0.5307027145f + (-0.7265760135f); q = q * t + 0.7107068705f; q = q * t + (-0.142248368f); q = q * t + 0.127414796f; q = q * t;
    const f32x2 s = (v * v) * (-0.72134752044f);
    f32x2 e; e.x = __builtin_amdgcn_exp2f(s.x); e.y = __builtin_amdgcn_exp2f(s.y);
    const f32x2 m = v * (q * e), r = v - m;
    f32x2 o; o.x = v.x < 0.f ? m.x : r.x; o.y = v.y < 0.f ? m.y : r.y; return o;
}

template <class Epi, class Sched, bool ALIGN_EPI = false, bool SP2 = false>
__device__ __forceinline__ void gemm_phase(PG8_LAS unsigned char* lds, const Gemm g, const Sched& S, const Epi& E) {
    const int tid = threadIdx.x, wid = __builtin_amdgcn_readfirstlane(tid >> 6), lane = tid & 63, wr = wid >> 2, wc = wid & 3, fr = lane & 15, fq = lane >> 4;
    const int K = g.K, nt = K / BK;
    unsigned voffA[2], voffB[2];
#pragma unroll
    for (int i = 0; i < 2; ++i) { int R, C; stage_rc(tid * 16 + i * 8192, R, C); const int Rb = Epi::PERM ? ((R & ~31) + perm32(R & 31)) : R;
        voffA[i] = (unsigned)(R * K + C) * 2u; voffB[i] = (unsigned)(Rb * K + C) * 2u; }
    const size_t kstep = (size_t)(BK * 2);
    const size_t hstep = (size_t)HALF * K * 2;
    const size_t tstep = 2 * hstep;
    const unsigned ldsw = (unsigned)wid * 1024u;
    const int aoff = lds_byte(wr * 64 + fr, fq * 8), boff = lds_byte(wc * 32 + fr, fq * 8);
#define PG8_SA(b, h) (((b) * 2 + (h)) * HTB)
#define PG8_SB(b, h) ((4 + (b) * 2 + (h)) * HTB)
#define PG8_STAGE(bufoff, gbase, voff) do { _Pragma("unroll") for (int _i = 0; _i < 2; ++_i) \
        __builtin_amdgcn_global_load_lds((const unsigned*)((const char*)(gbase) + (voff)[_i]), (PG8_LAS unsigned*)(lds + (bufoff) + ldsw + _i * 8192), 16, 0, 0); } while (0)
#define PG8_LDA(dst, b, h) do { _Pragma("unroll") for (int m = 0; m < 4; ++m) _Pragma("unroll") for (int k = 0; k < 2; ++k) dst[m][k] = *(const PG8_LAS bf16x8*)(lds + PG8_SA(b, h) + aoff + m * 2048 + k * 1024); } while (0)
#define PG8_LDB(dst, b, h) do { _Pragma("unroll") for (int n = 0; n < 2; ++n) _Pragma("unroll") for (int k = 0; k < 2; ++k) dst[n][k] = *(const PG8_LAS bf16x8*)(lds + PG8_SB(b, h) + boff + n * 2048 + k * 1024); } while (0)
#define PG8_MMA(ai, bj, At, Bt) do { __builtin_amdgcn_s_setprio(1); _Pragma("unroll") for (int m = 0; m < 4; ++m) _Pragma("unroll") for (int n = 0; n < 2; ++n) _Pragma("unroll") for (int k = 0; k < 2; ++k) \
        acc[ai][bj][m][n] = __builtin_amdgcn_mfma_f32_16x16x32_bf16(Bt[n][k], At[m][k], acc[ai][bj][m][n], 0, 0, 0); __builtin_amdgcn_s_setprio(0); } while (0)
#define PG8_WAIT_V(n) asm volatile("s_waitcnt vmcnt(" #n ")" ::: "memory")
#define PG8_WAIT_L(n) asm volatile("s_waitcnt lgkmcnt(" #n ")" ::: "memory")
#define PG8_BAR __builtin_amdgcn_s_barrier()
#define PG8_SCHED __builtin_amdgcn_sched_barrier(0)
    Unit cur, nxt; int ui = 0;
    if (!S.next(0, cur)) return;
    f32x4 acc[2][2][4][2];
#pragma unroll
    for (int a = 0; a < 2; ++a)
#pragma unroll
        for (int b = 0; b < 2; ++b)
#pragma unroll
            for (int m = 0; m < 4; ++m)
#pragma unroll
                for (int n = 0; n < 2; ++n) acc[a][b][m][n] = (f32x4){0.f, 0.f, 0.f, 0.f};
    bf16x8 At[4][2], B0[2][2], B1[2][2];
    const char* cA = (const char*)g.A + (size_t)cur.pm * tstep; const char* cB = (const char*)g.Bt + (size_t)cur.pn * tstep;
    S.a_ready(cur);
    if constexpr (SP2) {
        PG8_STAGE(PG8_SB(0, 0), cB, voffB); PG8_STAGE(PG8_SB(0, 1), cB + hstep, voffB); PG8_STAGE(PG8_SA(0, 0), cA, voffA); PG8_STAGE(PG8_SA(0, 1), cA + hstep, voffA);
        if (wr == 1) PG8_BAR;
        PG8_WAIT_V(2); PG8_BAR;
        PG8_STAGE(PG8_SB(1, 0), cB + kstep, voffB); PG8_STAGE(PG8_SA(1, 0), cA + kstep, voffA); PG8_STAGE(PG8_SB(1, 1), cB + hstep + kstep, voffB);
        PG8_WAIT_V(6); PG8_BAR;
    } else {
        PG8_STAGE(PG8_SB(0, 0), cB, voffB); PG8_STAGE(PG8_SA(0, 0), cA, voffA); PG8_STAGE(PG8_SB(0, 1), cB + hstep, voffB); PG8_STAGE(PG8_SA(0, 1), cA + hstep, voffA);
        if (wr == 1) PG8_BAR;
        PG8_WAIT_V(4); PG8_BAR;
        PG8_STAGE(PG8_SB(1, 0), cB + kstep, voffB); PG8_STAGE(PG8_SA(1, 0), cA + kstep, voffA); PG8_STAGE(PG8_SB(1, 1), cB + hstep + kstep, voffB);
        PG8_WAIT_V(6); PG8_BAR;
    }
    for (;;) {
        const bool has_next = S.next(ui + 1, nxt);
        const char* nA = has_next ? (const char*)g.A + (size_t)nxt.pm * tstep : cA; const char* nB = has_next ? (const char*)g.Bt + (size_t)nxt.pn * tstep : cB;
        for (int t = 0; t < nt; t += 2) {
            const bool last = (t == nt - 2);
            const char* a1 = cA + (size_t)(t + 1) * kstep;
            const char* a2 = last ? nA : cA + (size_t)(t + 2) * kstep; const char* b2 = last ? nB : cB + (size_t)(t + 2) * kstep;
            const char* a3 = a2 + kstep; const char* b3 = b2 + kstep;
            if (last && has_next) S.a_ready(nxt);
            if constexpr (SP2) {
            PG8_LDB(B0, 0, 0); PG8_LDB(B1, 0, 1); PG8_SCHED; PG8_LDA(At, 0, 0); PG8_STAGE(PG8_SA(1, 1), a1 + hstep, voffA);
            PG8_WAIT_V(8); PG8_WAIT_L(0); PG8_BAR; PG8_MMA(0, 0, At, B0); PG8_MMA(0, 1, At, B1); PG8_BAR; PG8_SCHED;
            PG8_LDA(At, 0, 1); PG8_STAGE(PG8_SB(0, 0), b2, voffB); PG8_STAGE(PG8_SB(0, 1), b2 + hstep, voffB); PG8_STAGE(PG8_SA(0, 0), a2, voffA);
            PG8_WAIT_V(8); PG8_WAIT_L(0); PG8_BAR; PG8_MMA(1, 0, At, B0); PG8_MMA(1, 1, At, B1); PG8_BAR; PG8_SCHED;
            PG8_LDB(B0, 1, 0); PG8_LDB(B1, 1, 1); PG8_SCHED; PG8_LDA(At, 1, 0); PG8_STAGE(PG8_SA(0, 1), a2 + hstep, voffA);
            PG8_WAIT_V(8); PG8_WAIT_L(0); PG8_BAR; PG8_MMA(0, 0, At, B0); PG8_MMA(0, 1, At, B1); PG8_BAR; PG8_SCHED;
            PG8_LDA(At, 1, 1); PG8_STAGE(PG8_SB(1, 0), b3, voffB); PG8_STAGE(PG8_SB(1, 1), b3 + hstep, voffB); PG8_STAGE(PG8_SA(1, 0), a3, voffA);
            PG8_WAIT_V(8); PG8_WAIT_L(0); PG8_BAR; PG8_MMA(1, 0, At, B0); PG8_MMA(1, 1, At, B1); PG8_BAR; PG8_SCHED;
            } else {
            PG8_LDB(B0, 0, 0); PG8_SCHED; PG8_LDA(At, 0, 0); PG8_STAGE(PG8_SA(1, 1), a1 + hstep, voffA);
            PG8_WAIT_L(8); PG8_BAR; PG8_WAIT_L(0); PG8_MMA(0, 0, At, B0); PG8_BAR; PG8_SCHED;
            PG8_LDB(B1, 0, 1); PG8_STAGE(PG8_SB(0, 0), b2, voffB);
            PG8_BAR; PG8_WAIT_L(0); PG8_MMA(0, 1, At, B1); PG8_BAR;
            PG8_LDA(At, 0, 1); PG8_STAGE(PG8_SA(0, 0), a2, voffA);
            PG8_BAR; PG8_WAIT_L(0); PG8_MMA(1, 0, At, B0); PG8_BAR; PG8_SCHED;
            PG8_STAGE(PG8_SB(0, 1), b2 + hstep, voffB);
            PG8_WAIT_V(6); PG8_BAR; PG8_MMA(1, 1, At, B1); PG8_BAR;
            PG8_LDB(B0, 1, 0); PG8_SCHED; PG8_LDA(At, 1, 0); PG8_STAGE(PG8_SA(0, 1), a2 + hstep, voffA);
            PG8_WAIT_L(8); PG8_BAR; PG8_WAIT_L(0); PG8_MMA(0, 0, At, B0); PG8_BAR; PG8_SCHED;
            PG8_LDB(B1, 1, 1); PG8_STAGE(PG8_SB(1, 0), b3, voffB);
            PG8_BAR; PG8_WAIT_L(0); PG8_MMA(0, 1, At, B1); PG8_BAR;
            PG8_LDA(At, 1, 1); PG8_STAGE(PG8_SA(1, 0), a3, voffA);
            PG8_BAR; PG8_WAIT_L(0); PG8_MMA(1, 0, At, B0); PG8_BAR; PG8_SCHED;
            PG8_STAGE(PG8_SB(1, 1), b3 + hstep, voffB);
            PG8_WAIT_V(6); PG8_BAR; PG8_MMA(1, 1, At, B1); PG8_BAR;
            }
        }
        if constexpr (ALIGN_EPI) { if (wr == 0) PG8_BAR; }
        if constexpr (!Epi::AFTER_DRAIN) { E(acc, cur, wr, wc, fr, fq); S.done(cur); }
        if (!has_next) break;
#pragma unroll
        for (int a = 0; a < 2; ++a)
#pragma unroll
            for (int b = 0; b < 2; ++b)
#pragma unroll
                for (int m = 0; m < 4; ++m)
#pragma unroll
                    for (int n = 0; n < 2; ++n) acc[a][b][m][n] = (f32x4){0.f, 0.f, 0.f, 0.f};
        cur = nxt; cA = nA; cB = nB; ++ui;
        if constexpr (ALIGN_EPI) { if (wr == 1) PG8_BAR; }
    }
    PG8_WAIT_V(0);
    if constexpr (!ALIGN_EPI) { if (wr == 0) PG8_BAR; }
    PG8_BAR;
    if constexpr (Epi::AFTER_DRAIN) { E.fused(acc, cur, wr, wc, fr, fq, lds, wid, lane); S.done(cur); }
#undef PG8_SA
#undef PG8_SB
#undef PG8_STAGE
#undef PG8_LDA
#undef PG8_LDB
#undef PG8_MMA
#undef PG8_WAIT_V
#undef PG8_WAIT_L
#undef PG8_BAR
#undef PG8_SCHED
}
}
namespace pg8 {
struct EpiProj {
    static constexpr bool PERM = true, AFTER_DRAIN = false;
    bf16_t* O;
    __device__ __forceinline__ void operator()(const f32x4 (&acc)[2][2][4][2], const Unit& u, int wr, int wc, int fr, int fq) const {
        const int row0 = u.pm * BM + wr * 64 + fr, col0 = u.pn * BM + wc * 32 + 8 * fq;
        const float sc = (u.pn == 2 || u.pn == 3) ? RK_SCALE : ((u.pn == 8 || u.pn == 9) ? QSCALE2 : 1.f);
#pragma unroll
        for (int ai = 0; ai < 2; ++ai)
#pragma unroll
            for (int m = 0; m < 4; ++m) { bf16_t* rowp = O + (size_t)(row0 + ai * HALF + m * 16) * NIN + col0;
#pragma unroll
                for (int bj = 0; bj < 2; ++bj) { const f32x4 v0 = acc[ai][bj][m][0] * sc, v1 = acc[ai][bj][m][1] * sc;
                    u32x4 w; w.x = cvt_pk_bf16(v0[0], v0[1]); w.y = cvt_pk_bf16(v0[2], v0[3]); w.z = cvt_pk_bf16(v1[0], v1[1]); w.w = cvt_pk_bf16(v1[2], v1[3]);
                    *(u32x4*)(rowp + bj * HALF) = w; } }
    }
};
struct EpiOut {
    static constexpr bool PERM = true, AFTER_DRAIN = false;
    const bf16_t* HN; const float* RMS; bf16_t* XB; float* RSS;
    __device__ __forceinline__ void operator()(const f32x4 (&acc)[2][2][4][2], const Unit& u, int wr, int wc, int fr, int fq) const {
        const int row0 = u.pm * BM + wr * 64 + fr, col0 = u.pn * BM + wc * 32 + 8 * fq;
        float rms[2][4];
#pragma unroll
        for (int ai = 0; ai < 2; ++ai)
#pragma unroll
            for (int m = 0; m < 4; ++m) rms[ai][m] = RMS[row0 + ai * HALF + m * 16];
#pragma unroll
        for (int ai = 0; ai < 2; ++ai)
#pragma unroll
            for (int m = 0; m < 4; ++m) { const int row = row0 + ai * HALF + m * 16; const size_t off = (size_t)row * DM + col0; float ss = 0.f; const float rm = rms[ai][m];
#pragma unroll
                for (int bj = 0; bj < 2; ++bj) {
                    const u32x4 xw = __builtin_nontemporal_load((const u32x4*)(HN + off + bj * HALF));
                    const f32x4 a0 = (f32x4){__builtin_bit_cast(float, xw.x << 16), __builtin_bit_cast(float, xw.x & 0xffff0000u), __builtin_bit_cast(float, xw.y << 16), __builtin_bit_cast(float, xw.y & 0xffff0000u)} * rm + acc[ai][bj][m][0];
                    const f32x4 a1 = (f32x4){__builtin_bit_cast(float, xw.z << 16), __builtin_bit_cast(float, xw.z & 0xffff0000u), __builtin_bit_cast(float, xw.w << 16), __builtin_bit_cast(float, xw.w & 0xffff0000u)} * rm + acc[ai][bj][m][1];
                    ss += (a0[0] * a0[0] + a0[1] * a0[1]) + (a0[2] * a0[2] + a0[3] * a0[3]) + (a1[0] * a1[0] + a1[1] * a1[1]) + (a1[2] * a1[2] + a1[3] * a1[3]);
                    u32x4 w; w.x = cvt_pk_bf16(a0[0], a0[1]); w.y = cvt_pk_bf16(a0[2], a0[3]); w.z = cvt_pk_bf16(a1[0], a1[1]); w.w = cvt_pk_bf16(a1[2], a1[3]);
                    *(u32x4*)(XB + off + bj * HALF) = w; }
                ss += __shfl_xor(ss, 16); ss += __shfl_xor(ss, 32);
                if (fq == 0) RSS[(size_t)row * 16 + u.pn * 4 + wc] = ss; }
    }
};
struct EpiQ {
    static constexpr bool PERM = true, AFTER_DRAIN = false;
    const float* RSS; bf16_t* Q;
    static constexpr int EQ_D = 3;
    __device__ __forceinline__ void operator()(const f32x4 (&acc)[2][2][4][2], const Unit& u, int wr, int wc, int fr, int fq) const {
        const int row0 = u.pm * BM + wr * 64 + fr, col0 = u.pn * BM + wc * 32 + 8 * fq;
        f32x4 rb[EQ_D + 1][4];
#define EQ_LOAD(st) do { const f32x4* rp_ = (const f32x4*)(RSS + (size_t)(row0 + ((st) >> 2) * HALF + ((st) & 3) * 16) * 16); \
            _Pragma("unroll") for (int q = 0; q < 4; ++q) rb[(st) % (EQ_D + 1)][q] = rp_[q]; __builtin_amdgcn_sched_barrier(0); } while (0)
#define EQ_STEP(st) do { const int ai = (st) >> 2, m = (st) & 3, row = row0 + ai * HALF + m * 16; \
            const f32x4 s0 = rb[(st) % (EQ_D + 1)][0], s1 = rb[(st) % (EQ_D + 1)][1], s2 = rb[(st) % (EQ_D + 1)][2], s3 = rb[(st) % (EQ_D + 1)][3]; \
            const float ss = ((s0[0] + s0[1]) + (s0[2] + s0[3])) + ((s1[0] + s1[1]) + (s1[2] + s1[3])) + ((s2[0] + s2[1]) + (s2[2] + s2[3])) + ((s3[0] + s3[1]) + (s3[2] + s3[3])); \
            const float rstd = 1.0f / sqrtf(ss * (1.0f / DM) + RMS_EPS); \
            bf16_t* rowp = Q + (size_t)row * NQ + col0; \
            _Pragma("unroll") for (int bj = 0; bj < 2; ++bj) { const f32x4 v0 = acc[ai][bj][m][0] * rstd, v1 = acc[ai][bj][m][1] * rstd; \
                u32x4 w; w.x = cvt_pk_bf16(v0[0], v0[1]); w.y = cvt_pk_bf16(v0[2], v0[3]); w.z = cvt_pk_bf16(v1[0], v1[1]); w.w = cvt_pk_bf16(v1[2], v1[3]); \
                *(u32x4*)(rowp + bj * HALF) = w; } __builtin_amdgcn_sched_barrier(0); } while (0)
        EQ_LOAD(0); EQ_LOAD(1); EQ_LOAD(2);
        EQ_LOAD(3); EQ_STEP(0); EQ_LOAD(4); EQ_STEP(1); EQ_LOAD(5); EQ_STEP(2); EQ_LOAD(6); EQ_STEP(3); EQ_LOAD(7); EQ_STEP(4);
        EQ_STEP(5); EQ_STEP(6); EQ_STEP(7);
#undef EQ_LOAD
#undef EQ_STEP
    }
};
}
struct Params {
    const float *x, *norm_mix_g, *w_in, *diff_lambda, *diff_subln_g, *w_out, *norm_ffn_g, *peer_wq, *peer_subkeys, *peer_u, *peer_v, *final_norm_g;
    float* out; unsigned char* ws; int ph_lo, ph_hi;
};
__device__ __forceinline__ void p0_transpose_item(const float* W, int K, int N, bf16* WT, LAS float* scr, int item, int lane, const float* gk = nullptr) {
    const int nblk = N / 32, kb = item / nblk, nb = item % nblk, k0 = 64 * kb, n0 = 32 * nb;
#pragma unroll 8
    for (int i = 0; i < 32; ++i) { const int kk = 2 * i + (lane >> 5); scr[kk * 33 + (lane & 31)] = W[(size_t)(k0 + kk) * N + n0 + (lane & 31)] * (gk ? gk[k0 + kk] : 1.0f); }
    asm volatile("s_waitcnt lgkmcnt(0)" ::: "memory");
    const int c = lane & 7;
#pragma unroll
    for (int j = 0; j < 4; ++j) { const int n = (lane >> 3) + 8 * j; const LAS float* s = scr + (8 * c) * 33 + n;
        u32x4 o; o.x = pk2(s[0 * 33], s[1 * 33]); o.y = pk2(s[2 * 33], s[3 * 33]); o.z = pk2(s[4 * 33], s[5 * 33]); o.w = pk2(s[6 * 33], s[7 * 33]);
        *(u32x4*)(WT + (size_t)(n0 + n) * K + k0 + 8 * c) = o; }
    asm volatile("s_waitcnt lgkmcnt(0)" ::: "memory");
}
__device__ __forceinline__ void p0_convert(const float* src, bf16* dst, size_t n8, int gw, int ngw, int lane) {
    for (size_t g = (size_t)gw * 64 + lane; g < n8; g += (size_t)ngw * 64) {
        const f32x4 a = ((const f32x4*)src)[2 * g], b = ((const f32x4*)src)[2 * g + 1];
        u32x4 o; o.x = pk2(a[0], a[1]); o.y = pk2(a[2], a[3]); o.z = pk2(b[0], b[1]); o.w = pk2(b[2], b[3]);
        ((u32x4*)dst)[g] = o; }
}
template <int NR = 2>
__device__ __forceinline__ void p0_fp4_rows(const float* src, unsigned char* dst, unsigned short* sc16, int gw, int ngw, int lane, int trip0 = 0, int ntrip = NEXP) {
    float cal; { float four = 4.f; asm volatile("" : "+v"(four)); const unsigned enc = __builtin_amdgcn_cvt_scalef32_pk_fp4_f32(0u, four, four, 1.0f, 0); const f32x2 dec = __builtin_amdgcn_cvt_scalef32_pk_f32_fp4(enc, 1.0f, 0); cal = 4.f / dec.x; }
    for (int row0 = gw + trip0 * NR * ngw, t_ = 0; row0 < NEXP && t_ < ntrip; row0 += NR * ngw, ++t_) {
        f32x4 v[NR][4]; float m[NR];
#pragma unroll
        for (int q = 0; q < NR; ++q) { const f32x4* sp = (const f32x4*)(src + (size_t)(row0 + q * ngw) * DM + 16 * lane);
#pragma unroll
            for (int j = 0; j < 4; ++j) v[q][j] = __builtin_nontemporal_load(sp + j); }
#pragma unroll
        for (int q = 0; q < NR; ++q) { float mm = 0.f;
#pragma unroll
            for (int j = 0; j < 4; ++j) mm = fmaxf(mm, fmaxf(fmaxf(fabsf(v[q][j][0]), fabsf(v[q][j][1])), fmaxf(fabsf(v[q][j][2]), fabsf(v[q][j][3]))));
#pragma unroll
            for (int o = 1; o < 64; o <<= 1) mm = fmaxf(mm, __shfl_xor(mm, o));
            m[q] = mm; }
#pragma unroll
        for (int q = 0; q < NR; ++q) { const int row = row0 + q * ngw;
            const unsigned ib = (__float_as_uint(m[q] > 0.f ? m[q] * (1.0f / 6.f) : 1.f) + 0xffffu) & 0xffff0000u;
            const float sc = 1.0f / __uint_as_float(ib);
            u32x2 o;
#pragma unroll
            for (int j = 0; j < 2; ++j) { unsigned pk = 0u;
                pk = __builtin_amdgcn_cvt_scalef32_pk_fp4_f32(pk, v[q][2 * j][0] * sc, v[q][2 * j][1] * sc, 1.0f, 0); pk = __builtin_amdgcn_cvt_scalef32_pk_fp4_f32(pk, v[q][2 * j][2] * sc, v[q][2 * j][3] * sc, 1.0f, 1);
                pk = __builtin_amdgcn_cvt_scalef32_pk_fp4_f32(pk, v[q][2 * j + 1][0] * sc, v[q][2 * j + 1][1] * sc, 1.0f, 2); pk = __builtin_amdgcn_cvt_scalef32_pk_fp4_f32(pk, v[q][2 * j + 1][2] * sc, v[q][2 * j + 1][3] * sc, 1.0f, 3);
                o[j] = pk; }
            *(u32x2*)(dst + (size_t)row * DM + 16 * lane + 8) = o;
            if (lane == 0) sc16[2 * row] = (unsigned short)(__float_as_uint(__uint_as_float(ib) * cal) >> 16); }
    }
}
__device__ __forceinline__ void p0_norm_row(const float* xrow, const float* g, bf16* orow, int lane) {
    const f32x4* xr = (const f32x4*)xrow + lane; const f32x4* gr = (const f32x4*)g + lane;
    f32x4 v[4]; float s = 0.f;
#pragma unroll
    for (int j = 0; j < 4; ++j) { v[j] = xr[64 * j]; s += (v[j][0] * v[j][0] + v[j][1] * v[j][1]) + (v[j][2] * v[j][2] + v[j][3] * v[j][3]); }
    const float rstd = 1.0f / sqrtf(wave_sum(s) * (1.f / DM) + RMS_EPS);
    u32x2* o8 = (u32x2*)orow + lane;
#pragma unroll
    for (int j = 0; j < 4; ++j) { const f32x4 gg = gr[64 * j]; u32x2 o; o.x = pk2(v[j][0] * rstd * gg[0], v[j][1] * rstd * gg[1]); o.y = pk2(v[j][2] * rstd * gg[2], v[j][3] * rstd * gg[3]); o8[64 * j] = o; }
}
__device__ __forceinline__ void p0_norm_row2(const float* xrow0, const float* xrow1, const float* g, bf16* orow0, bf16* orow1, int lane) {
    const f32x4* x0 = (const f32x4*)xrow0 + lane; const f32x4* x1 = (const f32x4*)xrow1 + lane; const f32x4* gr = (const f32x4*)g + lane;
    f32x4 a[4], b[4]; float sa = 0.f, sb = 0.f;
#pragma unroll
    for (int j = 0; j < 4; ++j) { a[j] = __builtin_nontemporal_load(x0 + 64 * j); b[j] = __builtin_nontemporal_load(x1 + 64 * j); }
#pragma unroll
    for (int j = 0; j < 4; ++j) { sa += (a[j][0] * a[j][0] + a[j][1] * a[j][1]) + (a[j][2] * a[j][2] + a[j][3] * a[j][3]); sb += (b[j][0] * b[j][0] + b[j][1] * b[j][1]) + (b[j][2] * b[j][2] + b[j][3] * b[j][3]); }
    const float ra = 1.0f / sqrtf(wave_sum(sa) * (1.f / DM) + RMS_EPS), rb = 1.0f / sqrtf(wave_sum(sb) * (1.f / DM) + RMS_EPS);
    u32x2* oa = (u32x2*)orow0 + lane; u32x2* ob = (u32x2*)orow1 + lane;
#pragma unroll
    for (int j = 0; j < 4; ++j) { const f32x4 gg = gr[64 * j];
        u32x2 o; o.x = pk2(a[j][0] * ra * gg[0], a[j][1] * ra * gg[1]); o.y = pk2(a[j][2] * ra * gg[2], a[j][3] * ra * gg[3]); oa[64 * j] = o;
        u32x2 q; q.x = pk2(b[j][0] * rb * gg[0], b[j][1] * rb * gg[1]); q.y = pk2(b[j][2] * rb * gg[2], b[j][3] * rb * gg[3]); ob[64 * j] = q; }
}
__device__ __forceinline__ void p0_hn_row2(const float* xrow0, const float* xrow1, bf16* orow0, bf16* orow1, float* r0, float* r1, int lane) {
    const f32x4* x0 = (const f32x4*)xrow0 + lane; const f32x4* x1 = (const f32x4*)xrow1 + lane;
    f32x4 a[4], b[4]; float sa = 0.f, sb = 0.f;
#pragma unroll
    for (int j = 0; j < 4; ++j) { a[j] = __builtin_nontemporal_load(x0 + 64 * j); b[j] = __builtin_nontemporal_load(x1 + 64 * j); }
#pragma unroll
    for (int j = 0; j < 4; ++j) { sa += (a[j][0] * a[j][0] + a[j][1] * a[j][1]) + (a[j][2] * a[j][2] + a[j][3] * a[j][3]); sb += (b[j][0] * b[j][0] + b[j][1] * b[j][1]) + (b[j][2] * b[j][2] + b[j][3] * b[j][3]); }
    const float ma = sqrtf(wave_sum(sa) * (1.f / DM) + RMS_EPS), mb = sqrtf(wave_sum(sb) * (1.f / DM) + RMS_EPS), ra = 1.0f / ma, rb = 1.0f / mb;
    u32x2* oa = (u32x2*)orow0 + lane; u32x2* ob = (u32x2*)orow1 + lane;
#pragma unroll
    for (int j = 0; j < 4; ++j) {
        u32x2 o; o.x = pk2(a[j][0] * ra, a[j][1] * ra); o.y = pk2(a[j][2] * ra, a[j][3] * ra); oa[64 * j] = o;
        u32x2 q; q.x = pk2(b[j][0] * rb, b[j][1] * rb); q.y = pk2(b[j][2] * rb, b[j][3] * rb); ob[64 * j] = q; }
    if (lane == 0) { *r0 = ma; *r1 = mb; }
}
template <int NR = 2>
__device__ __forceinline__ void p0_i4_rows(const float* src, const float* gain, unsigned char* dst, unsigned short* sc16, int gw, int ngw, int lane, int trip0 = 0, int ntrip = NEXP) {
    f32x4 gq[4];
#pragma unroll
    for (int j = 0; j < 4; ++j) gq[j] = *(const f32x4*)(gain + 16 * lane + 4 * j);
    for (int row0 = gw + trip0 * NR * ngw, t_ = 0; row0 < NEXP && t_ < ntrip; row0 += NR * ngw, ++t_) {
        f32x4 v[NR][4]; float m[NR];
#pragma unroll
        for (int q = 0; q < NR; ++q) { const f32x4* sp = (const f32x4*)(src + (size_t)(row0 + q * ngw) * DM + 16 * lane);
#pragma unroll
            for (int j = 0; j < 4; ++j) v[q][j] = __builtin_nontemporal_load(sp + j) * gq[j]; }
#pragma unroll
        for (int q = 0; q < NR; ++q) { float mm = 0.f;
#pragma unroll
            for (int j = 0; j < 4; ++j) mm = fmaxf(mm, fmaxf(fmaxf(fabsf(v[q][j][0]), fabsf(v[q][j][1])), fmaxf(fabsf(v[q][j][2]), fabsf(v[q][j][3]))));
#pragma unroll
            for (int o = 1; o < 64; o <<= 1) mm = fmaxf(mm, __shfl_xor(mm, o));
            m[q] = mm; }
#pragma unroll
        for (int q = 0; q < NR; ++q) { const int row = row0 + q * ngw;
            const unsigned ib = (__float_as_uint(m[q] > 0.f ? m[q] * (1.0f / 7.f) : 1.f) + 0xffffu) & 0xffff0000u;
            const float sc = 1.0f / __uint_as_float(ib);
            u32x2 o;
#pragma unroll
            for (int h = 0; h < 2; ++h) { unsigned pk = 0u;
#pragma unroll
                for (int i = 0; i < 8; ++i) { const int b = (int)rintf(v[q][2 * h + (i >> 2)][i & 3] * sc); pk |= ((unsigned)b & 15u) << (4 * i); }
                o[h] = pk; }
            *(u32x2*)(dst + (size_t)row * DM + 16 * lane) = o;
            if (lane == 0) sc16[2 * row + 1] = (unsigned short)(ib >> 16); }
    }
}
__device__ __forceinline__ void p0_prologue(const Params& P, LAS unsigned char* lds, int wave, int lane) {
    LAS float* scr = (LAS float*)(lds + wave * 16384);
    const int gw = blockIdx.x * 8 + wave, ngw = gridDim.x * 8;
    constexpr int I_IN = (DM / 64) * (NIN / 32), I_OUT = (DM / 64) * (DM / 32), I_WQ = (DM / 64) * (NQ / 32), NIT = I_IN + I_OUT + I_WQ;
    bf16* WinT = (bf16*)(P.ws + WS_WIN); bf16* WoutT = (bf16*)(P.ws + WS_WOUT); bf16* WqT = (bf16*)(P.ws + WS_WQ);
    for (int it = gw; it < NIT; it += ngw) {
        int r = it;
        if (r < I_IN) { p0_transpose_item(P.w_in, DM, NIN, WinT, scr, r, lane, P.norm_mix_g); continue; }   r -= I_IN;
        if (r < I_OUT) { p0_transpose_item(P.w_out, DM, DM, WoutT, scr, r, lane); continue; } r -= I_OUT;
        p0_transpose_item(P.peer_wq, DM, NQ, WqT, scr, r, lane, P.norm_ffn_g);
    }
    p0_convert(P.peer_subkeys, (bf16*)(P.ws + WS_SK), (size_t)16 * 128 * 128 / 8, gw, ngw, lane);
#ifndef TABLES_IN_P1
    p0_i4_rows(P.peer_u, P.norm_ffn_g, P.ws + WS_U, (unsigned short*)(P.ws + WS_SC), gw, ngw, lane);
    p0_fp4_rows(P.peer_v, P.ws + WS_U, (unsigned short*)(P.ws + WS_SC), gw, ngw, lane);
#endif
    {   bf16* HN = (bf16*)P.out; float* RMS = (float*)(P.ws + WS_RMS);
        for (int m = gw; m < MTOK; m += 2 * ngw) p0_hn_row2(P.x + (size_t)m * DM, P.x + (size_t)(m + ngw) * DM, HN + (size_t)m * DM, HN + (size_t)(m + ngw) * DM, RMS + m, RMS + m + ngw, lane); }
}
#define MFMA32(a, b, c) __builtin_amdgcn_mfma_f32_32x32x16_bf16((a), (b), (c), 0, 0, 0)
#define MFMA16(a, b, c) __builtin_amdgcn_mfma_f32_16x16x32_bf16((a), (b), (c), 0, 0, 0)
__device__ __forceinline__ float swap_max(float v) { auto rr = __builtin_amdgcn_permlane32_swap(__float_as_uint(v), __float_as_uint(v), false, false); return fmaxf(__uint_as_float(rr[0]), __uint_as_float(rr[1])); }
__device__ __forceinline__ float swap_add(float v) { auto rr = __builtin_amdgcn_permlane32_swap(__float_as_uint(v), __float_as_uint(v), false, false); return __uint_as_float(rr[0]) + __uint_as_float(rr[1]); }
__device__ __forceinline__ bf16x8 pack8(const f32x16& x, int s) {
    u32x4 p; p.x = pk2(x[8 * s], x[8 * s + 1]); p.y = pk2(x[8 * s + 2], x[8 * s + 3]); p.z = pk2(x[8 * s + 4], x[8 * s + 5]); p.w = pk2(x[8 * s + 6], x[8 * s + 7]);
    return __builtin_bit_cast(bf16x8, p);
}
constexpr float ATT_THR = 8.0f;
constexpr float ATT_NEG = -1.0e30f;

constexpr int PR = 272, PT = 320;
constexpr int AT_Q = 0, AT_KV = 256 * PR, AT_KVSZ = 64 * PR + 64 * PT;
static_assert(AT_KV + 2 * AT_KVSZ <= LDS_MAIN, "attention LDS");
__device__ __forceinline__ void attn_unit(const bf16* PROJ, bf16* Y, const float* subln_g, float lam, int b, int h, int qb, LAS unsigned char* lds) {
    int tid = threadIdx.x; asm volatile("" : "+v"(tid));
    const int lane = tid & 63, r32 = lane & 31, hi = lane >> 5;
    const int w = __builtin_amdgcn_readfirstlane(tid >> 6);
    const size_t rowbase = (size_t)b * SEQ;
    const float slope2 = exp2f(-2.f * (float)(h + 1)) * LOG2E;
    const int srow = tid >> 4, sch = tid & 15;
    const char* gbase = (const char*)(PROJ + rowbase * NIN + h * 128);
    const unsigned soff = (unsigned)(srow * NIN + sch * 8) * 2u;
    {   const char* qb_ = gbase + ((size_t)qb * 256 * NIN + C_DQ) * 2;
#pragma unroll
        for (int i = 0; i < 8; ++i) { const int row = srow + 32 * i; const u32x4 v = *(const u32x4*)(qb_ + (soff + (unsigned)(32 * i * NIN * 2))); *(LAS u32x4*)(lds + AT_Q + row * PR + sch * 16) = v; } }
    u32x4 sk[2], sv[2];
#define A_LOAD(j) do { const char* kb_ = gbase + ((size_t)(64 * (j)) * NIN + C_DK) * 2; const char* vb_ = gbase + ((size_t)(64 * (j)) * NIN + C_DV) * 2; \
        _Pragma("unroll") for (int i_ = 0; i_ < 2; ++i_) { sk[i_] = *(const u32x4*)(kb_ + (soff + (unsigned)(32 * i_ * NIN * 2))); sv[i_] = *(const u32x4*)(vb_ + (soff + (unsigned)(32 * i_ * NIN * 2))); } } while (0)
#define A_STORE(buf) do { _Pragma("unroll") for (int i_ = 0; i_ < 2; ++i_) { \
        *(LAS u32x4*)(lds + AT_KV + (buf) * AT_KVSZ + (srow + 32 * i_) * PR + sch * 16) = sk[i_]; *(LAS u32x4*)(lds + AT_KV + (buf) * AT_KVSZ + 64 * PR + (srow + 32 * i_) * PT + sch * 16) = sv[i_]; } } while (0)
    const int nt = 4 * qb + 4, jd = 4 * qb + (w >> 1);
    const int qpos = qb * 256 + 32 * w + r32;
    unsigned qbase = AT_Q + (32 * w + r32) * PR + hi * 16, kbase = r32 * PR + hi * 16;
    unsigned vbase = 64 * PR + (4 * hi + ((lane & 15) >> 2)) * PT + ((lane >> 4) & 1) * 32 + (lane & 3) * 8;
    f32x16 O1[4], O2[4];
#pragma unroll
    for (int c = 0; c < 4; ++c)
#pragma unroll
        for (int r = 0; r < 16; ++r) { O1[c][r] = 0.f; O2[c][r] = 0.f; }
    float mref[2] = {0.f, 0.f}, lsum[2] = {0.f, 0.f};
    bool started = false;
    A_LOAD(nt - 1); A_STORE(0); if (nt > 1) A_LOAD(nt - 2);
    __syncthreads();
    for (int it = 0; it < nt; ++it) {
        const int j = nt - 1 - it, cur = it & 1;
        asm volatile("" : "+v"(qbase), "+v"(kbase), "+v"(vbase));
        if (it + 1 < nt) A_STORE(cur ^ 1);
        if (it + 2 < nt) A_LOAD(j - 2);
        if (j <= jd) {
            const unsigned kvo = AT_KV + cur * AT_KVSZ;
            for (int kb = 1; kb >= 0; --kb) {
                const bool diag = (j == jd);
                if (diag && kb > (w & 1)) continue;
                const bool domask = diag && kb == (w & 1);
                bf16x8 Pb[2][2];
#pragma unroll
                for (int p = 0; p < 2; ++p) {
                    f32x16 S;
                    const float tb = slope2 * (float)(64 * j + 32 * kb - qpos + 4 * hi) - mref[p];
#pragma unroll
                    for (int r = 0; r < 16; ++r) S[r] = tb + slope2 * (float)((r & 3) + 8 * (r >> 2));
#pragma unroll
                    for (int ks = 0; ks < 4; ++ks) {
                        const bf16x8 qf = *(const LAS bf16x8*)(lds + qbase + (8 * p + 2 * ks) * 16);
                        const bf16x8 kf = *(const LAS bf16x8*)(lds + (kbase + kvo + kb * (32 * PR)) + (8 * p + 2 * ks) * 16);
                        S = MFMA32(kf, qf, S);
                    }
                    if (domask) {
#pragma unroll
                        for (int r = 0; r < 16; ++r) { const int kv = (r & 3) + 8 * (r >> 2) + 4 * hi; if (kv > r32) S[r] = ATT_NEG; } }
                    float rm = fmaxf(S[0], S[1]);
#pragma unroll
                    for (int r = 2; r < 16; ++r) rm = fmaxf(rm, S[r]);
                    rm = swap_max(rm);
                    if (!started) {
                        mref[p] = rm;
#pragma unroll
                        for (int r = 0; r < 16; ++r) S[r] -= rm;
                    } else if (__any(rm > ATT_THR)) {
                        const float dl = fmaxf(rm, 0.f); mref[p] += dl;
#pragma unroll
                        for (int r = 0; r < 16; ++r) S[r] -= dl;
                        const float f = exp2f(-dl); lsum[p] *= f;
                        if (p == 0) {
#pragma unroll
                            for (int c = 0; c < 4; ++c) O1[c] = O1[c] * f;
                        } else {
#pragma unroll
                            for (int c = 0; c < 4; ++c) O2[c] = O2[c] * f;
                        }
                    }
                    float ls = 0.f;
#pragma unroll
                    for (int r = 0; r < 16; ++r) { S[r] = __builtin_amdgcn_exp2f(S[r]); ls += S[r]; }
                    lsum[p] += ls;
                    Pb[p][0] = pack8(S, 0); Pb[p][1] = pack8(S, 1);
                }
                started = true;
#pragma unroll
                for (int c = 0; c < 4; ++c)
#pragma unroll
                    for (int ss = 0; ss < 2; ++ss) {
                        const LAS char* vp = (const LAS char*)lds + (vbase + kvo + kb * (32 * PT));
                        const bf16x8 vf = cat8(lds_tr(vp + ((16 * ss) * PT + c * 64)), lds_tr(vp + ((16 * ss + 8) * PT + c * 64)));
                        O1[c] = MFMA32(vf, Pb[0][ss], O1[c]); O2[c] = MFMA32(vf, Pb[1][ss], O2[c]);
                    }
            }
        }
        __syncthreads();
    }
#undef A_LOAD
#undef A_STORE
    const float inv1 = 1.0f / swap_add(lsum[0]), inv2 = lam / swap_add(lsum[1]);
    float ss = 0.f;
#pragma unroll
    for (int c = 0; c < 4; ++c)
#pragma unroll
        for (int r = 0; r < 16; ++r) { const float o = O1[c][r] * inv1 - O2[c][r] * inv2; O1[c][r] = o; ss += o * o; }
    ss = swap_add(ss);
    const float rstd = (1.0f / sqrtf(ss * (1.0f / 128.f) + RMS_EPS)) * 0.8f;
    __syncthreads();
#pragma unroll
    for (int c = 0; c < 4; ++c)
#pragma unroll
        for (int g4 = 0; g4 < 4; ++g4) { u32x2 o; o.x = pk2(O1[c][4 * g4] * rstd, O1[c][4 * g4 + 1] * rstd); o.y = pk2(O1[c][4 * g4 + 2] * rstd, O1[c][4 * g4 + 3] * rstd);
            *(LAS u32x2*)(lds + AT_Q + (32 * w + r32) * PR + (32 * c + 8 * g4 + 4 * hi) * 2) = o; }
    {   const int ch = lane & 15, rr = lane >> 4;
        const f32x4 ga = *(const f32x4*)(subln_g + 8 * ch), gb = *(const f32x4*)(subln_g + 8 * ch + 4);
        bf16* yb = Y + (rowbase + (size_t)qb * 256 + 32 * w + rr) * DM + 512 + h * 128 + 8 * ch;
#pragma unroll
        for (int i = 0; i < 8; ++i) { const u32x4 ov = *(const LAS u32x4*)(lds + AT_Q + (32 * w + 4 * i + rr) * PR + ch * 16); u32x4 o;
            o.x = pk2(bf_lo(ov.x) * ga[0], bf_hi(ov.x) * ga[1]); o.y = pk2(bf_lo(ov.y) * ga[2], bf_hi(ov.y) * ga[3]); o.z = pk2(bf_lo(ov.z) * gb[0], bf_hi(ov.z) * gb[1]); o.w = pk2(bf_lo(ov.w) * gb[2], bf_hi(ov.w) * gb[3]);
            *(u32x4*)(yb + (size_t)(4 * i) * DM) = o; }
    }
    __syncthreads();
}

constexpr int RT_P = 0, RT_K = 128 * PR, RT_V = 2 * 128 * PR, RT_ST = 2 * 128 * PR + 128 * PT;
static_assert(RT_ST + 128 * PR <= LDS_MAIN, "retention LDS");
__device__ __forceinline__ u32x4 scale8(u32x4 v, float f) { u32x4 o; o.x = pk2(bf_lo(v.x) * f, bf_hi(v.x) * f); o.y = pk2(bf_lo(v.y) * f, bf_hi(v.y) * f); o.z = pk2(bf_lo(v.z) * f, bf_hi(v.z) * f); o.w = pk2(bf_lo(v.w) * f, bf_hi(v.w) * f); return o; }
__device__ __forceinline__ void ret_unit(const bf16* PROJ, bf16* Y, int b, int h, LAS unsigned char* lds) {
    int tid = threadIdx.x; asm volatile("" : "+v"(tid));
    const int lane = tid & 63, l15 = lane & 15, g = lane >> 4;
    const int w = __builtin_amdgcn_readfirstlane(tid >> 6);
    const size_t rowbase = (size_t)b * SEQ;
    const float gam = 1.0f - exp2f(-5.f - (float)h), lg = log2f(gam), cdec = exp2f(128.f * lg), g127 = exp2f(127.f * lg);
    const int srow = tid >> 4, sch = tid & 15;
    const char* gbase = (const char*)(PROJ + rowbase * NIN + h * 128);
    const unsigned soff = (unsigned)(srow * NIN + sch * 8) * 2u;
    const unsigned qoff = (unsigned)((16 * w + l15) * NIN + C_RQ + 8 * g) * 2u;
    const unsigned toff = (unsigned)((16 * w + (lane >> 4)) * NIN + C_RG + 8 * l15) * 2u;
    const float qscale = exp2f(lg * (float)(16 * w + l15));
    u32x4 sk[4], sv[4];
#define R_LOAD(n) do { const char* kb_ = gbase + ((size_t)(128 * (n)) * NIN + C_RK) * 2; const char* vb_ = gbase + ((size_t)(128 * (n)) * NIN + C_RV) * 2; \
        _Pragma("unroll") for (int i_ = 0; i_ < 4; ++i_) { sk[i_] = *(const u32x4*)(kb_ + (soff + (unsigned)(32 * i_ * NIN * 2))); sv[i_] = *(const u32x4*)(vb_ + (soff + (unsigned)(32 * i_ * NIN * 2))); } } while (0)
#define R_STORE() do { _Pragma("unroll") for (int i_ = 0; i_ < 4; ++i_) { const int row_ = srow + 32 * i_; \
        *(LAS u32x4*)(lds + RT_K + row_ * PR + sch * 16) = scale8(sk[i_], exp2f(-lg * (float)row_)); *(LAS u32x4*)(lds + RT_V + row_ * PT + sch * 16) = sv[i_]; } } while (0)
#define Q_LOAD(n) do { const char* qb_ = gbase + (size_t)(128 * (n)) * NIN * 2; _Pragma("unroll") for (int s_ = 0; s_ < 4; ++s_) qraw[s_] = *(const u32x4*)(qb_ + (qoff + 64u * s_)); } while (0)
    f32x4 Sacc[8];
#pragma unroll
    for (int c = 0; c < 8; ++c) Sacc[c] = (f32x4){0.f, 0.f, 0.f, 0.f};
    {   unsigned z0 = 0u; asm volatile("" : "+v"(z0));
        for (int i = tid; i < 128 * PR / 16; i += 512) *(LAS u32x4*)(lds + RT_ST + i * 16) = (u32x4){z0, z0, z0, z0}; }
    u32x4 qraw[4];
    R_LOAD(0); Q_LOAD(0); R_STORE();
    __syncthreads();
    const int tq = (lane & 15) >> 2, tp = lane & 3;
    unsigned b_k = RT_K + l15 * PR + g * 16;
    unsigned b_p = RT_P + (16 * w + l15) * PR + g * 16;
    unsigned b_pw = RT_P + (16 * w + l15) * PR + g * 8;
    unsigned b_kt = RT_K + (8 * g + tq) * PR + tp * 8 + w * 32;
    unsigned b_vt = RT_V + (8 * g + tq) * PT + tp * 8;
    unsigned b_st = RT_ST + l15 * PR + g * 16;
    unsigned b_sw = RT_ST + l15 * PR + (16 * w + 4 * g) * 2;
    for (int n = 0; n < SEQ / 128; ++n) {
        asm volatile("" : "+v"(b_k), "+v"(b_p), "+v"(b_pw), "+v"(b_kt), "+v"(b_vt), "+v"(b_st), "+v"(b_sw));
        bf16x8 Qf[4], Pf[4], KTf[4];
#pragma unroll
        for (int s = 0; s < 4; ++s) Qf[s] = __builtin_bit_cast(bf16x8, scale8(qraw[s], qscale));
        u32x4 rgv[4];
        {   const char* rgb_ = gbase + (size_t)(128 * n) * NIN * 2;
#pragma unroll
            for (int i = 0; i < 4; ++i) rgv[i] = *(const u32x4*)(rgb_ + (toff + (unsigned)(4 * i * NIN * 2))); }
        if (n + 1 < SEQ / 128) { Q_LOAD(n + 1); R_LOAD(n + 1); }
#pragma unroll
        for (int jb = 0; jb < 8; ++jb) {
            f32x4 a = (f32x4){0.f, 0.f, 0.f, 0.f};
#pragma unroll
            for (int s = 0; s < 4; ++s) { const bf16x8 kf = *(const LAS bf16x8*)(lds + (b_k + jb * (16 * PR) + s * 64)); a = MFMA16(kf, Qf[s], a); }
            const int ii = 16 * w + l15, jj = 16 * jb + 4 * g;
            u32x2 pw; pw.x = pk2(jj <= ii ? a[0] : 0.f, jj + 1 <= ii ? a[1] : 0.f); pw.y = pk2(jj + 2 <= ii ? a[2] : 0.f, jj + 3 <= ii ? a[3] : 0.f);
            *(LAS u32x2*)(lds + (b_pw + jb * 32)) = pw;
        }
#pragma unroll
        for (int s = 0; s < 4; ++s) { Pf[s] = *(const LAS bf16x8*)(lds + (b_p + s * 64));
            KTf[s] = cat8(lds_tr((const LAS char*)lds + (b_kt + (32 * s) * PR)), lds_tr((const LAS char*)lds + (b_kt + (32 * s + 4) * PR))); }
        f32x4 OT[8];
#pragma unroll
        for (int c = 0; c < 8; ++c) {
            f32x4 o = (f32x4){0.f, 0.f, 0.f, 0.f}, t4 = (f32x4){0.f, 0.f, 0.f, 0.f};
#pragma unroll
            for (int s = 0; s < 4; ++s) {
                const bf16x8 vf = cat8(lds_tr((const LAS char*)lds + (b_vt + (32 * s) * PT + c * 32)), lds_tr((const LAS char*)lds + (b_vt + (32 * s + 4) * PT + c * 32)));
                const bf16x8 stf = *(const LAS bf16x8*)(lds + (b_st + c * (16 * PR) + s * 64));
                o = MFMA16(stf, Qf[s], o); o = MFMA16(vf, Pf[s], o); t4 = MFMA16(KTf[s], vf, t4);
            }
            OT[c] = o; Sacc[c] = Sacc[c] * cdec + t4 * g127;
            __builtin_amdgcn_sched_barrier(0);
        }
        float ss = 0.f;
#pragma unroll
        for (int c = 0; c < 8; ++c) ss += (OT[c][0] * OT[c][0] + OT[c][1] * OT[c][1]) + (OT[c][2] * OT[c][2] + OT[c][3] * OT[c][3]);
        ss += __shfl_xor(ss, 16); ss += __shfl_xor(ss, 32);
        const float rstd = __builtin_amdgcn_rsqf(ss * (1.0f / 128.f) + RMS_EPS);
#pragma unroll
        for (int c = 0; c < 8; ++c) { u32x2 o; o.x = pk2(OT[c][0] * rstd, OT[c][1] * rstd); o.y = pk2(OT[c][2] * rstd, OT[c][3] * rstd); *(LAS u32x2*)(lds + (b_pw + c * 32)) = o; }
        char* yb = (char*)(Y + (rowbase + (size_t)n * 128) * DM + h * 128); const unsigned yoff = (unsigned)((16 * w + (lane >> 4)) * DM + 8 * l15) * 2u;
        const unsigned b_or = RT_P + (16 * w + (lane >> 4)) * PR + l15 * 16;
#pragma unroll
        for (int i = 0; i < 4; ++i) { const u32x4 ov = *(const LAS u32x4*)(lds + (b_or + i * (4 * PR))); const u32x4 rg = rgv[i]; u32x4 o;
#pragma unroll
            for (int q = 0; q < 4; ++q) { const float r0 = bf_lo(rg[q]), r1 = bf_hi(rg[q]);
                const float s0 = r0 * __builtin_amdgcn_rcpf(1.f + __expf(-r0)), s1 = r1 * __builtin_amdgcn_rcpf(1.f + __expf(-r1));
                o[q] = pk2(bf_lo(ov[q]) * s0, bf_hi(ov[q]) * s1); }
            *(u32x4*)(yb + (yoff + (unsigned)(4 * i * DM * 2))) = o; }
        __syncthreads();
#pragma unroll
        for (int c = 0; c < 8; ++c) { u32x2 o; o.x = pk2(Sacc[c][0] * gam, Sacc[c][1] * gam); o.y = pk2(Sacc[c][2] * gam, Sacc[c][3] * gam);
            *(LAS u32x2*)(lds + (b_sw + c * (16 * PR))) = o; }
        if (n + 1 < SEQ / 128) R_STORE();
        __syncthreads();
    }
#undef R_LOAD
#undef R_STORE
#undef Q_LOAD
}

constexpr int P2_NRET = BATCH * 4, P2_NATT = BATCH * 4 * 8, P2_NITEMS = P2_NRET + P2_NATT;
__device__ __forceinline__ void p2_mixers(const Params& P, LAS unsigned char* lds) {
    const int tid = threadIdx.x;
    unsigned* ctl = (unsigned*)(P.ws + WS_CTL);
    volatile LAS int* lctl = (volatile LAS int*)(lds + LDS_MAIN);
    const bf16* PROJ = (const bf16*)(P.ws + WS_PROJ); bf16* Y = (bf16*)(P.ws + WS_H);
    float d1 = 0.f, d2 = 0.f;
    for (int i = 0; i < 64; ++i) { d1 += P.diff_lambda[i] * P.diff_lambda[64 + i]; d2 += P.diff_lambda[128 + i] * P.diff_lambda[192 + i]; }
    const float lam = expf(d1) - expf(d2) + 0.2f;
    for (;;) {
        if (tid == 0) lctl[0] = (int)atomicAdd(ctl + CW_QUEUE, 1u);
        __syncthreads();
        const int item = __builtin_amdgcn_readfirstlane(lctl[0]);
        __syncthreads();
        if (item >= P2_NITEMS) break;
        if (item < P2_NRET) ret_unit(PROJ, Y, item >> 2, item & 3, lds);
        else { const int idx = item - P2_NRET; attn_unit(PROJ, Y, P.diff_subln_g, lam, (idx & 63) >> 2, idx & 3, 7 - (idx >> 6), lds); }
    }
}
#define XB_TMO      128
#define XB_XCNT(j)  (256  + 64 * (j))
#define XB_XSUB(j)  (1280 + 64 * (j))
#define XB_XGEN(j)  (2304 + 64 * (j))
#define XB_TOP      3328
#define XB_TOPGEN   3392
#define XCD_BAR_WORDS 3456
#define XB_SPIN_CAP (1u << 18)

__device__ __forceinline__ unsigned xb_ld(unsigned* p)              { return __hip_atomic_load(p, __ATOMIC_RELAXED, __HIP_MEMORY_SCOPE_AGENT); }
__device__ __forceinline__ unsigned xb_add(unsigned* p, unsigned v) { return __hip_atomic_fetch_add(p, v, __ATOMIC_RELAXED, __HIP_MEMORY_SCOPE_AGENT); }
__device__ __forceinline__ unsigned xb_xcc_id() { return (unsigned)__builtin_amdgcn_s_getreg((3 << 11) | 20) & 0xFu; }
#define XB_SPIN(cond, bar) do { unsigned _sp = 0; while (cond) { __builtin_amdgcn_s_sleep(1); \
    if ((++_sp & 255u) == 0u) { if (xb_ld(&(bar)[XB_TMO])) break; if (_sp > XB_SPIN_CAP) { atomicAdd(&(bar)[XB_TMO], 1u); break; } } } } while (0)

struct XcdBarrier {
    unsigned* bar; unsigned x;
    volatile LAS unsigned* st;
};

__device__ __forceinline__ XcdBarrier xcd_barrier_post(unsigned* bar, volatile LAS unsigned* st) {
    XcdBarrier b; b.bar = bar; b.x = xb_xcc_id(); b.st = st;
    if (threadIdx.x == 0) (void)xb_add(&bar[XB_XCNT(b.x)], 1u);
    return b;
}
__device__ __forceinline__ void xcd_barrier_complete(unsigned* bar, unsigned x, unsigned& nloc, unsigned& nx) {
    const unsigned G = gridDim.x * gridDim.y * gridDim.z;
    unsigned sum, cnt, mine, sp = 0u;
    for (;;) {
        sum = 0u; cnt = 0u; mine = 0u;
#pragma unroll
        for (unsigned j = 0; j < 16; ++j) { const unsigned c = xb_ld(&bar[XB_XCNT(j)]); sum += c; cnt += (c > 0u) ? 1u : 0u; mine = (j == x) ? c : mine; }
        if (sum == G) break;
        __builtin_amdgcn_s_sleep(1);
        if ((++sp & 255u) == 0u) { if (xb_ld(&bar[XB_TMO])) break; if (sp > XB_SPIN_CAP) { atomicAdd(&bar[XB_TMO], 1u); break; } }
    }
    nloc = mine > 0u ? mine : 1u; nx = cnt > 0u ? cnt : 1u;
}

__device__ __forceinline__ void xcd_barrier(const XcdBarrier& b) {
    asm volatile("s_waitcnt vmcnt(0)" ::: "memory");
    __syncthreads();
    if (threadIdx.x == 0) {
        unsigned* bar = b.bar;
        __builtin_amdgcn_s_waitcnt(0);
        unsigned nloc = b.st[0], nx = b.st[1];
        if (nloc == 0u) { xcd_barrier_complete(bar, b.x, nloc, nx); b.st[0] = nloc; b.st[1] = nx; }
        const unsigned old = xb_add(&bar[XB_XSUB(b.x)], 1u);
        const unsigned gen = old / nloc;
        if (old + 1u == (gen + 1u) * nloc) {
            __builtin_amdgcn_fence(__ATOMIC_RELEASE, "agent");
            asm volatile("s_waitcnt vmcnt(0)" ::: "memory");
            const unsigned og = xb_add(&bar[XB_TOP], 1u);
            const unsigned tg = og / nx;
            if (og + 1u == (tg + 1u) * nx) xb_add(&bar[XB_TOPGEN], 1u);
            else XB_SPIN(xb_ld(&bar[XB_TOPGEN]) == tg, bar);
            __builtin_amdgcn_fence(__ATOMIC_ACQUIRE, "agent");
            xb_add(&bar[XB_XGEN(b.x)], 1u);
            asm volatile("s_waitcnt vmcnt(0)" ::: "memory");
        } else {
            XB_SPIN(xb_ld(&bar[XB_XGEN(b.x)]) == gen, bar);
            __builtin_amdgcn_fence(__ATOMIC_ACQUIRE, "agent");
            asm volatile("s_waitcnt vmcnt(0)" ::: "memory");
        }
    }
    __syncthreads();
}
__device__ __forceinline__ int ord_key(float s) { return __float_as_int(s); }
__device__ __forceinline__ float ord_val(int k) { return __int_as_float(k); }
__device__ __forceinline__ int imax(int a, int b) { int r; asm("v_max_f32 %0, %1, %2" : "=v"(r) : "v"(a), "v"(b)); return r; }
__device__ __forceinline__ int imin(int a, int b) { int r; asm("v_min_f32 %0, %1, %2" : "=v"(r) : "v"(a), "v"(b)); return r; }
__device__ __forceinline__ void merge_halves16(int (&L)[16]) {
    int c[16];
#pragma unroll
    for (int i = 0; i < 8; ++i) {
        auto r0 = __builtin_amdgcn_permlane32_swap((unsigned)L[i], (unsigned)L[15 - i], false, false);
        auto r1 = __builtin_amdgcn_permlane32_swap((unsigned)L[15 - i], (unsigned)L[i], false, false);
        const bool hi = (threadIdx.x & 32) != 0;
        const int pa_i = hi ? (int)r1[0] : (int)r0[1], pa_15i = hi ? (int)r0[0] : (int)r1[1];
        c[i] = imax(L[i], pa_15i); c[15 - i] = imax(L[15 - i], pa_i);
    }
#define BSTAGE(d) _Pragma("unroll") for (int i = 0; i < 16; ++i) if ((i & (d)) == 0) { const int a = c[i], b = c[i + (d)]; c[i] = imax(a, b); c[i + (d)] = imin(a, b); }
    BSTAGE(8) BSTAGE(4) BSTAGE(2) BSTAGE(1)
#undef BSTAGE
#pragma unroll
    for (int i = 0; i < 16; ++i) L[i] = c[i];
}

#define CEX(v, a, b) do { const int x_ = v[a], y_ = v[b]; v[a] = imax(x_, y_); v[b] = imin(x_, y_); } while (0)
#define SORT16_DESC(v) do { \
    CEX(v,0,13); CEX(v,1,12); CEX(v,2,15); CEX(v,3,14); CEX(v,4,8); CEX(v,5,6); CEX(v,7,11); CEX(v,9,10); \
    CEX(v,0,5); CEX(v,1,7); CEX(v,2,9); CEX(v,3,4); CEX(v,6,13); CEX(v,8,14); CEX(v,10,15); CEX(v,11,12); \
    CEX(v,0,1); CEX(v,2,3); CEX(v,4,5); CEX(v,6,8); CEX(v,7,9); CEX(v,10,11); CEX(v,12,13); CEX(v,14,15); \
    CEX(v,0,2); CEX(v,1,3); CEX(v,4,10); CEX(v,5,11); CEX(v,6,7); CEX(v,8,9); CEX(v,12,14); CEX(v,13,15); \
    CEX(v,1,2); CEX(v,3,12); CEX(v,4,6); CEX(v,5,7); CEX(v,8,10); CEX(v,9,11); CEX(v,13,14); \
    CEX(v,1,4); CEX(v,2,6); CEX(v,5,8); CEX(v,7,10); CEX(v,9,13); CEX(v,11,14); \
    CEX(v,2,4); CEX(v,3,6); CEX(v,9,12); CEX(v,11,13); \
    CEX(v,3,5); CEX(v,6,8); CEX(v,7,9); CEX(v,10,12); \
    CEX(v,3,4); CEX(v,5,6); CEX(v,7,8); CEX(v,9,10); CEX(v,11,12); \
    CEX(v,6,7); CEX(v,8,9); } while (0)
#define TOP16_MERGE(A, B) do { _Pragma("unroll") for (int i_ = 0; i_ < 16; ++i_) A[i_] = imax(A[i_], B[15 - i_]); \
    _Pragma("unroll") for (int d_ = 8; d_ >= 1; d_ >>= 1) { _Pragma("unroll") for (int i_ = 0; i_ < 16; ++i_) if ((i_ & d_) == 0) CEX(A, i_, i_ + d_); } } while (0)
__device__ __forceinline__ void p5_scores(const Params& P, LAS unsigned char* lds) {
    int tid = threadIdx.x; asm volatile("" : "+v"(tid));
    const int lane = tid & 63, r32 = lane & 31, hi = lane >> 5;
    const int w = __builtin_amdgcn_readfirstlane(tid >> 6), tg = w >> 1, ph = w & 1;
    const int tok0 = blockIdx.x * 128;
    const bf16* SKb = (const bf16*)(P.ws + WS_SK); const bf16* Qb = (const bf16*)(P.ws + WS_Q);
    u32x2* ENT = (u32x2*)(P.ws + WS_H); const unsigned* SC = (const unsigned*)(P.ws + WS_SC);
    LAS int* lists = (LAS int*)(lds + 131072);
    u32x4 st[8];
#define S_LOAD(h) do { _Pragma("unroll") for (int i_ = 0; i_ < 8; ++i_) { const int n_ = tid + 512 * i_; st[i_] = *(const u32x4*)(SKb + ((size_t)(h) * 256 + (n_ >> 4)) * 128 + (n_ & 15) * 8); } } while (0)
#define S_STORE(buf) do { _Pragma("unroll") for (int i_ = 0; i_ < 8; ++i_) { const int n_ = tid + 512 * i_; *(LAS u32x4*)(lds + (buf) * 65536 + (n_ >> 11) * 32768 + off_b((n_ >> 4) & 127, n_ & 15)) = st[i_]; } } while (0)
    S_LOAD(0); S_STORE(0); S_LOAD(1);
    const bf16* qrow0 = Qb + (size_t)(tok0 + 32 * tg + r32) * NQ + ph * 128 + 8 * hi;
    bf16x8 qf[8];
#pragma unroll
    for (int ks = 0; ks < 8; ++ks) qf[ks] = *(const bf16x8*)(qrow0 + 16 * ks);
    __syncthreads();
    for (int h = 0; h < 8; ++h) {
        const int cur = h & 1;
        int L[16];
        {
            f32x16 acc[4];
#pragma unroll
            for (int kb = 0; kb < 4; ++kb)
#pragma unroll
                for (int r = 0; r < 16; ++r) acc[kb][r] = 0.f;
            const LAS unsigned char* SKl = lds + cur * 65536 + ph * 32768;
#pragma unroll
            for (int ks = 0; ks < 8; ++ks)
#pragma unroll
                for (int kb = 0; kb < 4; ++kb) { const bf16x8 a = *(const LAS bf16x8*)(SKl + off_b(32 * kb + r32, 2 * ks + hi)); acc[kb] = MFMA32(a, qf[ks], acc[kb]); }
            asm volatile("" : "+v"(acc[0]), "+v"(acc[1]), "+v"(acc[2]), "+v"(acc[3]));
            {   const bf16* qn = qrow0 + ((h + 1) & 7) * 256;
#pragma unroll
                for (int ks = 0; ks < 8; ++ks) qf[ks] = *(const bf16x8*)(qn + 16 * ks); }
            int Kw[4][16];
#pragma unroll
            for (int kb = 0; kb < 4; ++kb) {
#pragma unroll
                for (int r = 0; r < 16; ++r) Kw[kb][r] = (ord_key(acc[kb][r]) & ~127) | (32 * kb + (r & 3) + 8 * (r >> 2) + 4 * hi);
                SORT16_DESC(Kw[kb]); }
            TOP16_MERGE(Kw[0], Kw[1]); TOP16_MERGE(Kw[2], Kw[3]); TOP16_MERGE(Kw[0], Kw[2]);
#pragma unroll
            for (int i = 0; i < 16; ++i) L[i] = Kw[0][i];
        }
        merge_halves16(L);
        if (hi == 0) { LAS int* lp = lists + ((tg * 2 + ph) * 32 + r32) * 16;
#pragma unroll
            for (int i = 0; i < 4; ++i) *(LAS u32x4*)(lp + 4 * i) = (u32x4){(unsigned)L[4 * i], (unsigned)L[4 * i + 1], (unsigned)L[4 * i + 2], (unsigned)L[4 * i + 3]}; }
        if (h + 1 < 8) { S_STORE(cur ^ 1); if (h + 2 < 8) S_LOAD(h + 2); }
        __syncthreads();
        if (ph == 0) {
            const LAS int* la = lists + ((tg * 2 + 0) * 32 + r32) * 16; const LAS int* lb = lists + ((tg * 2 + 1) * 32 + r32) * 16;
            float A[16], B[16];
            {   int bl[16];
#pragma unroll
                for (int i = 0; i < 4; ++i) { const u32x4 v = *(const LAS u32x4*)(lb + 4 * i); bl[4 * i] = (int)v.x; bl[4 * i + 1] = (int)v.y; bl[4 * i + 2] = (int)v.z; bl[4 * i + 3] = (int)v.w; }
#pragma unroll
                for (int i = 0; i < 16; ++i) { const float av = ord_val(L[i] & ~127), bv = ord_val(bl[i] & ~127); A[i] = hi ? bv : av; B[i] = hi ? av : bv; } }
            int C[16], T10[10];
#define CWORD(i, j) (((ord_key(A[i] + B[j])) & ~255) | (hi ? ((j) * 16 + (i)) : ((i) * 16 + (j))))
#pragma unroll
            for (int j = 1; j < 16; ++j) C[j - 1] = CWORD(0, j);
            C[15] = (int)0xff800000;
#pragma unroll
            for (int j = 2; j < 8; ++j) T10[j - 2] = CWORD(1, j);
            T10[6] = CWORD(2, 3); T10[7] = CWORD(2, 4);
            {
                const float v0 = hi ? (A[2] + B[2]) : (A[0] + B[0]), v1 = hi ? (A[3] + B[3]) : (A[1] + B[1]);
                T10[8] = (ord_key(v0) & ~255) | (hi ? 0x22 : 0x00); T10[9] = (ord_key(v1) & ~255) | (hi ? 0x33 : 0x11); }
#undef CWORD
            CEX(T10,4,9); CEX(T10,3,8); CEX(T10,2,7); CEX(T10,1,6); CEX(T10,0,5); CEX(T10,1,4); CEX(T10,6,9); CEX(T10,0,3); CEX(T10,5,8); CEX(T10,0,2); CEX(T10,3,6); CEX(T10,7,9);
            CEX(T10,0,1); CEX(T10,2,4); CEX(T10,5,7); CEX(T10,8,9); CEX(T10,1,2); CEX(T10,4,6); CEX(T10,7,8); CEX(T10,3,5); CEX(T10,2,5); CEX(T10,6,8); CEX(T10,1,3); CEX(T10,4,7);
            CEX(T10,2,3); CEX(T10,6,7); CEX(T10,3,4); CEX(T10,5,6); CEX(T10,4,5);
#pragma unroll
            for (int i = 6; i < 16; ++i) C[i] = imax(C[i], T10[15 - i]);
#pragma unroll
            for (int d_ = 8; d_ >= 1; d_ >>= 1) {
#pragma unroll
                for (int i = 0; i < 16; ++i) if ((i & d_) == 0) CEX(C, i, i + d_); }
            merge_halves16(C);
            float gsum = 0.f, e[16];
            const float vmax = ord_val(C[0] & ~255);
#pragma unroll
            for (int i = 0; i < 16; ++i) { e[i] = __expf(ord_val(C[i] & ~255) - vmax); gsum += e[i]; }
            const float ginv = 1.0f / gsum;
            u32x2* ep = ENT + (size_t)(tok0 + 32 * tg + r32) * 128 + h * 16 + hi * 8;
            int Cs[8]; float Gs[8];
#pragma unroll
            for (int i = 0; i < 8; ++i) { int c0 = C[i], c1 = C[i + 8]; float e0 = e[i], e1 = e[i + 8]; asm volatile("" : "+v"(c0), "+v"(c1), "+v"(e0), "+v"(e1)); Cs[i] = hi ? c1 : c0; Gs[i] = (hi ? e1 : e0) * ginv; }
            unsigned ee[8], scv[8];
#pragma unroll
            for (int i = 0; i < 8; ++i) { const int code = Cs[i] & 255; const int i1 = la[code >> 4] & 127, i2 = lb[code & 15] & 127; ee[i] = (unsigned)(i1 * 128 + i2); scv[i] = SC[ee[i]]; }
            asm volatile("" : "+v"(scv[0]), "+v"(scv[1]), "+v"(scv[2]), "+v"(scv[3]), "+v"(scv[4]), "+v"(scv[5]), "+v"(scv[6]), "+v"(scv[7]));
#pragma unroll
            for (int i = 0; i < 8; i += 2) {
                u32x4 o;
                o.x = ee[i] | ((scv[i] >> 16) << 17); o.y = __float_as_uint(Gs[i] * __uint_as_float(scv[i] << 16));
                o.z = ee[i + 1] | ((scv[i + 1] >> 16) << 17); o.w = __float_as_uint(Gs[i + 1] * __uint_as_float(scv[i + 1] << 16));
                *(u32x4*)(ep + i) = o;
            }
        }
        __syncthreads();
    }
#undef S_LOAD
#undef S_STORE
}
#define P6_REP(k) (32 * ((k) >> 2) + 16 * (((k) >> 1) & 1) + 8 * ((k) & 1))
__device__ __forceinline__ int dot8z(int a, int b) { int r; asm("v_dot8_i32_i4 %0, %1, %2, 0" : "=v"(r) : "v"(a), "v"(b)); return r; }
__device__ __forceinline__ float gelu_erf(float v) {
    const float av = fabsf(v), t = __builtin_amdgcn_rcpf(av * 0.2316418882f + 1.0f);
    float q = t * 0.5307027145f + (-0.7265760135f); q = q * t + 0.7107068705f; q = q * t + (-0.142248368f); q = q * t + 0.127414796f; q = q * t;
    const float m = v * (q * __builtin_amdgcn_exp2f((v * v) * (-0.72134752044f)));
    return v < 0.f ? m : v - m;
}
__device__ __forceinline__ void p6_gather(const Params& P, LAS unsigned char* lds, int w  ) {
    int lane = (int)__builtin_amdgcn_mbcnt_hi(~0u, __builtin_amdgcn_mbcnt_lo(~0u, 0u)); asm volatile("" : "+v"(lane));
    const int tok0 = blockIdx.x * 128;
    const u32x2* ENT = (const u32x2*)(P.ws + WS_H);
    const bf16* XG = (const bf16*)(P.ws + WS_XG); const unsigned char* U8 = P.ws + WS_U;
    const float* RSS = (const float*)(P.ws + WS_RSS);
    const int kk = 4 * (lane >> 5) + 2 * ((lane >> 4) & 1) + ((lane >> 3) & 1);
    const unsigned xsb = (unsigned)w * 8192u + (unsigned)lane * 16u;
    const unsigned ssb = 65536u + (unsigned)w * 8192u;
    const unsigned ska = ssb + (unsigned)kk * 8u;
    const unsigned rowoff = 16u * (unsigned)lane;
    for (int r = 0; r < 2; ++r) {
        float rstd[8];
#pragma unroll
        for (int t = 0; t < 8; ++t) {
            const size_t tok = (size_t)tok0 + 64 * r + 8 * w + t;
            const u32x4 e4 = ((const u32x4*)ENT)[tok * 64 + lane];
            float xscale;
            {
                const u32x4 xa = *(const u32x4*)(XG + tok * DM + 16 * lane), xb = *(const u32x4*)(XG + tok * DM + 16 * lane + 8); float xf[16];
#pragma unroll
                for (int j = 0; j < 4; ++j) { xf[2 * j] = bf_lo(xa[j]); xf[2 * j + 1] = bf_hi(xa[j]); xf[8 + 2 * j] = bf_lo(xb[j]); xf[8 + 2 * j + 1] = bf_hi(xb[j]); }
                float mx = 0.f;
#pragma unroll
                for (int i = 0; i < 16; ++i) mx = fmaxf(mx, fabsf(xf[i]));
                mx = wave_max_fast(mx);
                const float qs = mx > 0.f ? 119.f / mx : 1.f; u32x4 xq = {0u, 0u, 0u, 0u};
#pragma unroll
                for (int i = 0; i < 16; ++i) { const int b = (int)rintf(xf[i] * qs), hi = (b + 8) >> 4, lo = b - 16 * hi;
                    xq[i >> 3] |= ((unsigned)hi & 15u) << (4 * (i & 7)); xq[2 + (i >> 3)] |= ((unsigned)lo & 15u) << (4 * (i & 7)); }
                *(LAS u32x4*)(lds + xsb + t * 1024) = xq; xscale = mx > 0.f ? mx * (1.0f / 119.f) : 1.f; }
            const f32x4* rp = (const f32x4*)(RSS + tok * 16); const f32x4 s0 = rp[0], s1 = rp[1], s2 = rp[2], s3 = rp[3];
            const float ssq = ((s0[0] + s0[1]) + (s0[2] + s0[3])) + ((s1[0] + s1[1]) + (s1[2] + s1[3])) + ((s2[0] + s2[1]) + (s2[2] + s2[3])) + ((s3[0] + s3[1]) + (s3[2] + s3[3]));
            rstd[t] = (1.0f / sqrtf(ssq * (1.0f / DM) + RMS_EPS)) * xscale;
#ifndef SORT_BITS
#define SORT_BITS 4
#endif
            const unsigned bA = (e4.x >> (14 - SORT_BITS)) & ((1u << SORT_BITS) - 1u), bB = (e4.z >> (14 - SORT_BITS)) & ((1u << SORT_BITS) - 1u); int posA = 0, posB = 0, base = 0;
            for (int s = 0; s < (1 << SORT_BITS); ++s) {
                const unsigned long long mA = __ballot(bA == (unsigned)s), mB = __ballot(bB == (unsigned)s);
                const int cA = __popcll(mA), cB = __popcll(mB);
                const int rA = (int)__builtin_amdgcn_mbcnt_hi((unsigned)(mA >> 32), __builtin_amdgcn_mbcnt_lo((unsigned)mA, 0u));
                const int rB = (int)__builtin_amdgcn_mbcnt_hi((unsigned)(mB >> 32), __builtin_amdgcn_mbcnt_lo((unsigned)mB, 0u));
                if (bA == (unsigned)s) posA = base + rA;
                if (bB == (unsigned)s) posB = base + cA + rB;
                base += cA + cB;
            }
            *(LAS u32x2*)(lds + ssb + t * 1024 + posA * 8) = (u32x2){e4.x, e4.y}; *(LAS u32x2*)(lds + ssb + t * 1024 + posB * 8) = (u32x2){e4.z, e4.w};
        }
        f32x2 acc[8][8];
#pragma unroll
        for (int t = 0; t < 8; ++t)
#pragma unroll
            for (int i = 0; i < 8; ++i) acc[t][i] = (f32x2){0.f, 0.f};
        {   u32x4 R[2][8]; u32x2 entC[2];
#define PF_ENT(B, T) (*(const LAS u32x2*)(lds + ska + (T) * 1024 + (B) * 64))
#define PF_LD(p, k, ev) do { const unsigned ex_ = (unsigned)__builtin_amdgcn_readlane((int)(ev).x, P6_REP(k)) & 16383u; R[p][k] = *(const u32x4*)(U8 + (ex_ * 1024u + rowoff)); } while (0)
#define PF_BODY(B, T, B2, T2) do { constexpr int p_ = (T) & 1; f32x2 (&accT)[8] = acc[T]; \
            const u32x2 ent = entC[p_]; \
            const u32x2 entN = PF_ENT(B2, T2);        \
            const float suk = __uint_as_float((ent.x >> 17) << 16); \
            const u32x4 xq = *(const LAS u32x4*)(lds + xsb + (T) * 1024); \
            int d[8]; \
            _Pragma("unroll") for (int k = 0; k < 8; ++k) { const int dh_ = __builtin_amdgcn_sdot8((int)R[p_][k].x, (int)xq.x, dot8z((int)R[p_][k].y, (int)xq.y), false); \
                d[k] = __builtin_amdgcn_sdot8((int)R[p_][k].x, (int)xq.z, __builtin_amdgcn_sdot8((int)R[p_][k].y, (int)xq.w, dh_ * 16, false), false); } \
            int s4[4], t2[2]; \
            _Pragma("unroll") for (int k = 0; k < 4; ++k) { auto rr = __builtin_amdgcn_permlane32_swap((unsigned)d[k], (unsigned)d[k + 4], false, false); s4[k] = (int)rr[0] + (int)rr[1]; } \
            _Pragma("unroll") for (int k = 0; k < 2; ++k) { auto rr = __builtin_amdgcn_permlane16_swap((unsigned)s4[k], (unsigned)s4[k + 2], false, false); t2[k] = (int)rr[0] + (int)rr[1]; } \
            const bool b3 = (lane & 8) != 0; \
            const int keep = b3 ? t2[1] : t2[0], give = b3 ? t2[0] : t2[1]; \
            int di = keep + __builtin_amdgcn_update_dpp(0, give, 0x128, 0xf, 0xf, false); \
            di += __builtin_amdgcn_update_dpp(0, di, 0xB1, 0xf, 0xf, false); di += __builtin_amdgcn_update_dpp(0, di, 0x4E, 0xf, 0xf, false); di += __builtin_amdgcn_update_dpp(0, di, 0x141, 0xf, 0xf, false); \
            const float a = rstd[T] * suk * (float)di; \
            const float wv = __uint_as_float(ent.y) * gelu_erf(a);     \
            __builtin_amdgcn_sched_barrier(0); \
            _Pragma("unroll") for (int k = 0; k < 8; ++k) PF_LD(1 - p_, k, entC[1 - p_]);        \
            __builtin_amdgcn_sched_barrier(0); \
            _Pragma("unroll") for (int k = 0; k < 8; ++k) { \
                const float wk_ = __int_as_float(__builtin_amdgcn_readlane(__float_as_int(wv), P6_REP(k))); const f32x2 wk2_ = {wk_, wk_}; \
                _Pragma("unroll") for (int j = 0; j < 2; ++j) { const unsigned wv_ = R[p_][k][2 + j]; \
                    accT[4 * j] = __builtin_elementwise_fma(__builtin_amdgcn_cvt_scalef32_pk_f32_fp4(wv_, 1.0f, 0), wk2_, accT[4 * j]); accT[4 * j + 1] = __builtin_elementwise_fma(__builtin_amdgcn_cvt_scalef32_pk_f32_fp4(wv_, 1.0f, 1), wk2_, accT[4 * j + 1]); \
                    accT[4 * j + 2] = __builtin_elementwise_fma(__builtin_amdgcn_cvt_scalef32_pk_f32_fp4(wv_, 1.0f, 2), wk2_, accT[4 * j + 2]); accT[4 * j + 3] = __builtin_elementwise_fma(__builtin_amdgcn_cvt_scalef32_pk_f32_fp4(wv_, 1.0f, 3), wk2_, accT[4 * j + 3]); } \
                asm volatile("" : "+v"(accT[0]), "+v"(accT[1]), "+v"(accT[2]), "+v"(accT[3]), "+v"(accT[4]), "+v"(accT[5]), "+v"(accT[6]), "+v"(accT[7])); \
                } \
            entC[p_] = entN; \
            __builtin_amdgcn_sched_barrier(0); \
        } while (0)
            entC[0] = PF_ENT(0, 0); entC[1] = PF_ENT(0, 1);
#pragma unroll
            for (int k = 0; k < 8; ++k) PF_LD(0, k, entC[0]);
#pragma unroll 1
            for (int b = 0; b < 16; ++b) {
                PF_BODY(b, 0, b, 2); PF_BODY(b, 1, b, 3); PF_BODY(b, 2, b, 4); PF_BODY(b, 3, b, 5);
                PF_BODY(b, 4, b, 6); PF_BODY(b, 5, b, 7); PF_BODY(b, 6, (b + 1) & 15, 0); PF_BODY(b, 7, (b + 1) & 15, 1);
            }
#undef PF_ENT
#undef PF_LD
#undef PF_BODY
        }
        asm volatile("s_waitcnt vmcnt(0) lgkmcnt(0)" ::: "memory");
#pragma unroll
        for (int t = 0; t < 8; ++t) {
            const size_t tok = (size_t)tok0 + 64 * r + 8 * w + t;
            float* orow = P.out + tok * DM + 16 * lane; const float* fg = P.final_norm_g + 16 * lane;
            const u32x4 ra = __builtin_nontemporal_load((const u32x4*)(XG + tok * DM + 16 * lane)), rb = __builtin_nontemporal_load((const u32x4*)(XG + tok * DM + 16 * lane + 8));
            f32x4 xr[4]; float ss = 0.f;
            xr[0] = (f32x4){bf_lo(ra.x), bf_hi(ra.x), bf_lo(ra.y), bf_hi(ra.y)}; xr[1] = (f32x4){bf_lo(ra.z), bf_hi(ra.z), bf_lo(ra.w), bf_hi(ra.w)};
            xr[2] = (f32x4){bf_lo(rb.x), bf_hi(rb.x), bf_lo(rb.y), bf_hi(rb.y)}; xr[3] = (f32x4){bf_lo(rb.z), bf_hi(rb.z), bf_lo(rb.w), bf_hi(rb.w)};
#pragma unroll
            for (int j = 0; j < 4; ++j) { xr[j] += (f32x4){acc[t][2 * j].x, acc[t][2 * j].y, acc[t][2 * j + 1].x, acc[t][2 * j + 1].y};
                ss += (xr[j][0] * xr[j][0] + xr[j][1] * xr[j][1]) + (xr[j][2] * xr[j][2] + xr[j][3] * xr[j][3]); }
            const float rs = 1.0f / sqrtf(wave_sum_fast(ss) * (1.0f / DM) + RMS_EPS);
#pragma unroll
            for (int j = 0; j < 4; ++j) *(f32x4*)(orow + 4 * j) = xr[j] * rs * *(const f32x4*)(fg + 4 * j);
        }
    }
}
constexpr int CW_BAR = 4096;
constexpr int NPHASE = 6;
#ifdef TABLES_IN_P1
struct TableHookOrder : pg8::StaticOrder {
    const Params* P; int gw, ngw, lane; mutable int ui;
    __device__ __forceinline__ void tables() const {
        p0_i4_rows<4>(P->peer_u, P->norm_ffn_g, P->ws + WS_U, (unsigned short*)(P->ws + WS_SC), gw, ngw, lane, 0, 2);
        p0_fp4_rows<4>(P->peer_v, P->ws + WS_U, (unsigned short*)(P->ws + WS_SC), gw, ngw, lane, 0, 2);
        asm volatile("s_waitcnt vmcnt(0)" ::: "memory");
    }
    __device__ __forceinline__ void done(const pg8::Unit&) const { ++ui; if (!(c & 1) && ui == 7) tables(); }
};
#endif
__global__ void __launch_bounds__(512, 2) fwd(Params P) {
    __shared__ __attribute__((aligned(16))) unsigned char lds_raw[LDS_BYTES];
    LAS unsigned char* lds = (LAS unsigned char*)lds_raw;
    const int tid = threadIdx.x, lane = tid & 63, wave = __builtin_amdgcn_readfirstlane(tid >> 6);
    const int lo = P.ph_lo, hi = P.ph_hi, G = gridDim.x;
#define IN(k) (lo <= (k) && (k) < hi)
#define SEAM(k) do { if (IN(k) && IN((k) + 1)) { if ((k) == 2) cg::this_grid().sync(); else xcd_barrier(xbar); } } while (0)
    bf16* WinT = (bf16*)(P.ws + WS_WIN); bf16* WoutT = (bf16*)(P.ws + WS_WOUT); bf16* WqT = (bf16*)(P.ws + WS_WQ);
    bf16* Hb = (bf16*)(P.ws + WS_H); bf16* PROJ = (bf16*)(P.ws + WS_PROJ); bf16* XG = (bf16*)(P.ws + WS_XG); bf16* Qb = (bf16*)(P.ws + WS_Q);
    float* RSS = (float*)(P.ws + WS_RSS);
    if (tid < 16) ((volatile LAS unsigned*)(lds + LDS_MAIN))[tid] = 0u;
    __syncthreads();
    XcdBarrier xbar = xcd_barrier_post((unsigned*)(P.ws + WS_CTL) + CW_BAR, (volatile LAS unsigned*)(lds + LDS_MAIN + 32));

    if (IN(0)) { p0_prologue(P, lds, wave, lane);
        SEAM(0); }
    if (IN(1)) {
#ifdef TABLES_IN_P1
        pg8::Gemm g{(const bf16*)P.out  , WinT, MTOK, NIN, DM}; TableHookOrder S; S.init(MTOK, NIN, G, (int)blockIdx.x); S.P = &P; S.gw = (int)blockIdx.x * 8 + wave; S.ngw = G * 8; S.lane = lane; S.ui = 0;
        if (blockIdx.x & 1) S.tables();
#else
        pg8::Gemm g{(const bf16*)P.out  , WinT, MTOK, NIN, DM}; pg8::StaticOrder S; S.init(MTOK, NIN, G, (int)blockIdx.x);
#endif
        pg8::EpiProj E{PROJ};
#ifdef TABLES_IN_P1
        pg8::gemm_phase<pg8::EpiProj, TableHookOrder, true, true>(lds, g, S, E);
#else
        pg8::gemm_phase<pg8::EpiProj, pg8::StaticOrder, true, true>(lds, g, S, E);
#endif
        SEAM(1);
    }
    if (IN(2)) { p2_mixers(P, lds); SEAM(2); }
    if (IN(3)) {
        pg8::Gemm g{Hb  , WoutT, MTOK, DM, DM}; pg8::StaticOrder S; S.init(MTOK, DM, G, (int)blockIdx.x);
        pg8::EpiOut E{(const bf16*)P.out  , (const float*)(P.ws + WS_RMS), XG, RSS};
        pg8::gemm_phase<pg8::EpiOut, pg8::StaticOrder, true, true>(lds, g, S, E);
        SEAM(3);
    }
    if (IN(4)) {
        pg8::Gemm g{XG, WqT, MTOK, NQ, DM}; pg8::StaticOrder S; S.init(MTOK, NQ, G, (int)blockIdx.x);
        pg8::EpiQ E{RSS, Qb};
        pg8::gemm_phase<pg8::EpiQ, pg8::StaticOrder, true, true>(lds, g, S, E);
        SEAM(4);
    }
    if (IN(5)) { p5_scores(P, lds);
        p6_gather(P, lds, wave);
    }
#undef IN
#undef SEAM
}

extern "C" void kernel_launch(void* const* d_in, const int* in_sizes, int n_in, void* d_out, int out_size, void* d_ws, size_t ws_size, hipStream_t stream) {
    static int grid = 0;
    if (grid == 0) {
        if (n_in != 12 || in_sizes[0] != MTOK * DM || out_size != MTOK * DM || ws_size < WS_END) { fprintf(stderr, "kernel_launch: unexpected shapes (n_in %d, in0 %d, out %d, ws %zu)\n", n_in, n_in > 0 ? in_sizes[0] : -1, out_size, ws_size); grid = -1; return; }
        int dev = 0, cus = 0, per_cu = 0;
        (void)hipGetDevice(&dev); (void)hipDeviceGetAttribute(&cus, hipDeviceAttributeMultiprocessorCount, dev);
        (void)hipOccupancyMaxActiveBlocksPerMultiprocessor(&per_cu, (const void*)fwd, 512, 0);
        (void)hipGetLastError();
        if (per_cu < 1 || cus != 256) { fprintf(stderr, "kernel_launch: occupancy %d, cus %d: need 1 block on each of 256 CUs\n", per_cu, cus); grid = -1; return; }
        grid = cus;
    }
    if (grid < 0) return;
    (void)hipMemsetAsync((char*)d_ws + WS_CTL, 0, CTL_BYTES, stream);
    Params p{};
    p.x = (const float*)d_in[0]; p.norm_mix_g = (const float*)d_in[1]; p.w_in = (const float*)d_in[2]; p.diff_lambda = (const float*)d_in[3];
    p.diff_subln_g = (const float*)d_in[4]; p.w_out = (const float*)d_in[5]; p.norm_ffn_g = (const float*)d_in[6]; p.peer_wq = (const float*)d_in[7];
    p.peer_subkeys = (const float*)d_in[8]; p.peer_u = (const float*)d_in[9]; p.peer_v = (const float*)d_in[10]; p.final_norm_g = (const float*)d_in[11];
    p.out = (float*)d_out; p.ws = (unsigned char*)d_ws;
    p.ph_lo = 0; p.ph_hi = NPHASE;
    void* args[] = {&p};
    hipError_t e = hipLaunchCooperativeKernel((const void*)fwd, dim3(grid), dim3(512), args, 0, stream);
    if (e != hipSuccess) fprintf(stderr, "kernel_launch: cooperative launch failed: %s\n", hipGetErrorString(e));
}
```
